# Optimizing an MI355X kernel written in HIP

```python
import math
import jax, jax.numpy as jnp
from jax import lax
import numpy as np

D_MODEL = 1024
BATCH = 8
SEQ = 8192
DEPTH = 1

ATT_HEADS = 8
ATT_KV_HEADS = 2
ATT_HEAD_DIM = 64
WINDOW = 128
ATT_BLOCK = 128
ML_HEADS = 4
ML_HEAD_DIM = 128
ML_CHUNK = 128
CONV_WIDTH = 3
ATT_WIDTH = ATT_HEADS * ATT_HEAD_DIM
KV_WIDTH = ATT_KV_HEADS * ATT_HEAD_DIM
ML_WIDTH = ML_HEADS * ML_HEAD_DIM
MIX_WIDTH = ATT_WIDTH + ML_WIDTH
N_GATES = 4 * ML_HEADS
IN_SECTIONS = (ATT_WIDTH, KV_WIDTH, KV_WIDTH, ML_WIDTH, ML_WIDTH, ML_WIDTH, ML_WIDTH, N_GATES)
IN_WIDTH = sum(IN_SECTIONS)
MEM_TOKENS = 256
MEM_HEADS = 4
MEM_HEAD_DIM = 128
MEM_WIDTH = MEM_HEADS * MEM_HEAD_DIM
N_EXPERTS = 16
EXPERT_FF = 1024
CAPACITY_FACTOR = 2
EPS = 1e-6

kernel_name = "hymba_swa_mlstm_ec_moe_encoder"


def rmsnorm(x, g):
    xf = x.astype(jnp.float32)
    y = xf * lax.rsqrt(jnp.mean(xf * xf, axis=-1, keepdims=True) + EPS)
    return (y * g.astype(jnp.float32)).astype(x.dtype)


def alibi_slopes(n):
    return jnp.exp2(-8.0 * jnp.arange(1, n + 1, dtype=jnp.float32) / n)


def windowed_sink_attention(q, k, v, sink):
    B, S, H, Dh = q.shape
    KV = k.shape[2]
    G = H // KV
    NB = S // ATT_BLOCK
    qb = q.reshape(B, NB, ATT_BLOCK, KV, G, Dh)

    def band(t):
        tp = jnp.pad(t, ((0, 0), (ATT_BLOCK, ATT_BLOCK), (0, 0), (0, 0)))
        tp = tp.reshape(B, NB + 2, ATT_BLOCK, KV, Dh)
        return jnp.concatenate([tp[:, :-2], tp[:, 1:-1], tp[:, 2:]], axis=2)

    kb, vb = band(k), band(v)
    scores = jnp.einsum('bnqkgd,bnskd->bnkgqs', qb, kb).astype(jnp.float32) * (Dh ** -0.5)
    qi = jnp.arange(ATT_BLOCK)[:, None]
    si = jnp.arange(3 * ATT_BLOCK)[None, :]
    dist = qi + ATT_BLOCK - si
    key_pos = jnp.arange(NB)[:, None, None] * ATT_BLOCK - ATT_BLOCK + si[None]
    valid = (jnp.abs(dist) <= WINDOW)[None] & (key_pos >= 0) & (key_pos < S)
    slopes = alibi_slopes(H).reshape(KV, G)
    bias = -slopes[:, :, None, None] * jnp.abs(dist).astype(jnp.float32)
    scores = jnp.where(valid[None, :, None, None], scores + bias[None, None], -jnp.inf)
    sink_l = sink.astype(jnp.float32).reshape(KV, G)[None, None, :, :, None, None]
    m = jnp.maximum(jnp.max(scores, axis=-1, keepdims=True), sink_l)
    p = jnp.exp(scores - m)
    denom = jnp.sum(p, axis=-1, keepdims=True) + jnp.exp(sink_l - m)
    out = jnp.einsum('bnkgqs,bnskd->bnqkgd', (p / denom).astype(v.dtype), vb)
    return out.reshape(B, S, H * Dh)


def centred_depthwise_conv(x, w, b):
    C = x.shape[-1]
    pad = (CONV_WIDTH - 1) // 2
    y = lax.conv_general_dilated(x, w[:, None, :].astype(x.dtype), window_strides=(1,),
                                 padding=[(pad, pad)], dimension_numbers=('NWC', 'WIO', 'NWC'),
                                 feature_group_count=C)
    return y + b.astype(x.dtype)


def mlstm_chunkwise(q, k, v, log_i, log_f):
    B, S, H, Dh = q.shape
    L = ML_CHUNK
    NC = S // L
    f32 = jnp.float32

    def chunks(t):
        t = t.astype(f32).reshape((B, NC, L, H) + t.shape[3:])
        return jnp.moveaxis(t, 3, 2)

    qc = chunks(q)
    kc = chunks(k) * (Dh ** -0.5)
    vc = chunks(v)
    ic = chunks(log_i)
    F = jnp.cumsum(chunks(log_f), axis=-1)
    F_end = F[..., -1]
    w_end = F_end[..., None] - F + ic
    m_loc = jnp.max(w_end, axis=-1)
    e_end = jnp.exp(w_end - m_loc[..., None])
    C_loc = jnp.einsum('bchs,bchsk,bchsv->bchkv', e_end, kc, vc)
    n_loc = jnp.einsum('bchs,bchsk->bchk', e_end, kc)

    def step(carry, inp):
        C, n, m = carry
        g, ml, Cl, nl = inp
        m_new = jnp.maximum(g + m, ml)
        a = jnp.exp(g + m - m_new)
        b = jnp.exp(ml - m_new)
        new = (a[..., None, None] * C + b[..., None, None] * Cl, a[..., None] * n + b[..., None] * nl, m_new)
        return new, (C, n, m)

    init = (jnp.zeros((B, H, Dh, Dh), f32), jnp.zeros((B, H, Dh), f32), jnp.zeros((B, H), f32))
    xs = (jnp.moveaxis(F_end, 1, 0), jnp.moveaxis(m_loc, 1, 0), jnp.moveaxis(C_loc, 1, 0), jnp.moveaxis(n_loc, 1, 0))
    _, (C0, n0, m0) = lax.scan(step, init, xs)
    C0 = jnp.moveaxis(C0, 0, 1)
    n0 = jnp.moveaxis(n0, 0, 1)
    m0 = jnp.moveaxis(m0, 0, 1)
    tri = jnp.tril(jnp.ones((L, L), dtype=bool))
    logD = jnp.where(tri, F[..., :, None] - F[..., None, :] + ic[..., None, :], -jnp.inf)
    a = F + m0[..., None]
    m_t = jnp.maximum(a, jnp.max(logD, axis=-1))
    e_inter = jnp.exp(a - m_t)
    s_qk = jnp.einsum('bchtd,bchsd->bchts', qc, kc) * jnp.exp(logD - m_t[..., None])
    num = e_inter[..., None] * jnp.einsum('bchtd,bchdv->bchtv', qc, C0) + jnp.einsum('bchts,bchsv->bchtv', s_qk, vc)
    den = e_inter * jnp.einsum('bchtd,bchd->bcht', qc, n0) + jnp.sum(s_qk, axis=-1)
    h = num / jnp.maximum(jnp.abs(den), jnp.exp(-m_t))[..., None]
    return jnp.moveaxis(h, 2, 3).reshape(B, S, H, Dh).astype(q.dtype)


def parallel_head_group_mixer(h, w_in, q_g, k_g, sink, conv_w, conv_b, gate_b, out_g, w_out):
    B, S, _ = h.shape
    splits = [int(c) for c in np.cumsum(IN_SECTIONS)[:-1]]
    aq, ak, av, mq, mk, mv, mo, gates = jnp.split(h @ w_in, splits, axis=-1)
    aq = rmsnorm(aq.reshape(B, S, ATT_HEADS, ATT_HEAD_DIM), q_g)
    ak = rmsnorm(ak.reshape(B, S, ATT_KV_HEADS, ATT_HEAD_DIM), k_g)
    av = av.reshape(B, S, ATT_KV_HEADS, ATT_HEAD_DIM)
    att_out = windowed_sink_attention(aq, ak, av, sink)
    qk = jax.nn.silu(centred_depthwise_conv(jnp.concatenate([mq, mk], axis=-1), conv_w, conv_b))
    mq, mk = jnp.split(qk, 2, axis=-1)
    mq = mq.reshape(B, S, ML_HEADS, ML_HEAD_DIM)
    mk = mk.reshape(B, S, ML_HEADS, ML_HEAD_DIM)
    mv = mv.reshape(B, S, ML_HEADS, ML_HEAD_DIM)
    g = gates.astype(jnp.float32) + gate_b.astype(jnp.float32)
    i_f, f_f, i_b, f_b = jnp.split(g, 4, axis=-1)
    h_fwd = mlstm_chunkwise(mq, mk, mv, i_f, jax.nn.log_sigmoid(f_f))
    rev = lambda t: jnp.flip(t, axis=1)
    h_bwd = rev(mlstm_chunkwise(rev(mq), rev(mk), rev(mv), rev(i_b), rev(jax.nn.log_sigmoid(f_b))))
    ml = rmsnorm(h_fwd + h_bwd, out_g.reshape(ML_HEADS, ML_HEAD_DIM)).reshape(B, S, ML_WIDTH)
    ml_out = jax.nn.sigmoid(mo) * ml
    return jnp.concatenate([att_out, ml_out], axis=-1) @ w_out


def memory_cross_attention(h, memn, w_q, w_kv, q_g, k_g, w_o):
    B, S, _ = h.shape
    M = memn.shape[1]
    q = rmsnorm((h @ w_q).reshape(B, S, MEM_HEADS, MEM_HEAD_DIM), q_g)
    k, v = jnp.split(memn @ w_kv, 2, axis=-1)
    k = rmsnorm(k.reshape(B, M, MEM_HEADS, MEM_HEAD_DIM), k_g)
    v = v.reshape(B, M, MEM_HEADS, MEM_HEAD_DIM)
    s = jnp.einsum('bshd,bmhd->bhsm', q, k).astype(jnp.float32) * (MEM_HEAD_DIM ** -0.5)
    p = jax.nn.softmax(s, axis=-1)
    o = jnp.einsum('bhsm,bmhd->bshd', p.astype(v.dtype), v).reshape(B, S, MEM_WIDTH)
    return o @ w_o


def expert_choice_ffn(h, w_router, b_router, w_gate, w_up, w_down):
    B, S, _ = h.shape
    C = CAPACITY_FACTOR * S // N_EXPERTS
    logits = (h @ w_router).astype(jnp.float32) + b_router.astype(jnp.float32)
    aff = jax.nn.softmax(logits, axis=-1)
    gval, idx = lax.top_k(jnp.swapaxes(aff, 1, 2), C)
    bidx = jnp.arange(B)[:, None, None]
    xe = h[bidx, idx]
    hid = jax.nn.silu(jnp.einsum('becd,edf->becf', xe, w_gate)) * jnp.einsum('becd,edf->becf', xe, w_up)
    ye = jnp.einsum('becf,efd->becd', hid, w_down) * gval[..., None].astype(h.dtype)
    return jnp.zeros_like(h).at[bidx, idx].add(ye)


def setup_inputs(seed: int = 0) -> dict:
    key = jax.random.key(seed)
    ks = jax.random.split(key, 32)
    f32 = jnp.float32
    L = DEPTH
    nrm = lambda k, shape, scale: jax.random.normal(k, shape, f32) * scale
    gain = lambda k, shape: 1.0 + 0.05 * jax.random.normal(k, shape, f32)
    fbias = jnp.linspace(3.0, 6.0, ML_HEADS, dtype=f32)
    ml_gate_b = jnp.concatenate([nrm(ks[10], (L, ML_HEADS), 0.1),
                                 fbias + nrm(ks[11], (L, ML_HEADS), 0.1),
                                 nrm(ks[12], (L, ML_HEADS), 0.1),
                                 fbias + nrm(ks[13], (L, ML_HEADS), 0.1)], axis=-1)
    return {
        "x": nrm(ks[0], (BATCH, SEQ, D_MODEL), 1.0),
        "mem": nrm(ks[1], (BATCH, MEM_TOKENS, D_MODEL), 1.0),
        "norm_mix_g": gain(ks[2], (L, D_MODEL)),
        "w_in": nrm(ks[3], (L, D_MODEL, IN_WIDTH), D_MODEL ** -0.5),
        "att_q_norm_g": gain(ks[4], (L, ATT_HEAD_DIM)),
        "att_k_norm_g": gain(ks[5], (L, ATT_HEAD_DIM)),
        "att_sink": nrm(ks[6], (L, ATT_HEADS), 0.5),
        "ml_conv_w": nrm(ks[7], (L, CONV_WIDTH, 2 * ML_WIDTH), CONV_WIDTH ** -0.5),
        "ml_conv_b": nrm(ks[8], (L, 2 * ML_WIDTH), 0.02),
        "ml_gate_b": ml_gate_b,
        "ml_out_norm_g": gain(ks[9], (L, ML_WIDTH)),
        "w_out": nrm(ks[14], (L, MIX_WIDTH, D_MODEL), MIX_WIDTH ** -0.5),
        "norm_mem_g": gain(ks[15], (L, D_MODEL)),
        "mem_kv_norm_g": gain(ks[16], (L, D_MODEL)),
        "w_mem_q": nrm(ks[17], (L, D_MODEL, MEM_WIDTH), D_MODEL ** -0.5),
        "w_mem_kv": nrm(ks[18], (L, D_MODEL, 2 * MEM_WIDTH), D_MODEL ** -0.5),
        "mem_q_norm_g": gain(ks[19], (L, MEM_HEAD_DIM)),
        "mem_k_norm_g": gain(ks[20], (L, MEM_HEAD_DIM)),
        "w_mem_o": nrm(ks[21], (L, MEM_WIDTH, D_MODEL), MEM_WIDTH ** -0.5),
        "norm_ffn_g": gain(ks[22], (L, D_MODEL)),
        "w_router": nrm(ks[23], (L, D_MODEL, N_EXPERTS), D_MODEL ** -0.5),
        "b_router": nrm(ks[24], (L, N_EXPERTS), 0.01),
        "w_exp_gate": nrm(ks[25], (L, N_EXPERTS, D_MODEL, EXPERT_FF), D_MODEL ** -0.5),
        "w_exp_up": nrm(ks[26], (L, N_EXPERTS, D_MODEL, EXPERT_FF), D_MODEL ** -0.5),
        "w_exp_down": nrm(ks[27], (L, N_EXPERTS, EXPERT_FF, D_MODEL), EXPERT_FF ** -0.5),
    }


def reference(x, mem, norm_mix_g, w_in, att_q_norm_g, att_k_norm_g, att_sink, ml_conv_w, ml_conv_b,
              ml_gate_b, ml_out_norm_g, w_out, norm_mem_g, mem_kv_norm_g, w_mem_q, w_mem_kv,
              mem_q_norm_g, mem_k_norm_g, w_mem_o, norm_ffn_g, w_router, b_router,
              w_exp_gate, w_exp_up, w_exp_down):
    for l in range(DEPTH):
        x = x + parallel_head_group_mixer(rmsnorm(x, norm_mix_g[l]), w_in[l], att_q_norm_g[l], att_k_norm_g[l],
                                          att_sink[l], ml_conv_w[l], ml_conv_b[l], ml_gate_b[l],
                                          ml_out_norm_g[l], w_out[l])
        x = x + memory_cross_attention(rmsnorm(x, norm_mem_g[l]), rmsnorm(mem, mem_kv_norm_g[l]),
                                       w_mem_q[l], w_mem_kv[l], mem_q_norm_g[l], mem_k_norm_g[l], w_mem_o[l])
        x = x + expert_choice_ffn(rmsnorm(x, norm_ffn_g[l]), w_router[l], b_router[l],
                                  w_exp_gate[l], w_exp_up[l], w_exp_down[l])
    return x
```

```cpp
#include <hip/hip_runtime.h>
#include <hip/hip_cooperative_groups.h>
#include <cstdio>
#include <cstdint>
namespace cg = cooperative_groups;
namespace pg8 {
#define PG8_LAS __attribute__((address_space(3)))
typedef unsigned short bf16_t;
typedef short bf16x8 __attribute__((ext_vector_type(8)));
typedef float f32x4 __attribute__((ext_vector_type(4)));
typedef unsigned u32x4 __attribute__((ext_vector_type(4)));
constexpr int BM = 256, BK = 64, HALF = 128, HTB = HALF * BK * 2  , STAGE_BYTES = 8 * HTB, NXCD = 8, WGM = 8;

__host__ __device__ __forceinline__ int lds_byte(int r, int c) { const int st = (r >> 4) * 2 + (c >> 5), rr = r & 15, cc = c & 31, ob = rr * 64 + cc * 2; return st * 1024 + (ob ^ (((ob >> 9) & 1) << 5)); }
__host__ __device__ __forceinline__ void stage_rc(int b, int& R, int& C) { const int st = b / 1024, sb = b % 1024, swz = sb ^ (((sb >> 9) & 1) << 5); R = (st >> 1) * 16 + swz / 64; C = (st & 1) * 32 + (swz % 64) / 2; }
__host__ __device__ __forceinline__ int perm32(int rho) { const int n = rho >> 4, i = rho & 15; return 8 * (i >> 2) + 4 * n + (i & 3); }

struct Unit { int pm, pn; };
struct Gemm { const bf16_t* A; const bf16_t* Bt; int M, N, K; };

struct StaticOrder {
    int nM, nN, nwg, G, c;
    __host__ __device__ void init(int M, int N, int G_, int c_) { nM = M / BM; nN = N / BM; nwg = nM * nN; G = G_; c = c_; }
    __host__ __device__ bool next(int i, Unit& u) const {
        const long L = (long)i * G + c; if (L >= nwg) return false;
        int wgid = (int)L; { const int q = nwg / NXCD, r = nwg % NXCD, xcd = wgid % NXCD, off = wgid / NXCD; wgid = (xcd < r ? xcd * (q + 1) : r * (q + 1) + (xcd - r) * q) + off; }
        const int nig = WGM * nN, gid = wgid / nig, fm = gid * WGM, gsz = (nM - fm) < WGM ? (nM - fm) : WGM;
        u.pm = fm + ((wgid % nig) % gsz); u.pn = (wgid % nig) / gsz; return true;
    }
    __device__ __forceinline__ void a_ready(const Unit&) const {}
    __device__ __forceinline__ void done(const Unit&) const {}
};

__device__ __forceinline__ unsigned cvt_pk_bf16(float lo, float hi) { unsigned r; asm volatile("v_cvt_pk_bf16_f32 %0, %1, %2" : "=v"(r) : "v"(lo), "v"(hi)); return r; }
typedef float f32x2 __attribute__((ext_vector_type(2)));
__device__ __forceinline__ f32x2 gelu_pk(f32x2 v) {
    const f32x2 av = __builtin_elementwise_abs(v), d = av * 0.2316418882f + 1.0f;
    f32x2 t; t.x = __builtin_amdgcn_rcpf(d.x); t.y = __builtin_amdgcn_rcpf(d.y);
    f32x2 q = t * 0.5307027145f + (-0.7265760135f); q = q * t + 0.7107068705f; q = q * t + (-0.142248368f); q = q * t + 0.127414796f; q = q * t;
    const f32x2 s = (v * v) * (-0.72134752044f);
    f32x2 e; e.x = __builtin_amdgcn_exp2f(s.x); e.y = __builtin_amdgcn_exp2f(s.y);
    const f32x2 m = v * (q * e), r = v - m;
    f32x2 o; o.x = v.x < 0.f ? m.x : r.x; o.y = v.y < 0.f ? m.y : r.y; return o;
}

template <int ACT  > struct EpiBf16 {
    static constexpr bool PERM = true, AFTER_DRAIN = false; static_assert(ACT == 0 || ACT == 1, "EpiBf16: ACT is 0 (none) or 1 (gelu_pk)");
    bf16_t* O; int ldc; const float* bias; int split_cols; size_t split_stride; float scale0;
    __device__ __forceinline__ void operator()(const f32x4 (&acc)[2][2][4][2], const Unit& u, int wr, int wc, int fr, int fq) const {
        const int row0 = u.pm * BM + wr * 64 + fr; int colt = u.pn * BM; bf16_t* base = O;
        float sc = 1.f; if (split_cols) { const int t = colt / split_cols; base += (size_t)t * split_stride; colt -= t * split_cols; if (t == 0) sc = scale0; }
        const int col0 = colt + wc * 32 + 8 * fq, bcol0 = u.pn * BM + wc * 32 + 8 * fq;
        f32x4 bv[2][2];
#pragma unroll
        for (int bj = 0; bj < 2; ++bj)
#pragma unroll
            for (int n = 0; n < 2; ++n) bv[bj][n] = bias ? *(const f32x4*)(bias + bcol0 + bj * HALF + 4 * n) : (f32x4){0.f, 0.f, 0.f, 0.f};
#pragma unroll
        for (int ai = 0; ai < 2; ++ai)
#pragma unroll
            for (int m = 0; m < 4; ++m) { bf16_t* rowp = base + (size_t)(row0 + ai * HALF + m * 16) * ldc + col0;
#pragma unroll
                for (int bj = 0; bj < 2; ++bj) { f32x4 v0 = acc[ai][bj][m][0] + bv[bj][0], v1 = acc[ai][bj][m][1] + bv[bj][1];
                    if (ACT == 1) { f32x2 a = gelu_pk((f32x2){v0[0], v0[1]}), b = gelu_pk((f32x2){v0[2], v0[3]}), c = gelu_pk((f32x2){v1[0], v1[1]}), d = gelu_pk((f32x2){v1[2], v1[3]});
                        v0 = (f32x4){a.x, a.y, b.x, b.y}; v1 = (f32x4){c.x, c.y, d.x, d.y}; }
                    v0 = v0 * sc; v1 = v1 * sc; u32x4 w; w.x = cvt_pk_bf16(v0[0], v0[1]); w.y = cvt_pk_bf16(v0[2], v0[3]); w.z = cvt_pk_bf16(v1[0], v1[1]); w.w = cvt_pk_bf16(v1[2], v1[3]);
                    *(u32x4*)(rowp + bj * HALF) = w; } }
    }
};
template <class Epi, class Sched, bool ALIGN_EPI = false, bool SP2 = false, bool GATHER = false>
__device__ __forceinline__ void gemm_phase(PG8_LAS unsigned char* lds, const Gemm g, const Sched& S, const Epi& E, const int* gidx = nullptr) {
    static_assert(!GATHER || SP2, "GATHER is wired into the SP2 loop only");
    int tid_ = threadIdx.x; asm volatile("" : "+v"(tid_));
    const int tid = tid_, wid = __builtin_amdgcn_readfirstlane(tid >> 6), lane = tid & 63, wr = wid >> 2, wc = wid & 3, fr = lane & 15, fq = lane >> 4;
    const int K = g.K, nt = K / BK;
    unsigned voffA[2], voffB[2];
#pragma unroll
    for (int i = 0; i < 2; ++i) { int R, C; stage_rc(tid * 16 + i * 8192, R, C); const int Rb = Epi::PERM ? ((R & ~31) + perm32(R & 31)) : R;
        voffA[i] = (unsigned)(R * K + C) * 2u; voffB[i] = (unsigned)(Rb * K + C) * 2u; }
    unsigned gC[2][2], gN[2][2]; int gRaw[2][2];
#define PG8_GRAW(pm_) do { _Pragma("unroll") for (int h_ = 0; h_ < 2; ++h_) _Pragma("unroll") for (int i_ = 0; i_ < 2; ++i_) { int R_, C_; stage_rc(tid * 16 + i_ * 8192, R_, C_); const int row_ = (pm_) * BM + h_ * HALF + R_; \
        gRaw[h_][i_] = (row_ >> 14) * 8192 + gidx[row_]; } } while (0)
#define PG8_GOFF(dst) do { _Pragma("unroll") for (int h_ = 0; h_ < 2; ++h_) _Pragma("unroll") for (int i_ = 0; i_ < 2; ++i_) { int R_, C_; stage_rc(tid * 16 + i_ * 8192, R_, C_); \
        dst[h_][i_] = ((unsigned)gRaw[h_][i_] * (unsigned)K + (unsigned)C_) * 2u; } } while (0)
    const size_t kstep = (size_t)(BK * 2);
    const size_t hstep = (size_t)HALF * K * 2;
    const size_t tstep = 2 * hstep;
    const unsigned ldsw = (unsigned)wid * 1024u;
    const int aoff = lds_byte(wr * 64 + fr, fq * 8), boff = lds_byte(wc * 32 + fr, fq * 8);
#define PG8_SA(b, h) (((b) * 2 + (h)) * HTB)
#define PG8_SB(b, h) ((4 + (b) * 2 + (h)) * HTB)
#define PG8_STAGE(bufoff, gbase, voff) do { _Pragma("unroll") for (int _i = 0; _i < 2; ++_i) \
        __builtin_amdgcn_global_load_lds((const unsigned*)((const char*)(gbase) + (voff)[_i]), (PG8_LAS unsigned*)(lds + (bufoff) + ldsw + _i * 8192), 16, 0, 0); } while (0)
#define PG8_STAGE_A(bufoff, aptr, h, nx) do { if constexpr (GATHER) { _Pragma("unroll") for (int _i = 0; _i < 2; ++_i) { const unsigned o_ = (nx) ? gN[h][_i] : gC[h][_i]; \
        __builtin_amdgcn_global_load_lds((const unsigned*)((const char*)(aptr) + o_), (PG8_LAS unsigned*)(lds + (bufoff) + ldsw + _i * 8192), 16, 0, 0); } } \
    else { PG8_STAGE(bufoff, (aptr) + (h) * hstep, voffA); } } while (0)
#define PG8_LDA(dst, b, h) do { _Pragma("unroll") for (int m = 0; m < 4; ++m) _Pragma("unroll") for (int k = 0; k < 2; ++k) dst[m][k] = *(const PG8_LAS bf16x8*)(lds + PG8_SA(b, h) + aoff + m * 2048 + k * 1024); } while (0)
#define PG8_LDB(dst, b, h) do { _Pragma("unroll") for (int n = 0; n < 2; ++n) _Pragma("unroll") for (int k = 0; k < 2; ++k) dst[n][k] = *(const PG8_LAS bf16x8*)(lds + PG8_SB(b, h) + boff + n * 2048 + k * 1024); } while (0)
#define PG8_MMA(ai, bj, At, Bt) do { __builtin_amdgcn_s_setprio(1); _Pragma("unroll") for (int m = 0; m < 4; ++m) _Pragma("unroll") for (int n = 0; n < 2; ++n) _Pragma("unroll") for (int k = 0; k < 2; ++k) \
        acc[ai][bj][m][n] = __builtin_amdgcn_mfma_f32_16x16x32_bf16(Bt[n][k], At[m][k], acc[ai][bj][m][n], 0, 0, 0); __builtin_amdgcn_s_setprio(0); } while (0)
#define PG8_WAIT_V(n) asm volatile("s_waitcnt vmcnt(" #n ")" ::: "memory")
#define PG8_WAIT_L(n) asm volatile("s_waitcnt lgkmcnt(" #n ")" ::: "memory")
#define PG8_BAR __builtin_amdgcn_s_barrier()
#define PG8_SCHED __builtin_amdgcn_sched_barrier(0)
    Unit cur, nxt; int ui = 0;
    if (!S.next(0, cur)) return;
    f32x4 acc[2][2][4][2];
#pragma unroll
    for (int a = 0; a < 2; ++a)
#pragma unroll
        for (int b = 0; b < 2; ++b)
#pragma unroll
            for (int m = 0; m < 4; ++m)
#pragma unroll
                for (int n = 0; n < 2; ++n) acc[a][b][m][n] = (f32x4){0.f, 0.f, 0.f, 0.f};
    bf16x8 At[4][2], B0[2][2], B1[2][2];
    const char* cA = GATHER ? (const char*)g.A : (const char*)g.A + (size_t)cur.pm * tstep; const char* cB = (const char*)g.Bt + (size_t)cur.pn * tstep;
    if constexpr (GATHER) { PG8_GRAW(cur.pm); PG8_GOFF(gC); PG8_GOFF(gN); }
    S.a_ready(cur);
    E.prefetch(cur, wr, fr);
    if constexpr (SP2) {
        PG8_STAGE(PG8_SB(0, 0), cB, voffB); PG8_STAGE(PG8_SB(0, 1), cB + hstep, voffB); PG8_STAGE_A(PG8_SA(0, 0), cA, 0, false); PG8_STAGE_A(PG8_SA(0, 1), cA, 1, false);
        if (wr == 1) PG8_BAR;
        PG8_WAIT_V(2); PG8_BAR;
        PG8_STAGE(PG8_SB(1, 0), cB + kstep, voffB); PG8_STAGE_A(PG8_SA(1, 0), cA + kstep, 0, false); PG8_STAGE(PG8_SB(1, 1), cB + hstep + kstep, voffB);
        PG8_WAIT_V(6); PG8_BAR;
    } else {
        PG8_STAGE(PG8_SB(0, 0), cB, voffB); PG8_STAGE(PG8_SA(0, 0), cA, voffA); PG8_STAGE(PG8_SB(0, 1), cB + hstep, voffB); PG8_STAGE(PG8_SA(0, 1), cA + hstep, voffA);
        if (wr == 1) PG8_BAR;
        PG8_WAIT_V(4); PG8_BAR;
        PG8_STAGE(PG8_SB(1, 0), cB + kstep, voffB); PG8_STAGE(PG8_SA(1, 0), cA + kstep, voffA); PG8_STAGE(PG8_SB(1, 1), cB + hstep + kstep, voffB);
        PG8_WAIT_V(6); PG8_BAR;
    }
    for (;;) {
        const bool has_next = S.next(ui + 1, nxt);
        if constexpr (GATHER) { if (has_next) PG8_GRAW(nxt.pm); }
        const char* nA = (has_next && !GATHER) ? (const char*)g.A + (size_t)nxt.pm * tstep : cA; const char* nB = has_next ? (const char*)g.Bt + (size_t)nxt.pn * tstep : cB;
        for (int t = 0; t < nt; t += 2) {
            const bool last = (t == nt - 2);
            const char* a1 = cA + (size_t)(t + 1) * kstep;
            const char* a2 = last ? nA : cA + (size_t)(t + 2) * kstep; const char* b2 = last ? nB : cB + (size_t)(t + 2) * kstep;
            const char* a3 = a2 + kstep; const char* b3 = b2 + kstep;
            if constexpr (GATHER) { if (last) { if (has_next) PG8_GOFF(gN); else { gN[0][0] = gC[0][0]; gN[0][1] = gC[0][1]; gN[1][0] = gC[1][0]; gN[1][1] = gC[1][1]; } } }
            if (last && has_next) S.a_ready(nxt);
            if constexpr (SP2) {
            PG8_LDB(B0, 0, 0); PG8_LDB(B1, 0, 1); PG8_SCHED; PG8_LDA(At, 0, 0); PG8_STAGE_A(PG8_SA(1, 1), a1, 1, false);
            PG8_WAIT_V(8); PG8_WAIT_L(0); PG8_BAR; PG8_MMA(0, 0, At, B0); PG8_MMA(0, 1, At, B1); PG8_BAR; PG8_SCHED;
            PG8_LDA(At, 0, 1); PG8_STAGE(PG8_SB(0, 0), b2, voffB); PG8_STAGE(PG8_SB(0, 1), b2 + hstep, voffB); PG8_STAGE_A(PG8_SA(0, 0), a2, 0, last);
            PG8_WAIT_V(8); PG8_WAIT_L(0); PG8_BAR; PG8_MMA(1, 0, At, B0); PG8_MMA(1, 1, At, B1); PG8_BAR; PG8_SCHED;
            PG8_LDB(B0, 1, 0); PG8_LDB(B1, 1, 1); PG8_SCHED; PG8_LDA(At, 1, 0); PG8_STAGE_A(PG8_SA(0, 1), a2, 1, last);
            PG8_WAIT_V(8); PG8_WAIT_L(0); PG8_BAR; PG8_MMA(0, 0, At, B0); PG8_MMA(0, 1, At, B1); PG8_BAR; PG8_SCHED;
            PG8_LDA(At, 1, 1); PG8_STAGE(PG8_SB(1, 0), b3, voffB); PG8_STAGE(PG8_SB(1, 1), b3 + hstep, voffB); PG8_STAGE_A(PG8_SA(1, 0), a3, 0, last);
            PG8_WAIT_V(8); PG8_WAIT_L(0); PG8_BAR; PG8_MMA(1, 0, At, B0); PG8_MMA(1, 1, At, B1); PG8_BAR; PG8_SCHED;
            } else {
            PG8_LDB(B0, 0, 0); PG8_SCHED; PG8_LDA(At, 0, 0); PG8_STAGE(PG8_SA(1, 1), a1 + hstep, voffA);
            PG8_WAIT_L(8); PG8_BAR; PG8_WAIT_L(0); PG8_MMA(0, 0, At, B0); PG8_BAR; PG8_SCHED;
            PG8_LDB(B1, 0, 1); PG8_STAGE(PG8_SB(0, 0), b2, voffB);
            PG8_BAR; PG8_WAIT_L(0); PG8_MMA(0, 1, At, B1); PG8_BAR;
            PG8_LDA(At, 0, 1); PG8_STAGE(PG8_SA(0, 0), a2, voffA);
            PG8_BAR; PG8_WAIT_L(0); PG8_MMA(1, 0, At, B0); PG8_BAR; PG8_SCHED;
            PG8_STAGE(PG8_SB(0, 1), b2 + hstep, voffB);
            PG8_WAIT_V(6); PG8_BAR; PG8_MMA(1, 1, At, B1); PG8_BAR;
            PG8_LDB(B0, 1, 0); PG8_SCHED; PG8_LDA(At, 1, 0); PG8_STAGE(PG8_SA(0, 1), a2 + hstep, voffA);
            PG8_WAIT_L(8); PG8_BAR; PG8_WAIT_L(0); PG8_MMA(0, 0, At, B0); PG8_BAR; PG8_SCHED;
            PG8_LDB(B1, 1, 1); PG8_STAGE(PG8_SB(1, 0), b3, voffB);
            PG8_BAR; PG8_WAIT_L(0); PG8_MMA(0, 1, At, B1); PG8_BAR;
            PG8_LDA(At, 1, 1); PG8_STAGE(PG8_SA(1, 0), a3, voffA);
            PG8_BAR; PG8_WAIT_L(0); PG8_MMA(1, 0, At, B0); PG8_BAR; PG8_SCHED;
            PG8_STAGE(PG8_SB(1, 1), b3 + hstep, voffB);
            PG8_WAIT_V(6); PG8_BAR; PG8_MMA(1, 1, At, B1); PG8_BAR;
            }
        }
        if constexpr (ALIGN_EPI) { if (wr == 0) PG8_BAR; }
        if constexpr (!Epi::AFTER_DRAIN) { E(acc, cur, wr, wc, fr, fq); S.done(cur); }
        if (!has_next) break;
#pragma unroll
        for (int a = 0; a < 2; ++a)
#pragma unroll
            for (int b = 0; b < 2; ++b)
#pragma unroll
                for (int m = 0; m < 4; ++m)
#pragma unroll
                    for (int n = 0; n < 2; ++n) acc[a][b][m][n] = (f32x4){0.f, 0.f, 0.f, 0.f};
        cur = nxt; cA = nA; cB = nB; ++ui;
        E.prefetch(cur, wr, fr);
        if constexpr (GATHER) { gC[0][0] = gN[0][0]; gC[0][1] = gN[0][1]; gC[1][0] = gN[1][0]; gC[1][1] = gN[1][1]; }
        if constexpr (ALIGN_EPI) { if (wr == 1) PG8_BAR; }
    }
    PG8_WAIT_V(0);
    if constexpr (!ALIGN_EPI) { if (wr == 0) PG8_BAR; }
    PG8_BAR;
    if constexpr (Epi::AFTER_DRAIN) { E.fused(acc, cur, wr, wc, fr, fq, lds, wid, lane); S.done(cur); }
#undef PG8_SA
#undef PG8_SB
#undef PG8_STAGE
#undef PG8_STAGE_A
#undef PG8_GRAW
#undef PG8_GOFF
#undef PG8_LDA
#undef PG8_LDB
#undef PG8_MMA
#undef PG8_WAIT_V
#undef PG8_WAIT_L
#undef PG8_BAR
#undef PG8_SCHED
}
}
constexpr int BATCH = 8, SEQ = 8192, DM = 1024, T = BATCH * SEQ;
constexpr int INW = 2832, INW_G = 2816;
constexpr int NEXP = 16, CAP = 1024, FF = 1024, MEMT = 256;
constexpr int XROWS = BATCH * NEXP * CAP;
constexpr float EPS = 1e-6f;
constexpr float LOG2E = 1.4426950408889634f;

#define GAS __attribute__((address_space(1)))
#define LAS __attribute__((address_space(3)))
typedef unsigned short bf16;
typedef unsigned u32x4 __attribute__((ext_vector_type(4)));
typedef unsigned u32x2 __attribute__((ext_vector_type(2)));
typedef float f32x4 __attribute__((ext_vector_type(4)));
typedef float f32x2 __attribute__((ext_vector_type(2)));
typedef float f32x16 __attribute__((ext_vector_type(16)));
typedef short bf16x8 __attribute__((ext_vector_type(8)));
typedef short bf16x4 __attribute__((ext_vector_type(4)));

constexpr size_t MiB = 1u << 20;
constexpr size_t WS_CTL = 0;
constexpr size_t WS_GATES = 1 * MiB;
constexpr size_t WS_SSQAQ = 5 * MiB;
constexpr size_t WS_SSQAK = 9 * MiB;
constexpr size_t WS_SSQ1 = 10 * MiB;
constexpr size_t WS_SSQQ = 14 * MiB;
constexpr size_t WS_SSQ2 = 18 * MiB;
constexpr size_t WS_AFF = 22 * MiB;
constexpr size_t WS_SLOT = 26 * MiB;
constexpr size_t WS_N0 = 30 * MiB;
constexpr size_t WS_MEMN = 32 * MiB;
constexpr size_t WS_KVM = 36 * MiB;
constexpr size_t WS_SSQMK = 40 * MiB;
constexpr size_t WS_RINV2 = 40 * MiB + 256 * 1024;
constexpr size_t WS_IDX = 40 * MiB + 512 * 1024;
constexpr size_t WS_GVAL = 41 * MiB;
constexpr size_t WS_RINVE = 41 * MiB + 512 * 1024;
constexpr size_t WS_WST = 43 * MiB;
constexpr size_t WS_FTA = 45 * MiB;
constexpr size_t WS_RINVX = 47 * MiB + 64 * 1024;
constexpr size_t WS_DEC = 47 * MiB;
constexpr size_t WS_ESA = 60 * MiB;
constexpr size_t WS_WG16 = 42 * MiB;
constexpr size_t WS_WRHI = 42 * MiB + 64 * 1024;
constexpr size_t WS_WRLO = 42 * MiB + 128 * 1024;
constexpr size_t WS_WIN = 48 * MiB;
constexpr size_t WS_WOUT = 54 * MiB;
constexpr size_t WS_WMQ = 56 * MiB;
constexpr size_t WS_WKV = 57 * MiB;
constexpr size_t WS_WMO = 59 * MiB;
constexpr size_t WS_WGU = 64 * MiB;
constexpr size_t WS_WD = 128 * MiB;
constexpr size_t WS_A = 160 * MiB;
constexpr size_t WS_AQ = WS_A, WS_AK = WS_A + 64 * MiB, WS_AV = WS_A + 80 * MiB, WS_MQ = WS_A + 96 * MiB, WS_MK = WS_A + 160 * MiB, WS_MV = WS_A + 224 * MiB, WS_MO = WS_A + 288 * MiB;
constexpr size_t WS_XE = WS_A, WS_Y = WS_A;
constexpr size_t WS_B = 512 * MiB;
constexpr size_t WS_XN = WS_B, WS_MIX = WS_B, WS_QM = WS_B, WS_OM = WS_B + 64 * MiB;
constexpr size_t WS_C = 640 * MiB;
constexpr size_t WS_C0 = WS_C, WS_X1B = WS_C;
constexpr size_t WS_X2B = 768 * MiB;
constexpr size_t WS_HID = WS_B;
constexpr size_t WS_QC = 768 * MiB, WS_KC = 832 * MiB;
constexpr size_t WS_XB = 896 * MiB;
constexpr size_t WS_END = 1024 * MiB;

constexpr int LDS_BYTES = 155648;

__device__ __forceinline__ unsigned f2bf(float f) { unsigned u = __builtin_bit_cast(unsigned, f); return (u + 0x7fffu + ((u >> 16) & 1u)) >> 16; }
typedef __bf16 hwbf16x2 __attribute__((ext_vector_type(2)));
__device__ __forceinline__ unsigned pk2(float lo, float hi) { const f32x2 v = {lo, hi}; return __builtin_bit_cast(unsigned, __builtin_convertvector(v, hwbf16x2)); }
__device__ __forceinline__ float bf2f(unsigned short h) { return __builtin_bit_cast(float, (unsigned)h << 16); }
__device__ __forceinline__ float bflo(unsigned w) { return __builtin_bit_cast(float, w << 16); }
__device__ __forceinline__ float bfhi(unsigned w) { return __builtin_bit_cast(float, w & 0xffff0000u); }
__device__ __forceinline__ float wave_sum(float v) {
#pragma unroll
    for (int o = 1; o < 64; o <<= 1) v += __shfl_xor(v, o);
    return v;
}
__device__ __forceinline__ f32x16 mfma32(bf16x8 a, bf16x8 b, f32x16 c) { return __builtin_amdgcn_mfma_f32_32x32x16_bf16(a, b, c, 0, 0, 0); }
__device__ __forceinline__ f32x4 mfma16(bf16x8 a, bf16x8 b, f32x4 c) { return __builtin_amdgcn_mfma_f32_16x16x32_bf16(a, b, c, 0, 0, 0); }
#define LDS_WAIT() asm volatile("s_waitcnt lgkmcnt(0)" ::: "memory")

enum { I_X = 0, I_MEM, I_NORM_MIX_G, I_W_IN, I_ATT_Q_G, I_ATT_K_G, I_ATT_SINK, I_CONV_W, I_CONV_B, I_GATE_B, I_ML_OUT_G, I_W_OUT, I_NORM_MEM_G, I_MEM_KV_G,
       I_W_MEM_Q, I_W_MEM_KV, I_MEM_Q_G, I_MEM_K_G, I_W_MEM_O, I_NORM_FFN_G, I_W_ROUTER, I_B_ROUTER, I_W_GATE, I_W_UP, I_W_DOWN };
#define CAS __attribute__((address_space(4)))
struct Frame {
    LAS unsigned char* lds;
    int tid, lane, wave, bid, G;
    float* out; unsigned char* ws;
};
__device__ __forceinline__ const float* inp(int i) { const volatile CAS unsigned long long* ka = (const volatile CAS unsigned long long*)__builtin_amdgcn_kernarg_segment_ptr(); return (const float*)(const GAS float*)ka[i]; }
template <class Tp> __device__ __forceinline__ Tp* wsp(const Frame& F, size_t off) { return (Tp*)(GAS Tp*)(F.ws + off); }

namespace pg8 {
struct EpiInProj {
    static constexpr bool PERM = true, AFTER_DRAIN = false;
    unsigned char* ws; mutable float rpre[8];
    __device__ __forceinline__ void prefetch(const Unit& u, int wr, int fr) const { const float* rx = (const float*)(ws + WS_RINVX) + u.pm * BM + wr * 64 + fr;
#pragma unroll
        for (int i = 0; i < 8; ++i) rpre[i] = rx[(i >> 2) * HALF + (i & 3) * 16]; }
    __device__ __forceinline__ void operator()(const f32x4 (&acc)[2][2][4][2], const Unit& u, int wr, int wc, int fr, int fq) const {
        const int pn = u.pn;
        bf16_t* base[2]; int ld[2];
        if (pn < 2) { base[0] = (bf16_t*)(ws + WS_AQ) + 256 * pn; base[1] = base[0] + 128; ld[0] = ld[1] = 512; }
        else if (pn == 2) { base[0] = (bf16_t*)(ws + WS_AK); base[1] = (bf16_t*)(ws + WS_AV); ld[0] = ld[1] = 128; }
        else { const int s = (pn - 3) >> 1; base[0] = (bf16_t*)(ws + WS_MQ + (size_t)s * (64u << 20)) + 256 * ((pn - 3) & 1); base[1] = base[0] + 128; ld[0] = ld[1] = 512; }
        const int row0 = u.pm * BM + wr * 64 + fr, cw = wc * 32 + 8 * fq;
        float* sq = (float*)(ws + WS_SSQAQ); float* sk = (float*)(ws + WS_SSQAK);
#pragma unroll
        for (int ai = 0; ai < 2; ++ai)
#pragma unroll
            for (int m = 0; m < 4; ++m) {
                const int row = row0 + ai * HALF + m * 16; const float rs = rpre[ai * 4 + m];
#pragma unroll
                for (int bj = 0; bj < 2; ++bj) {
                    const f32x4 v0 = acc[ai][bj][m][0] * rs, v1 = acc[ai][bj][m][1] * rs;
                    u32x4 w; w.x = cvt_pk_bf16(v0[0], v0[1]); w.y = cvt_pk_bf16(v0[2], v0[3]); w.z = cvt_pk_bf16(v1[0], v1[1]); w.w = cvt_pk_bf16(v1[2], v1[3]);
                    *(GAS u32x4*)(base[bj] + (size_t)row * ld[bj] + cw) = w;
                    if (pn < 2 || (pn == 2 && bj == 0)) {
                        float s = (v0[0] * v0[0] + v0[1] * v0[1]) + (v0[2] * v0[2] + v0[3] * v0[3]) + (v1[0] * v1[0] + v1[1] * v1[1]) + (v1[2] * v1[2] + v1[3] * v1[3]);
                        s += __shfl_xor(s, 16); s += __shfl_xor(s, 32);
                        if (fq == 0) { if (pn < 2) sq[(size_t)((pn * 4 + bj * 2 + (wc >> 1)) * 2 + (wc & 1)) * T + row] = s; else sk[(size_t)wc * T + row] = s; }
                    }
                }
            }
    }
};
template <bool ROWSCALE> struct EpiHead128 {
    static constexpr bool PERM = true, AFTER_DRAIN = false;
    bf16_t* O; int ldc; const float* ssq_in; float* ssq_out; int nssq_tiles; int nrows;
    mutable float rpre[8];
    __device__ __forceinline__ void prefetch(const Unit& u, int wr, int fr) const {
        if (ROWSCALE) {
#pragma unroll
            for (int i = 0; i < 8; ++i) { const int row = u.pm * BM + wr * 64 + fr + (i >> 2) * HALF + (i & 3) * 16;
                float t = 0.f;
#pragma unroll
                for (int q = 0; q < 16; ++q) t += ssq_in[(size_t)q * nrows + row];
                rpre[i] = 1.0f / sqrtf(t * (1.0f / 1024.0f) + 1e-6f); }
        }
    }
    __device__ __forceinline__ void operator()(const f32x4 (&acc)[2][2][4][2], const Unit& u, int wr, int wc, int fr, int fq) const {
        const int row0 = u.pm * BM + wr * 64 + fr, col0 = u.pn * BM + wc * 32 + 8 * fq;
#pragma unroll
        for (int ai = 0; ai < 2; ++ai)
#pragma unroll
            for (int m = 0; m < 4; ++m) {
                const int row = row0 + ai * HALF + m * 16;
                const float rs = ROWSCALE ? rpre[ai * 4 + m] : 1.f;
#pragma unroll
                for (int bj = 0; bj < 2; ++bj) {
                    const f32x4 v0 = acc[ai][bj][m][0] * rs, v1 = acc[ai][bj][m][1] * rs;
                    u32x4 w; w.x = cvt_pk_bf16(v0[0], v0[1]); w.y = cvt_pk_bf16(v0[2], v0[3]); w.z = cvt_pk_bf16(v1[0], v1[1]); w.w = cvt_pk_bf16(v1[2], v1[3]);
                    *(u32x4*)(O + (size_t)row * ldc + col0 + bj * HALF) = w;
                    if (u.pn < nssq_tiles) {
                        float s = (v0[0] * v0[0] + v0[1] * v0[1]) + (v0[2] * v0[2] + v0[3] * v0[3]) + (v1[0] * v1[0] + v1[1] * v1[1]) + (v1[2] * v1[2] + v1[3] * v1[3]);
                        s += __shfl_xor(s, 16); s += __shfl_xor(s, 32);
                        if (fq == 0) ssq_out[(size_t)((2 * u.pn + bj) * 4 + wc) * nrows + row] = s;
                    }
                }
            }
    }
};
template <bool BASE_BF16> struct EpiResid {
    static constexpr bool PERM = true, AFTER_DRAIN = false;
    const void* base; bf16_t* outb; float* ssq;
    __device__ __forceinline__ void prefetch(const Unit&, int, int) const {}
    __device__ __forceinline__ void operator()(const f32x4 (&acc)[2][2][4][2], const Unit& u, int wr, int wc, int fr, int fq) const {
        const int row0 = u.pm * BM + wr * 64 + fr, col0 = u.pn * BM + wc * 32 + 8 * fq;
#pragma unroll
        for (int ai = 0; ai < 2; ++ai)
#pragma unroll
            for (int m = 0; m < 4; ++m) {
                const int row = row0 + ai * HALF + m * 16; const size_t off = (size_t)row * 1024 + col0;
                float s = 0.f;
#pragma unroll
                for (int bj = 0; bj < 2; ++bj) {
                    f32x4 b0, b1;
                    if (BASE_BF16) { const u32x4 bw = *(const u32x4*)((const bf16_t*)base + off + bj * HALF);
                        b0[0] = __builtin_bit_cast(float, bw.x << 16); b0[1] = __builtin_bit_cast(float, bw.x & 0xffff0000u); b0[2] = __builtin_bit_cast(float, bw.y << 16); b0[3] = __builtin_bit_cast(float, bw.y & 0xffff0000u);
                        b1[0] = __builtin_bit_cast(float, bw.z << 16); b1[1] = __builtin_bit_cast(float, bw.z & 0xffff0000u); b1[2] = __builtin_bit_cast(float, bw.w << 16); b1[3] = __builtin_bit_cast(float, bw.w & 0xffff0000u); }
                    else { b0 = *(const f32x4*)((const float*)base + off + bj * HALF); b1 = *(const f32x4*)((const float*)base + off + bj * HALF + 4); }
                    const f32x4 v0 = acc[ai][bj][m][0] + b0, v1 = acc[ai][bj][m][1] + b1;
                    u32x4 w; w.x = cvt_pk_bf16(v0[0], v0[1]); w.y = cvt_pk_bf16(v0[2], v0[3]); w.z = cvt_pk_bf16(v1[0], v1[1]); w.w = cvt_pk_bf16(v1[2], v1[3]);
                    *(u32x4*)(outb + off + bj * HALF) = w;
                    s += (v0[0] * v0[0] + v0[1] * v0[1]) + (v0[2] * v0[2] + v0[3] * v0[3]) + (v1[0] * v1[0] + v1[1] * v1[1]) + (v1[2] * v1[2] + v1[3] * v1[3]);
                }
                s += __shfl_xor(s, 16); s += __shfl_xor(s, 32);
                if (ssq != nullptr && fq == 0) ssq[(size_t)(u.pn * 4 + wc) * T + row] = s;
            }
    }
};
struct EpiGateUp {
    static constexpr bool PERM = true, AFTER_DRAIN = false;
    bf16_t* H; const float* rinv; mutable float rpre[8];
    __device__ __forceinline__ void prefetch(const Unit& u, int wr, int fr) const { const float* p = rinv + u.pm * BM + wr * 64 + fr;
#pragma unroll
        for (int i = 0; i < 8; ++i) rpre[i] = p[(i >> 2) * HALF + (i & 3) * 16]; }
    __device__ __forceinline__ void operator()(const f32x4 (&acc)[2][2][4][2], const Unit& u, int wr, int wc, int fr, int fq) const {
        const int row0 = u.pm * BM + wr * 64 + fr, col0 = (u.pn & 7) * 128 + wc * 32 + 8 * fq;
#pragma unroll
        for (int ai = 0; ai < 2; ++ai)
#pragma unroll
            for (int m = 0; m < 4; ++m) {
                const int row = row0 + ai * HALF + m * 16; const float r = rpre[ai * 4 + m];
                float h[8];
#pragma unroll
                for (int n = 0; n < 2; ++n)
#pragma unroll
                    for (int e = 0; e < 4; ++e) { const float g = acc[ai][0][m][n][e] * r, up = acc[ai][1][m][n][e] * r;
                        const float sg = g * __builtin_amdgcn_rcpf(1.0f + __builtin_amdgcn_exp2f(-g * 1.4426950408889634f)); h[n * 4 + e] = sg * up; }
                u32x4 w; w.x = cvt_pk_bf16(h[0], h[1]); w.y = cvt_pk_bf16(h[2], h[3]); w.z = cvt_pk_bf16(h[4], h[5]); w.w = cvt_pk_bf16(h[6], h[7]);
                *(u32x4*)(H + (size_t)row * 1024 + col0) = w;
            }
    }
};
struct EpiDown {
    static constexpr bool PERM = true, AFTER_DRAIN = false;
    bf16_t* Y; const float* gval; mutable float rpre[8];
    __device__ __forceinline__ void prefetch(const Unit& u, int wr, int fr) const { const float* p = gval + u.pm * BM + wr * 64 + fr;
#pragma unroll
        for (int i = 0; i < 8; ++i) rpre[i] = p[(i >> 2) * HALF + (i & 3) * 16]; }
    __device__ __forceinline__ void operator()(const f32x4 (&acc)[2][2][4][2], const Unit& u, int wr, int wc, int fr, int fq) const {
        const int row0 = u.pm * BM + wr * 64 + fr, col0 = (u.pn & 3) * BM + wc * 32 + 8 * fq;
#pragma unroll
        for (int ai = 0; ai < 2; ++ai)
#pragma unroll
            for (int m = 0; m < 4; ++m) {
                const int row = row0 + ai * HALF + m * 16; const float r = rpre[ai * 4 + m];
#pragma unroll
                for (int bj = 0; bj < 2; ++bj) {
                    const f32x4 v0 = acc[ai][bj][m][0] * r, v1 = acc[ai][bj][m][1] * r;
                    u32x4 w; w.x = cvt_pk_bf16(v0[0], v0[1]); w.y = cvt_pk_bf16(v0[2], v0[3]); w.z = cvt_pk_bf16(v1[0], v1[1]); w.w = cvt_pk_bf16(v1[2], v1[3]);
                    *(u32x4*)(Y + (size_t)row * 1024 + col0 + bj * HALF) = w;
                }
            }
    }
};
template <int NT> struct ExpertOrder {
    int G, c;
    __device__ bool next(int i, Unit& u) const {
        constexpr int UPG = 4 * NT, NU = 128 * UPG;
        const long L = (long)i * G + c; if (L >= NU) return false;
        const int xcd = (int)(L % 8), off = (int)(L / 8), idx = xcd * (NU / 8) + off;
        const int g = idx / UPG, w = idx % UPG, e = g >> 3, b = g & 7;
        u.pm = (b * 16 + e) * 4 + (w & 3); u.pn = e * NT + (w >> 2); return true;
    }
    __device__ __forceinline__ void a_ready(const Unit&) const {}
    __device__ __forceinline__ void done(const Unit&) const {}
};
}
#define XB_TMO      128
#define XB_XCNT(j)  (256  + 64 * (j))
#define XB_XSUB(j)  (1280 + 64 * (j))
#define XB_XGEN(j)  (2304 + 64 * (j))
#define XB_TOP      3328
#define XB_TOPGEN   3392
#define XCD_BAR_WORDS 3456
#define XB_SPIN_CAP (1u << 18)

__device__ __forceinline__ unsigned xb_ld(unsigned* p)              { return __hip_atomic_load(p, __ATOMIC_RELAXED, __HIP_MEMORY_SCOPE_AGENT); }
__device__ __forceinline__ unsigned xb_add(unsigned* p, unsigned v) { return __hip_atomic_fetch_add(p, v, __ATOMIC_RELAXED, __HIP_MEMORY_SCOPE_AGENT); }
__device__ __forceinline__ unsigned xb_xcc_id() { return (unsigned)__builtin_amdgcn_s_getreg((3 << 11) | 20) & 0xFu; }
#define XB_SPIN(cond, bar) do { unsigned _sp = 0; while (cond) { __builtin_amdgcn_s_sleep(1); \
    if ((++_sp & 255u) == 0u) { if (xb_ld(&(bar)[XB_TMO])) break; if (_sp > XB_SPIN_CAP) { atomicAdd(&(bar)[XB_TMO], 1u); break; } } } } while (0)

struct XcdBarrier {
    unsigned* bar; unsigned x;
    volatile LAS unsigned* st;
};

__device__ __forceinline__ XcdBarrier xcd_barrier_post(unsigned* bar, volatile LAS unsigned* st) {
    XcdBarrier b; b.bar = bar; b.x = xb_xcc_id(); b.st = st;
    if (threadIdx.x == 0) (void)xb_add(&bar[XB_XCNT(b.x)], 1u);
    return b;
}
__device__ __forceinline__ void xcd_barrier_complete(unsigned* bar, unsigned x, unsigned& nloc, unsigned& nx) {
    const unsigned G = gridDim.x * gridDim.y * gridDim.z;
    unsigned sum, cnt, mine, sp = 0u;
    for (;;) {
        sum = 0u; cnt = 0u; mine = 0u;
#pragma unroll
        for (unsigned j = 0; j < 16; ++j) { const unsigned c = xb_ld(&bar[XB_XCNT(j)]); sum += c; cnt += (c > 0u) ? 1u : 0u; mine = (j == x) ? c : mine; }
        if (sum == G) break;
        __builtin_amdgcn_s_sleep(1);
        if ((++sp & 255u) == 0u) { if (xb_ld(&bar[XB_TMO])) break; if (sp > XB_SPIN_CAP) { atomicAdd(&bar[XB_TMO], 1u); break; } }
    }
    nloc = mine > 0u ? mine : 1u; nx = cnt > 0u ? cnt : 1u;
}

__device__ __forceinline__ void xcd_barrier(const XcdBarrier& b) {
    asm volatile("s_waitcnt vmcnt(0)" ::: "memory");
    __syncthreads();
    if (threadIdx.x == 0) {
        unsigned* bar = b.bar;
        __builtin_amdgcn_s_waitcnt(0);
        unsigned nloc = b.st[0], nx = b.st[1];
        if (nloc == 0u) { xcd_barrier_complete(bar, b.x, nloc, nx); b.st[0] = nloc; b.st[1] = nx; }
        const unsigned old = xb_add(&bar[XB_XSUB(b.x)], 1u);
        const unsigned gen = old / nloc;
        if (old + 1u == (gen + 1u) * nloc) {
            __builtin_amdgcn_fence(__ATOMIC_RELEASE, "agent");
            asm volatile("s_waitcnt vmcnt(0)" ::: "memory");
            const unsigned og = xb_add(&bar[XB_TOP], 1u);
            const unsigned tg = og / nx;
            if (og + 1u == (tg + 1u) * nx) xb_add(&bar[XB_TOPGEN], 1u);
            else XB_SPIN(xb_ld(&bar[XB_TOPGEN]) == tg, bar);
            __builtin_amdgcn_fence(__ATOMIC_ACQUIRE, "agent");
            xb_add(&bar[XB_XGEN(b.x)], 1u);
            asm volatile("s_waitcnt vmcnt(0)" ::: "memory");
        } else {
            XB_SPIN(xb_ld(&bar[XB_XGEN(b.x)]) == gen, bar);
            __builtin_amdgcn_fence(__ATOMIC_ACQUIRE, "agent");
            asm volatile("s_waitcnt vmcnt(0)" ::: "memory");
        }
    }
    __syncthreads();
}

template <class RowMap> __device__ __forceinline__ void tr_tile(const float* W, int N, int k0, int n0, bf16* WT, int K, const float* kscale, LAS unsigned char* tile, int lane, RowMap rowmap) {
    const int ksub = lane >> 4, n4 = (lane & 15) * 4;
    const float* src = W + (size_t)(k0 + ksub) * N + n0 + n4;
    f32x4 v[16];
#pragma unroll
    for (int i = 0; i < 16; ++i) v[i] = *(const f32x4*)(src + (size_t)(4 * i) * N);
    if (kscale) {
#pragma unroll
        for (int i = 0; i < 16; ++i) v[i] = v[i] * kscale[k0 + 4 * i + ksub];
    }
    LAS unsigned short* t = (LAS unsigned short*)tile;
#pragma unroll
    for (int i = 0; i < 16; ++i) { const unsigned p0 = pk2(v[i][0], v[i][1]), p1 = pk2(v[i][2], v[i][3]); const int k = 4 * i + ksub;
        t[(n4 + 0) * 72 + k] = (unsigned short)(p0 & 0xffffu); t[(n4 + 1) * 72 + k] = (unsigned short)(p0 >> 16);
        t[(n4 + 2) * 72 + k] = (unsigned short)(p1 & 0xffffu); t[(n4 + 3) * 72 + k] = (unsigned short)(p1 >> 16); }
    LDS_WAIT(); asm volatile("" ::: "memory");
    const int ch = lane & 7;
#pragma unroll
    for (int j = 0; j < 8; ++j) { const int n = (lane >> 3) + 8 * j;
        const u32x4 o = *(const LAS u32x4*)(tile + n * 144 + ch * 16);
        *(u32x4*)(WT + (size_t)rowmap(n0 + n) * K + k0 + 8 * ch) = o; }
    LDS_WAIT(); asm volatile("" ::: "memory");
}
struct RowId { __device__ __forceinline__ int operator()(int n) const { return n; } };
struct RowOff { int off; __device__ __forceinline__ int operator()(int n) const { return off + n; } };
struct RowGateUp { int e, which; __device__ __forceinline__ int operator()(int n) const { return e * 2048 + 256 * (n >> 7) + 128 * which + (n & 127); } };
__device__ __forceinline__ void rms_row_to_bf16(const float* xrow, const float* g, bf16* orow, int lane) {
    const f32x4* xr = (const f32x4*)xrow + lane; const f32x4* gr = (const f32x4*)g + lane;
    f32x4 v[4]; float s = 0.f;
#pragma unroll
    for (int j = 0; j < 4; ++j) { v[j] = xr[64 * j]; s += (v[j][0] * v[j][0] + v[j][1] * v[j][1]) + (v[j][2] * v[j][2] + v[j][3] * v[j][3]); }
    const float r = 1.0f / sqrtf(wave_sum(s) * (1.0f / 1024.0f) + EPS);
    u32x2* o8 = (u32x2*)orow + lane;
#pragma unroll
    for (int j = 0; j < 4; ++j) { const f32x4 gg = gr[64 * j]; u32x2 w; w.x = pk2(v[j][0] * r * gg[0], v[j][1] * r * gg[1]); w.y = pk2(v[j][2] * r * gg[2], v[j][3] * r * gg[3]); o8[64 * j] = w; }
}
__device__ __forceinline__ void x_row2_to_bf16(const float* xrow, bf16* orow, float* rinv, int lane) {
    const f32x4* xr = (const f32x4*)xrow + lane;
    f32x4 v[8]; float s0 = 0.f, s1 = 0.f;
#pragma unroll
    for (int j = 0; j < 8; ++j) v[j] = xr[64 * j];
    u32x2* o8 = (u32x2*)orow + lane;
#pragma unroll
    for (int j = 0; j < 8; ++j) { u32x2 w; w.x = pk2(v[j][0], v[j][1]); w.y = pk2(v[j][2], v[j][3]); o8[64 * j] = w; }
#pragma unroll
    for (int j = 0; j < 4; ++j) { s0 += (v[j][0] * v[j][0] + v[j][1] * v[j][1]) + (v[j][2] * v[j][2] + v[j][3] * v[j][3]);
                                  s1 += (v[j + 4][0] * v[j + 4][0] + v[j + 4][1] * v[j + 4][1]) + (v[j + 4][2] * v[j + 4][2] + v[j + 4][3] * v[j + 4][3]); }
#pragma unroll
    for (int o = 1; o < 64; o <<= 1) { s0 += __shfl_xor(s0, o); s1 += __shfl_xor(s1, o); }
    if (lane == 0) { rinv[0] = 1.0f / sqrtf(s0 * (1.0f / 1024.0f) + EPS); rinv[1] = 1.0f / sqrtf(s1 * (1.0f / 1024.0f) + EPS); }
}
__device__ __forceinline__ void prep_weights(Frame& F) {
    const float* w_in = inp(I_W_IN); const float* norm_ffn_g = inp(I_NORM_FFN_G);
    const int gw = F.bid * 8 + F.wave, NGW = F.G * 8, lane = F.lane;
    LAS unsigned char* tile = F.lds + F.wave * 9216;
    constexpr int I_IN = 16 * 44, I_OUT = 16 * 16, I_MQ = 16 * 8, I_KV = 16 * 16, I_MO = 8 * 16, I_EX = 16 * 16 * 16;
    constexpr int NITEMS = I_IN + I_OUT + I_MQ + I_KV + I_MO + 3 * I_EX;
    for (int it = gw; it < NITEMS; it += NGW) {
        int r = it;
        if (r < I_IN) { const int kb = r / 44, nb = r % 44; tr_tile(w_in, INW, 64 * kb, 64 * nb, wsp<bf16>(F, WS_WIN), 1024, inp(I_NORM_MIX_G), tile, lane, RowId{}); continue; } r -= I_IN;
        if (r < I_OUT) { const int kb = r / 16, nb = r % 16; tr_tile(inp(I_W_OUT), 1024, 64 * kb, 64 * nb, wsp<bf16>(F, WS_WOUT), 1024, nullptr, tile, lane, RowId{}); continue; } r -= I_OUT;
        if (r < I_MQ) { const int kb = r / 8, nb = r % 8; tr_tile(inp(I_W_MEM_Q), 512, 64 * kb, 64 * nb, wsp<bf16>(F, WS_WMQ), 1024, inp(I_NORM_MEM_G), tile, lane, RowId{}); continue; } r -= I_MQ;
        if (r < I_KV) { const int kb = r / 16, nb = r % 16; tr_tile(inp(I_W_MEM_KV), 1024, 64 * kb, 64 * nb, wsp<bf16>(F, WS_WKV), 1024, nullptr, tile, lane, RowId{}); continue; } r -= I_KV;
        if (r < I_MO) { const int kb = r / 16, nb = r % 16; tr_tile(inp(I_W_MEM_O), 1024, 64 * kb, 64 * nb, wsp<bf16>(F, WS_WMO), 512, nullptr, tile, lane, RowId{}); continue; } r -= I_MO;
        if (r < 2 * I_EX) {
            const int which = r / I_EX; const int q = r % I_EX; const int e = q / 256, kb = (q % 256) / 16, nb = q % 16;
            const float* W = (which ? inp(I_W_UP) : inp(I_W_GATE)) + (size_t)e * 1024 * 1024;
            tr_tile(W, 1024, 64 * kb, 64 * nb, wsp<bf16>(F, WS_WGU), 1024, norm_ffn_g, tile, lane, RowGateUp{e, which}); continue; }
        r -= 2 * I_EX;
        { const int e = r / 256, kb = (r % 256) / 16, nb = r % 16;
          tr_tile(inp(I_W_DOWN) + (size_t)e * 1024 * 1024, 1024, 64 * kb, 64 * nb, wsp<bf16>(F, WS_WD), 1024, nullptr, tile, lane, RowOff{e * 1024}); }
    }
}
__device__ __forceinline__ void prep_small(Frame& F) {
    const float* w_in = inp(I_W_IN); const float* norm_ffn_g = inp(I_NORM_FFN_G); const float* norm_mix_g = inp(I_NORM_MIX_G);
    {
        const int gt = F.bid * 512 + F.tid, NGT = F.G * 512; const float* w_router = inp(I_W_ROUTER);
        for (int it = gt; it < 2 * 16 * 128; it += NGT) {
            const int which = it >> 11, q = it & 2047, n = q >> 7, c = q & 127;
            float v[8];
#pragma unroll
            for (int j = 0; j < 8; ++j) { const int k = 8 * c + j; v[j] = which ? w_router[(size_t)k * 16 + n] * norm_ffn_g[k] : w_in[(size_t)k * INW + INW_G + n] * norm_mix_g[k]; }
            u32x4 hi; hi.x = pk2(v[0], v[1]); hi.y = pk2(v[2], v[3]); hi.z = pk2(v[4], v[5]); hi.w = pk2(v[6], v[7]);
            if (!which) *(u32x4*)(wsp<bf16>(F, WS_WG16) + n * 1024 + 8 * c) = hi;
            else {
                *(u32x4*)(wsp<bf16>(F, WS_WRHI) + n * 1024 + 8 * c) = hi;
                float l[8]; const unsigned hw[4] = {hi.x, hi.y, hi.z, hi.w};
#pragma unroll
                for (int j = 0; j < 8; ++j) l[j] = v[j] - ((j & 1) ? bfhi(hw[j >> 1]) : bflo(hw[j >> 1]));
                u32x4 lo; lo.x = pk2(l[0], l[1]); lo.y = pk2(l[2], l[3]); lo.z = pk2(l[4], l[5]); lo.w = pk2(l[6], l[7]);
                *(u32x4*)(wsp<bf16>(F, WS_WRLO) + n * 1024 + 8 * c) = lo;
            }
        }
    }
}
__device__ __forceinline__ void prep_rows(Frame& F) {
    const int gw = F.bid * 8 + F.wave, NGW = F.G * 8, lane = F.lane;
    { const float* x = inp(I_X); bf16* XB = wsp<bf16>(F, WS_XB); float* RX = wsp<float>(F, WS_RINVX);
    for (int m = 2 * gw; m < T; m += 2 * NGW) x_row2_to_bf16(x + (size_t)m * 1024, XB + (size_t)m * 1024, RX + m, lane); }
    { const float* mem = inp(I_MEM); const float* g = inp(I_MEM_KV_G);
    for (int m = gw; m < BATCH * MEMT; m += NGW) rms_row_to_bf16(mem + (size_t)m * 1024, g, wsp<bf16>(F, WS_MEMN) + (size_t)m * 1024, lane); }
}

__device__ __forceinline__ void phase_gates(Frame& F, int first_block) {
    const int gw = (F.bid - first_block) * 8 + F.wave, NGW = (F.G - first_block) * 8, lane = F.lane, r16 = lane & 15, kg = lane >> 4;
    if (F.bid < first_block) return;
    const bf16* XN = wsp<bf16>(F, WS_XB); const float* RX = wsp<float>(F, WS_RINVX); const bf16* WG = wsp<bf16>(F, WS_WG16) + r16 * 1024 + 8 * kg; float* GA = wsp<float>(F, WS_GATES);
    const float gb = inp(I_GATE_B)[r16];
    for (int task = gw; task < T / 16; task += NGW) {
        const bf16* a = XN + (size_t)(task * 16 + r16) * 1024 + 8 * kg;
        f32x4 acc = {0.f, 0.f, 0.f, 0.f};
#pragma unroll 8
        for (int s = 0; s < 32; ++s) { const bf16x8 av = *(const bf16x8*)(a + 32 * s), bv = *(const bf16x8*)(WG + 32 * s); acc = mfma16(av, bv, acc); }
#pragma unroll
        for (int r = 0; r < 4; ++r) GA[(size_t)(task * 16 + 4 * kg + r) * 16 + r16] = acc[r] * RX[task * 16 + 4 * kg + r] + gb;
    }
}
__device__ __forceinline__ void phase_router(Frame& F) {
    const int gw = F.bid * 8 + F.wave, NGW = F.G * 8, lane = F.lane, r16 = lane & 15, kg = lane >> 4;
    const bf16* WH = wsp<bf16>(F, WS_WRHI) + r16 * 1024 + 8 * kg; const bf16* WL = wsp<bf16>(F, WS_WRLO) + r16 * 1024 + 8 * kg;
    float* AFF = wsp<float>(F, WS_AFF); float* RINV2 = wsp<float>(F, WS_RINV2); const bf16* X2B = wsp<bf16>(F, WS_X2B);
    const float br = inp(I_B_ROUTER)[r16];
    for (int task = gw; task < T / 16; task += NGW) {
        const bf16* a = X2B + (size_t)(task * 16 + r16) * 1024 + 8 * kg;
        f32x4 acc = {0.f, 0.f, 0.f, 0.f}; float ss = 0.f;
#pragma unroll 8
        for (int s = 0; s < 32; ++s) {
            const u32x4 xw = *(const u32x4*)(a + 32 * s);
            const float x0 = bflo(xw.x), x1 = bfhi(xw.x), x2 = bflo(xw.y), x3 = bfhi(xw.y), x4 = bflo(xw.z), x5 = bfhi(xw.z), x6 = bflo(xw.w), x7 = bfhi(xw.w);
            ss += (x0 * x0 + x1 * x1) + (x2 * x2 + x3 * x3) + (x4 * x4 + x5 * x5) + (x6 * x6 + x7 * x7);
            const bf16x8 av = __builtin_bit_cast(bf16x8, xw);
            const bf16x8 bh = *(const bf16x8*)(WH + 32 * s), bl = *(const bf16x8*)(WL + 32 * s);
            acc = mfma16(av, bh, acc); acc = mfma16(av, bl, acc);
        }
        ss += __shfl_xor(ss, 16); ss += __shfl_xor(ss, 32);
        const float rinv = 1.0f / sqrtf(ss * (1.0f / 1024.0f) + EPS);
        if (kg == 0) RINV2[task * 16 + r16] = rinv;
        f32x4 p;
#pragma unroll
        for (int r = 0; r < 4; ++r) {
            const float rr = __shfl(rinv, 4 * kg + r);
            const float lg = acc[r] * rr + br;
            float mx = lg;
#pragma unroll
            for (int o = 1; o < 16; o <<= 1) mx = fmaxf(mx, __shfl_xor(mx, o));
            const float ex = __expf(lg - mx); float sm = ex;
#pragma unroll
            for (int o = 1; o < 16; o <<= 1) sm += __shfl_xor(sm, o);
            p[r] = ex / sm;
        }
        const int t0 = task * 16 + 4 * kg, b = t0 >> 13, s0 = t0 & 8191;
        *(f32x4*)(AFF + ((size_t)(b * 16 + r16) << 13) + s0) = p;
    }
}
template <int D> __device__ __forceinline__ f32x16 st_tile(const LAS unsigned char* kp, const bf16x8* qf) {
    f32x16 acc;
#pragma unroll
    for (int i = 0; i < 16; ++i) acc[i] = 0.f;
#pragma unroll
    for (int ks = 0; ks < D / 16; ++ks) acc = mfma32(*(const LAS bf16x8*)(kp + ks * 32), qf[ks], acc);
    return acc;
}
__device__ __forceinline__ bf16x8 pack8(const f32x16& p, int s) {
    u32x4 w; w.x = pk2(p[8 * s + 0], p[8 * s + 1]); w.y = pk2(p[8 * s + 2], p[8 * s + 3]); w.z = pk2(p[8 * s + 4], p[8 * s + 5]); w.w = pk2(p[8 * s + 6], p[8 * s + 7]);
    return __builtin_bit_cast(bf16x8, w);
}
__device__ __forceinline__ bf16x8 vt_frag(const LAS unsigned char* vp) {
    const u32x2 a = *(const LAS u32x2*)vp, b = *(const LAS u32x2*)(vp + 16);
    const u32x4 w = {a.x, a.y, b.x, b.y};
    return __builtin_bit_cast(bf16x8, w);
}

typedef short v4i16 __attribute__((ext_vector_type(4)));
__device__ __forceinline__ bf16x8 tr_pair(const LAS unsigned char* p, int second) {
    const v4i16 a = __builtin_amdgcn_ds_read_tr16_b64_v4i16((LAS v4i16*)p), b = __builtin_amdgcn_ds_read_tr16_b64_v4i16((LAS v4i16*)(p + second));
    return (bf16x8){a[0], a[1], a[2], a[3], b[0], b[1], b[2], b[3]};
}
__device__ __forceinline__ int vfrag_base(int lane, int rs) { const int i = lane & 15, g = lane >> 4; return (4 * (g >> 1) + (i >> 2)) * rs + (16 * (g & 1) + 4 * (i & 3)) * 2; }

constexpr int OST_BYTES = 32 * 72;
__device__ __forceinline__ void stage_store_32x32(LAS unsigned char* stg, const u32x2 (&w)[4], bf16* gbase, int ld, int lane) {
    const int r = lane & 31, h = lane >> 5;
#pragma unroll
    for (int rg = 0; rg < 4; ++rg) *(LAS u32x2*)(stg + r * 72 + (8 * rg + 4 * h) * 2) = w[rg];
    LDS_WAIT();
#pragma unroll
    for (int ps = 0; ps < 2; ++ps) { const int row = (lane >> 2) + 16 * ps, ch = lane & 3;
        const u32x2 a = *(const LAS u32x2*)(stg + row * 72 + ch * 16), b = *(const LAS u32x2*)(stg + row * 72 + ch * 16 + 8);
        const u32x4 v = {a.x, a.y, b.x, b.y};
        *(u32x4*)(gbase + (size_t)row * ld + ch * 8) = v; }
    LDS_WAIT();
}

constexpr int WA_KS = 144, WA_VS = 192;
constexpr int WA_K_OFF = 0, WA_V_OFF = 384 * WA_KS;
template <int KIND> __device__ __forceinline__ void wa_tile(f32x16 s, float rq, float nslope2, const float (&cs)[16], int dist0, float& m, float& l, f32x16 (&o)[2], const LAS unsigned char* vtile) {
    bf16x8 vf[2][2];
#pragma unroll
    for (int s2 = 0; s2 < 2; ++s2)
#pragma unroll
        for (int dt = 0; dt < 2; ++dt) vf[s2][dt] = tr_pair(vtile + 16 * s2 * WA_VS + dt * 64, 8 * WA_VS);
    const float b0 = nslope2 * (float)dist0;
    float tmax = -INFINITY;
#pragma unroll
    for (int reg = 0; reg < 16; ++reg) {
        const int off = (reg & 3) + 8 * (reg >> 2);
        float v;
        if (KIND == 0 || KIND == 1) v = __builtin_fmaf(s[reg], rq, b0) - cs[reg];
        else if (KIND == 3 || KIND == 4) v = __builtin_fmaf(s[reg], rq, -b0) + cs[reg];
        else { const int dist = dist0 - off; v = __builtin_fmaf(s[reg], rq, nslope2 * (float)(dist < 0 ? -dist : dist)); }
        if (KIND == 0) v = (dist0 - off <= 128) ? v : -INFINITY;
        if (KIND == 4) v = (dist0 - off >= -128) ? v : -INFINITY;
        s[reg] = v; tmax = fmaxf(tmax, v);
    }
    tmax = fmaxf(tmax, __shfl_xor(tmax, 32));
    if (__any(tmax > m + 8.0f)) {
        const float mn = fmaxf(m, tmax), f = __builtin_amdgcn_exp2f(m - mn);
        o[0] = o[0] * f; o[1] = o[1] * f; l *= f; m = mn;
    }
#pragma unroll
    for (int reg = 0; reg < 16; ++reg) { const float p = __builtin_amdgcn_exp2f(s[reg] - m); l += p; s[reg] = p; }
#pragma unroll
    for (int s2 = 0; s2 < 2; ++s2) {
        const bf16x8 pb = pack8(s, s2);
#pragma unroll
        for (int dt = 0; dt < 2; ++dt) o[dt] = mfma32(vf[s2][dt], pb, o[dt]);
    }
}
__device__ __forceinline__ void wattn_unit(Frame& F, int b, int qb, int kvh) {
    const int tid = F.tid, lane = F.lane, wave = F.wave, r = lane & 31, h = lane >> 5;
    LAS unsigned char* Ks = F.lds + WA_K_OFF; LAS unsigned char* VS = F.lds + WA_V_OFF;
    const bf16* AK = wsp<bf16>(F, WS_AK); const bf16* AV = wsp<bf16>(F, WS_AV); const bf16* AQ = wsp<bf16>(F, WS_AQ);
    const float* SSK = wsp<float>(F, WS_SSQAK); const float* SSQ = wsp<float>(F, WS_SSQAQ); bf16* MIX = wsp<bf16>(F, WS_MIX);
    const int kpos0 = qb * 128 - 128; const float* sinkp = inp(I_ATT_SINK);
    __syncthreads();
    {
        const int ch = tid & 7; float gs[8]; const float* akg = inp(I_ATT_K_G); const float* aqg = inp(I_ATT_Q_G);
#pragma unroll
        for (int j = 0; j < 8; ++j) gs[j] = akg[ch * 8 + j] * aqg[ch * 8 + j] * (0.125f * LOG2E);
        u32x4 kraw[6], vraw[6]; float s0[6], s1[6];
#pragma unroll
        for (int i = 0; i < 6; ++i) {
            const int key = (tid >> 3) + 64 * i, kp = kpos0 + key, kpc = kp < 0 ? 0 : (kp >= SEQ ? SEQ - 1 : kp); const size_t tok = (size_t)b * SEQ + kpc;
            kraw[i] = *(const u32x4*)(AK + tok * 128 + kvh * 64 + ch * 8); vraw[i] = *(const u32x4*)(AV + tok * 128 + kvh * 64 + ch * 8);
            s0[i] = SSK[(size_t)(2 * kvh) * T + tok]; s1[i] = SSK[(size_t)(2 * kvh + 1) * T + tok];
        }
#pragma unroll
        for (int i = 0; i < 6; ++i) {
            const int key = (tid >> 3) + 64 * i, kp = kpos0 + key; const bool ok = kp >= 0 && kp < SEQ;
            const float rk = ok ? 1.0f / sqrtf((s0[i] + s1[i]) * (1.0f / 64.0f) + EPS) : 0.f;
            const u32x4 raw = kraw[i]; u32x4 w;
            w.x = pk2(bflo(raw.x) * rk * gs[0], bfhi(raw.x) * rk * gs[1]); w.y = pk2(bflo(raw.y) * rk * gs[2], bfhi(raw.y) * rk * gs[3]);
            w.z = pk2(bflo(raw.z) * rk * gs[4], bfhi(raw.z) * rk * gs[5]); w.w = pk2(bflo(raw.w) * rk * gs[6], bfhi(raw.w) * rk * gs[7]);
            *(LAS u32x4*)(Ks + key * WA_KS + ch * 16) = w;
            u32x4 vv = vraw[i]; if (!ok) vv = (u32x4){0u, 0u, 0u, 0u};
            *(LAS u32x4*)(VS + key * WA_VS + ch * 16) = vv;
        }
    }
    __syncthreads();
    const int vb = vfrag_base(lane, WA_VS);
#pragma unroll 1
    for (int it = 0; it < 2; ++it) {
        const int id = wave * 2 + it, g = id >> 2, jq = id & 3, hq = kvh * 4 + g, qi = 32 * jq + r;
        const size_t tok = (size_t)b * SEQ + qb * 128 + qi;
        bf16x8 qf[4];
#pragma unroll
        for (int ks = 0; ks < 4; ++ks) qf[ks] = *(const bf16x8*)(AQ + tok * 512 + hq * 64 + 16 * ks + 8 * h);
        const float rq = 1.0f / sqrtf((SSQ[(size_t)(2 * hq) * T + tok] + SSQ[(size_t)(2 * hq + 1) * T + tok]) * (1.0f / 64.0f) + EPS);
        const float nslope2 = -__builtin_amdgcn_exp2f(-(float)(hq + 1)) * LOG2E, sink2 = sinkp[hq] * LOG2E;
        const LAS unsigned char* kp0 = Ks + r * WA_KS + h * 16;
        float m = sink2, l = 0.f;
        f32x16 o[2];
#pragma unroll
        for (int i = 0; i < 16; ++i) { o[0][i] = 0.f; o[1][i] = 0.f; }
        float cs[16];
#pragma unroll
        for (int reg = 0; reg < 16; ++reg) cs[reg] = nslope2 * (float)((reg & 3) + 8 * (reg >> 2));
        const int kt_lo = (qb == 0 && jq < 4) ? 4 : jq, kt_hi = (qb == 63 && jq + 8 > 7) ? 7 : jq + 8;
#pragma unroll 1
        for (int kt = kt_lo; kt <= kt_hi; ++kt) {
            const f32x16 s = st_tile<64>(kp0 + kt * 32 * WA_KS, qf);
            const int dist0 = qi + 128 - 32 * kt - 4 * h, rel = kt - jq;
            const LAS unsigned char* vtile = VS + vb + kt * 32 * WA_VS;
            if (rel == 0) wa_tile<0>(s, rq, nslope2, cs, dist0, m, l, o, vtile);
            else if (rel < 4) wa_tile<1>(s, rq, nslope2, cs, dist0, m, l, o, vtile);
            else if (rel == 4) wa_tile<2>(s, rq, nslope2, cs, dist0, m, l, o, vtile);
            else if (rel < 8) wa_tile<3>(s, rq, nslope2, cs, dist0, m, l, o, vtile);
            else wa_tile<4>(s, rq, nslope2, cs, dist0, m, l, o, vtile);
        }
        l += __shfl_xor(l, 32); l += __builtin_amdgcn_exp2f(sink2 - m);
        const float inv = __builtin_amdgcn_rcpf(l);
        bf16* obase = MIX + ((size_t)b * SEQ + qb * 128 + 32 * jq) * 1024 + hq * 64;
        LAS unsigned char* stg = F.lds + WA_V_OFF + 384 * WA_VS + wave * OST_BYTES;
#pragma unroll
        for (int dt = 0; dt < 2; ++dt) { u32x2 w[4];
#pragma unroll
            for (int rg = 0; rg < 4; ++rg) { w[rg].x = pk2(o[dt][4 * rg] * inv, o[dt][4 * rg + 1] * inv); w[rg].y = pk2(o[dt][4 * rg + 2] * inv, o[dt][4 * rg + 3] * inv); }
            stage_store_32x32(stg, w, obase + dt * 32, 1024, lane); }
    }
}

constexpr int XA_KS = 272, XA_VS = 520;
constexpr int XA_K_OFF = 0, XA_V_OFF = 256 * XA_KS;
__device__ __forceinline__ void xattn_phase(Frame& F) {
    const int tid = F.tid, lane = F.lane, wave = F.wave, r = lane & 31, h = lane >> 5;
    LAS unsigned char* Ks = F.lds + XA_K_OFF; LAS unsigned char* VT = F.lds + XA_V_OFF;
    const bf16* KVM = wsp<bf16>(F, WS_KVM); const float* SSK = wsp<float>(F, WS_SSQMK); const bf16* QM = wsp<bf16>(F, WS_QM); const float* SSQ = wsp<float>(F, WS_SSQQ);
    bf16* OM = wsp<bf16>(F, WS_OM);
    const int nunits = BATCH * 4 * 32;
    const int per = (nunits + F.G - 1) / F.G;
    int cur_bh = -1;
#pragma unroll 1
    for (int ui = 0; ui < per; ++ui) {
        const int u = F.bid * per + ui; if (u >= nunits) break;
        const int bh = u >> 5, qblk = u & 31, b = bh >> 2, hd = bh & 3;
        if (bh != cur_bh) {
            cur_bh = bh;
            __syncthreads();
            const int ch = tid & 15; float gs[8]; const float* mkg = inp(I_MEM_K_G); const float* mqg = inp(I_MEM_Q_G);
#pragma unroll
            for (int j = 0; j < 8; ++j) gs[j] = mkg[ch * 8 + j] * mqg[ch * 8 + j] * (0.08838834764831845f * LOG2E);
#pragma unroll
            for (int i = 0; i < 8; ++i) {
                const int key = (tid >> 4) + 32 * i; const size_t row = (size_t)b * MEMT + key;
                const u32x4 raw = *(const u32x4*)(KVM + row * 1024 + hd * 128 + ch * 8);
                const float* sp = SSK + (size_t)(hd * 4) * (BATCH * MEMT) + row;
                const float rk = 1.0f / sqrtf(((sp[0] + sp[BATCH * MEMT]) + (sp[2 * BATCH * MEMT] + sp[3 * BATCH * MEMT])) * (1.0f / 128.0f) + EPS);
                u32x4 w;
                w.x = pk2(bflo(raw.x) * rk * gs[0], bfhi(raw.x) * rk * gs[1]); w.y = pk2(bflo(raw.y) * rk * gs[2], bfhi(raw.y) * rk * gs[3]);
                w.z = pk2(bflo(raw.z) * rk * gs[4], bfhi(raw.z) * rk * gs[5]); w.w = pk2(bflo(raw.w) * rk * gs[6], bfhi(raw.w) * rk * gs[7]);
                *(LAS u32x4*)(Ks + key * XA_KS + ch * 16) = w;
            }
#pragma unroll
            for (int i = 0; i < 8; ++i) {
                const int idx = tid + 512 * i, key = idx & 255, vc = idx >> 8;
                const u32x4 raw = *(const u32x4*)(KVM + ((size_t)b * MEMT + key) * 1024 + 512 + hd * 128 + vc * 8);
                LAS unsigned short* vt = (LAS unsigned short*)(VT + (vc * 8) * XA_VS + key * 2);
                const unsigned rw[4] = {raw.x, raw.y, raw.z, raw.w};
#pragma unroll
                for (int j = 0; j < 8; ++j) vt[j * (XA_VS / 2)] = (unsigned short)((j & 1) ? (rw[j >> 1] >> 16) : (rw[j >> 1] & 0xffffu));
            }
            __syncthreads();
        }
        const size_t tok = (size_t)b * SEQ + qblk * 256 + wave * 32 + r;
        bf16x8 qf[8];
#pragma unroll
        for (int ks = 0; ks < 8; ++ks) qf[ks] = *(const bf16x8*)(QM + tok * 512 + hd * 128 + 16 * ks + 8 * h);
        const float* sp = SSQ + (size_t)(hd * 4) * T + tok;
        const float rq = 1.0f / sqrtf(((sp[0] + sp[T]) + (sp[2 * (size_t)T] + sp[3 * (size_t)T])) * (1.0f / 128.0f) + EPS);
        const LAS unsigned char* kp0 = Ks + r * XA_KS + h * 16;
        float m = -INFINITY, l = 0.f;
        f32x16 o[4];
#pragma unroll
        for (int i = 0; i < 16; ++i) { o[0][i] = 0.f; o[1][i] = 0.f; o[2][i] = 0.f; o[3][i] = 0.f; }
#pragma unroll 1
        for (int kt = 0; kt < 8; ++kt) {
            bf16x8 vf[2][4];
#pragma unroll
            for (int s2 = 0; s2 < 2; ++s2)
#pragma unroll
                for (int dt = 0; dt < 4; ++dt) vf[s2][dt] = vt_frag(VT + (dt * 32 + r) * XA_VS + (kt * 32 + 16 * s2 + 4 * h) * 2);
            f32x16 s = st_tile<128>(kp0 + kt * 32 * XA_KS, qf);
            float tmax = -INFINITY;
#pragma unroll
            for (int reg = 0; reg < 16; ++reg) { s[reg] *= rq; tmax = fmaxf(tmax, s[reg]); }
            tmax = fmaxf(tmax, __shfl_xor(tmax, 32));
            if (__any(tmax > m + 8.0f)) {
                const float mn = fmaxf(m, tmax), f = __builtin_amdgcn_exp2f(m - mn);
                o[0] = o[0] * f; o[1] = o[1] * f; o[2] = o[2] * f; o[3] = o[3] * f; l *= f; m = mn;
            }
#pragma unroll
            for (int reg = 0; reg < 16; ++reg) { const float p = __builtin_amdgcn_exp2f(s[reg] - m); l += p; s[reg] = p; }
#pragma unroll
            for (int s2 = 0; s2 < 2; ++s2) {
                const bf16x8 pb = pack8(s, s2);
#pragma unroll
                for (int dt = 0; dt < 4; ++dt) o[dt] = mfma32(vf[s2][dt], pb, o[dt]);
            }
        }
        l += __shfl_xor(l, 32);
        const float inv = __builtin_amdgcn_rcpf(l);
        bf16* obase = OM + ((size_t)b * SEQ + qblk * 256 + wave * 32) * 512 + hd * 128;
        LAS unsigned char* stg = F.lds + XA_V_OFF + 128 * XA_VS + wave * OST_BYTES;
#pragma unroll
        for (int dt = 0; dt < 4; ++dt) { u32x2 w[4];
#pragma unroll
            for (int rg = 0; rg < 4; ++rg) { w[rg].x = pk2(o[dt][4 * rg] * inv, o[dt][4 * rg + 1] * inv); w[rg].y = pk2(o[dt][4 * rg + 2] * inv, o[dt][4 * rg + 3] * inv); }
            stage_store_32x32(stg, w, obase + dt * 32, 512, lane); }
    }
}
__device__ __forceinline__ float logsig2(float f) { return (fminf(f, 0.f) - log1pf(expf(-fabsf(f)))) * LOG2E; }
__device__ __forceinline__ float wave_incl_scan(float v, int lane) {
#pragma unroll
    for (int o = 1; o < 64; o <<= 1) { const float t = __shfl_up(v, o); if (lane >= o) v += t; }
    return v;
}
__device__ __forceinline__ float silu_f(float x) { return x * __builtin_amdgcn_rcpf(1.0f + __builtin_amdgcn_exp2f(-x * LOG2E)); }
__device__ __forceinline__ float sigmoid_f(float x) { return __builtin_amdgcn_rcpf(1.0f + __builtin_amdgcn_exp2f(-x * LOG2E)); }

__device__ __forceinline__ void phase_conv(Frame& F) {
    const bf16* MQ = wsp<bf16>(F, WS_MQ); const bf16* MK = wsp<bf16>(F, WS_MK); bf16* QC = wsp<bf16>(F, WS_QC); bf16* KC = wsp<bf16>(F, WS_KC);
    const float* conv_w = inp(I_CONV_W); const float* conv_b = inp(I_CONV_B);
    const int gt = F.bid * 512 + F.tid, NGT = F.G * 512;
#pragma unroll 1
    for (int it = gt; it < (T / 4) * 128; it += NGT) {
        const int cc = it & 127, rg = it >> 7, tok0 = rg * 4, pos0 = tok0 & (SEQ - 1), which = cc >> 6, col = (cc & 63) * 8, ch = which * 512 + col;
        const bf16* src = (which ? MK : MQ) + col;
        u32x4 rw[6];
#pragma unroll
        for (int d = 0; d < 6; ++d) { const int pp = pos0 + d - 1; const bool ok = pp >= 0 && pp < SEQ; rw[d] = *(const u32x4*)(src + (size_t)(ok ? tok0 + d - 1 : tok0) * 512); if (!ok) rw[d] = (u32x4){0u, 0u, 0u, 0u}; }
        const f32x4 w0a = *(const f32x4*)(conv_w + ch), w0b = *(const f32x4*)(conv_w + ch + 4), w1a = *(const f32x4*)(conv_w + 1024 + ch), w1b = *(const f32x4*)(conv_w + 1024 + ch + 4);
        const f32x4 w2a = *(const f32x4*)(conv_w + 2048 + ch), w2b = *(const f32x4*)(conv_w + 2048 + ch + 4), bba = *(const f32x4*)(conv_b + ch), bbb = *(const f32x4*)(conv_b + ch + 4);
        const float sc = which ? 0.08838834764831845f : 1.0f;
        float y[4][8];
#pragma unroll
        for (int j = 0; j < 8; ++j) {
            const float w0 = j < 4 ? w0a[j & 3] : w0b[j & 3], w1 = j < 4 ? w1a[j & 3] : w1b[j & 3], w2 = j < 4 ? w2a[j & 3] : w2b[j & 3], bb = j < 4 ? bba[j & 3] : bbb[j & 3];
            float xv[6];
#pragma unroll
            for (int d = 0; d < 6; ++d) { const unsigned wd = (j >> 1) == 0 ? rw[d].x : (j >> 1) == 1 ? rw[d].y : (j >> 1) == 2 ? rw[d].z : rw[d].w; xv[d] = (j & 1) ? bfhi(wd) : bflo(wd); }
#pragma unroll
            for (int rr = 0; rr < 4; ++rr) y[rr][j] = silu_f(bb + w0 * xv[rr] + w1 * xv[rr + 1] + w2 * xv[rr + 2]) * sc;
        }
        bf16* dst = (which ? KC : QC) + col;
#pragma unroll
        for (int rr = 0; rr < 4; ++rr) { u32x4 w; w.x = pk2(y[rr][0], y[rr][1]); w.y = pk2(y[rr][2], y[rr][3]); w.z = pk2(y[rr][4], y[rr][5]); w.w = pk2(y[rr][6], y[rr][7]);
            *(u32x4*)(dst + (size_t)(tok0 + rr) * 512) = w; }
    }
}
__device__ __forceinline__ void phase_gatescan(Frame& F) {
    const int gw = F.bid * 8 + F.wave, NGW = F.G * 8, lane = F.lane;
    const float* GA = wsp<float>(F, WS_GATES); float* WST = wsp<float>(F, WS_WST); float* FTA = wsp<float>(F, WS_FTA); float* ESA = wsp<float>(F, WS_ESA); float* DEC = wsp<float>(F, WS_DEC);
#pragma unroll 1
    for (int task = gw; task < BATCH * 64 * 4 * 2; task += NGW) {
        const int dir = task & 1, hd = (task >> 1) & 3, bc = task >> 3; const size_t tok0 = (size_t)bc * 128;
        const float* g = GA + (tok0 + 2 * lane) * 16 + dir * 8 + hd;
        const float i0 = g[0] * LOG2E, i1 = g[16] * LOG2E, l0 = logsig2(g[4]), l1 = logsig2(g[20]);
        const float incl = wave_incl_scan(l0 + l1, lane), tot = __shfl(incl, 63);
        float F0, F1;
        if (!dir) { F1 = incl; F0 = incl - l1; } else { F0 = tot - incl + l0 + l1; F1 = tot - incl + l1; }
        const size_t o = (size_t)(dir * 4 + hd) * T + tok0 + 2 * lane;
        *(f32x2*)(FTA + o) = (f32x2){F0, F1}; *(f32x2*)(ESA + o) = (f32x2){i0 - F0, i1 - F1};
        *(f32x2*)(WST + o) = (f32x2){__builtin_amdgcn_exp2f(tot - F0 + i0), __builtin_amdgcn_exp2f(tot - F1 + i1)};
        if (lane == 0) DEC[task] = __builtin_amdgcn_exp2f(tot);
    }
}

constexpr int MS_KW_STRIDE = 96, MS_VT_STRIDE = 288;
constexpr int MS_KW_BYTES = 128 * MS_KW_STRIDE, MS_VT_BYTES = 128 * MS_VT_STRIDE, MS_BUF = MS_KW_BYTES + MS_VT_BYTES;
__device__ __forceinline__ void mlstm_state_unit(Frame& F, int u) {
    const int tid = F.tid, lane = F.lane, wave = F.wave;
    const int ksl = u & 3, dir = (u >> 2) & 1, hd = (u >> 3) & 3, b = u >> 5;
    const bf16* KC = wsp<bf16>(F, WS_KC); const bf16* MV = wsp<bf16>(F, WS_MV); const float* WST = wsp<float>(F, WS_WST); const float* DEC = wsp<float>(F, WS_DEC);
    bf16* C0 = wsp<bf16>(F, WS_C0); float* N0 = wsp<float>(F, WS_N0);
    const int krow = tid >> 2, kch = tid & 3, kcol = hd * 128 + ksl * 32 + kch * 8;
    f32x4 acc[2], nacc[2];
#pragma unroll
    for (int i = 0; i < 2; ++i) { acc[i] = (f32x4){0.f, 0.f, 0.f, 0.f}; nacc[i] = (f32x4){0.f, 0.f, 0.f, 0.f}; }
    const bf16x8 ones = {0x3F80, 0x3F80, 0x3F80, 0x3F80, 0x3F80, 0x3F80, 0x3F80, 0x3F80};
    const int tg = lane >> 4, ti = lane & 15, tq = ti >> 2, tp = ti & 3;
    const int aoff = (8 * tg + tq) * MS_KW_STRIDE + (4 * tp) * 2, boff = (8 * tg + tq) * MS_VT_STRIDE + (16 * wave + 4 * tp) * 2;
    u32x4 krA, vrA[4], krB, vrB[4]; float wA, wB, dA, dB;
#define MS_LOAD(kr, vr, wv, dv, c) do { const size_t tok0_ = (size_t)b * SEQ + (c) * 128; \
        kr = *(const u32x4*)(KC + (tok0_ + krow) * 512 + kcol); wv = WST[(size_t)(dir * 4 + hd) * T + tok0_ + krow]; dv = DEC[((((size_t)b * 64 + (c)) * 4 + hd) * 2) + dir]; \
        _Pragma("unroll") for (int i_ = 0; i_ < 4; ++i_) { const int idx_ = tid + 512 * i_; vr[i_] = *(const u32x4*)(MV + (tok0_ + (idx_ >> 4)) * 512 + hd * 128 + (idx_ & 15) * 8); } } while (0)
#define MS_STEP(kr, vr, wv, dv, ci) do { \
        const int c = dir ? 63 - (ci) : (ci), buf = (ci) & 1; \
        LAS unsigned char* KW = F.lds + buf * MS_BUF; LAS unsigned char* VT = KW + MS_KW_BYTES; \
        const float dec = dv; \
        { u32x4 w_; w_.x = pk2(bflo(kr.x) * wv, bfhi(kr.x) * wv); w_.y = pk2(bflo(kr.y) * wv, bfhi(kr.y) * wv); w_.z = pk2(bflo(kr.z) * wv, bfhi(kr.z) * wv); w_.w = pk2(bflo(kr.w) * wv, bfhi(kr.w) * wv); \
          *(LAS u32x4*)(KW + krow * MS_KW_STRIDE + kch * 16) = w_; \
          _Pragma("unroll") for (int i = 0; i < 4; ++i) { const int idx = tid + 512 * i; *(LAS u32x4*)(VT + (idx >> 4) * MS_VT_STRIDE + (idx & 15) * 16) = vr[i]; } } \
        if ((ci) + 2 < 64) MS_LOAD(kr, vr, wv, dv, dir ? 61 - (ci) : (ci) + 2);     \
        __syncthreads(); \
        {   \
            const size_t unit4 = (((size_t)b * 64 + c) * 4 + hd) * 2 + dir; \
            bf16* cdst = C0 + unit4 * 16384 + ksl * 4096 + (16 * wave + (lane & 15)) * 32 + 4 * (lane >> 4); \
            _Pragma("unroll") for (int kt = 0; kt < 2; ++kt) { u32x2 w; w.x = pk2(acc[kt][0], acc[kt][1]); w.y = pk2(acc[kt][2], acc[kt][3]); *(u32x2*)(cdst + 16 * kt) = w; } \
            if (wave == 0 && (lane & 15) == 0) { \
                _Pragma("unroll") for (int kt = 0; kt < 2; ++kt) *(f32x4*)(N0 + unit4 * 128 + ksl * 32 + 16 * kt + 4 * (lane >> 4)) = nacc[kt]; } \
        } \
        _Pragma("unroll") for (int kt = 0; kt < 2; ++kt) { acc[kt] = acc[kt] * dec; nacc[kt] = nacc[kt] * dec; } \
        _Pragma("unroll") for (int ks = 0; ks < 4; ++ks) { \
            const bf16x8 bv = tr_pair(VT + boff + 32 * ks * MS_VT_STRIDE, 4 * MS_VT_STRIDE); \
            _Pragma("unroll") for (int kt = 0; kt < 2; ++kt) { \
                const bf16x8 av = tr_pair(KW + aoff + 32 * ks * MS_KW_STRIDE + 32 * kt, 4 * MS_KW_STRIDE); \
                acc[kt] = mfma16(av, bv, acc[kt]); nacc[kt] = mfma16(av, ones, nacc[kt]); } } \
    } while (0)
    MS_LOAD(krA, vrA, wA, dA, dir ? 63 : 0);
    MS_LOAD(krB, vrB, wB, dB, dir ? 62 : 1);
    __syncthreads();
#pragma unroll 1
    for (int ci = 0; ci < 64; ci += 2) {
        MS_STEP(krA, vrA, wA, dA, ci);
        MS_STEP(krB, vrB, wB, dB, ci + 1);
    }
#undef MS_STEP
#undef MS_LOAD
}

constexpr int MO_KS = 0, MO_VS = 34816, MO_C0 = 71680, MO_FT = 141312, MO_ES = 142336, MO_N0 = 143360, MO_XS = 144384, MO_OG = 145408;
__device__ __forceinline__ void mlstm_out_unit(Frame& F, int u) {
    const int tid = F.tid, lane = F.lane, wave = F.wave, r = lane & 31, hh = lane >> 5;
    const int hd = u & 3, c = (u >> 2) & 63, b = u >> 8;
    const size_t tok0 = (size_t)b * SEQ + c * 128;
    const bf16* MV = wsp<bf16>(F, WS_MV); const bf16* MOg = wsp<bf16>(F, WS_MO);
    const bf16* C0 = wsp<bf16>(F, WS_C0); const float* N0 = wsp<float>(F, WS_N0); bf16* MIX = wsp<bf16>(F, WS_MIX);
    LAS unsigned char* L = F.lds;
    LAS float* FT = (LAS float*)(L + MO_FT); LAS float* ES = (LAS float*)(L + MO_ES); LAS float* N0s = (LAS float*)(L + MO_N0); LAS float* XS = (LAS float*)(L + MO_XS); LAS float* OG = (LAS float*)(L + MO_OG);
    const size_t unit4 = (((size_t)b * 64 + c) * 4 + hd) * 2;
    const int tt = wave & 3, vh = wave >> 2, t = 32 * tt + r;
    bf16x8 qf[8];
    {
    __syncthreads();
    u32x4 kst[4], vst[4], cst[8];
    {
        const bf16* KC = wsp<bf16>(F, WS_KC);
#pragma unroll
        for (int i = 0; i < 4; ++i) { const int idx = tid + 512 * i, row = idx >> 4, ch = idx & 15;
            kst[i] = *(const u32x4*)(KC + (tok0 + row) * 512 + hd * 128 + ch * 8); vst[i] = *(const u32x4*)(MV + (tok0 + row) * 512 + hd * 128 + ch * 8); }
#pragma unroll
        for (int i = 0; i < 8; ++i) cst[i] = *(const u32x4*)(C0 + unit4 * 16384 + (size_t)(tid + 512 * i) * 8);
    }
    float ftv = 0.f, esv = 0.f, n0v = 0.f;
    if (tid < 256) { const int dir = tid >> 7, pos = tid & 127; const size_t o = (size_t)(dir * 4 + hd) * T + tok0 + pos;
        ftv = wsp<float>(F, WS_FTA)[o]; esv = wsp<float>(F, WS_ESA)[o]; n0v = N0[(unit4 + dir) * 128 + pos]; }
#pragma unroll
    for (int ks = 0; ks < 8; ++ks) qf[ks] = *(const bf16x8*)(wsp<bf16>(F, WS_QC) + (tok0 + t) * 512 + hd * 128 + 16 * ks + 8 * hh);
#pragma unroll
    for (int i = 0; i < 4; ++i) { const int idx = tid + 512 * i, row = idx >> 4, ch = idx & 15;
        *(LAS u32x4*)(L + MO_KS + row * 272 + ch * 16) = kst[i]; *(LAS u32x4*)(L + MO_VS + row * 288 + ch * 16) = vst[i]; }
#pragma unroll
    for (int i = 0; i < 8; ++i) { const int cidx = tid + 512 * i, dir = cidx >> 11, ksl = (cidx >> 9) & 3, v = (cidx >> 2) & 127, kq = cidx & 3;
        *(LAS u32x4*)(L + MO_C0 + dir * 34816 + v * 272 + (ksl * 32 + kq * 8) * 2) = cst[i]; }
    if (tid >= 384) OG[tid - 384] = inp(I_ML_OUT_G)[hd * 128 + tid - 384];
    if (tid < 256) { FT[tid] = ftv; ES[tid] = esv; ((LAS unsigned short*)N0s)[tid] = (unsigned short)pk2(n0v, 0.f); }
    __syncthreads();
    }
    const int vb = vfrag_base(lane, 288);
    f32x16 hs[2];
    {
#pragma unroll
    for (int i = 0; i < 16; ++i) { hs[0][i] = 0.f; hs[1][i] = 0.f; }
#pragma unroll 1
    for (int dir = 0; dir < 2; ++dir) {
        const float Ft = FT[dir * 128 + t], at = __builtin_amdgcn_exp2f(Ft);
        float qn;
        { f32x16 qa;
#pragma unroll
          for (int i = 0; i < 16; ++i) qa[i] = 0.f;
#pragma unroll
          for (int ks = 0; ks < 8; ++ks) qa = mfma32(*(const LAS bf16x8*)((const LAS unsigned char*)N0s + dir * 256 + (16 * ks + 8 * hh) * 2), qf[ks], qa);
          qn = qa[0]; }
        f32x16 num[2];
        const LAS unsigned char* c0 = L + MO_C0 + dir * 34816 + (64 * vh + r) * 272 + 16 * hh;
#pragma unroll
        for (int vt = 0; vt < 2; ++vt) {
#pragma unroll
            for (int i = 0; i < 16; ++i) num[vt][i] = 0.f;
#pragma unroll
            for (int ks = 0; ks < 8; ++ks) num[vt] = mfma32(*(const LAS bf16x8*)(c0 + vt * 32 * 272 + 32 * ks), qf[ks], num[vt]);
            num[vt] = num[vt] * at;
        }
        float rowsum = 0.f;
        const int st_lo = dir ? tt : 0, st_hi = dir ? 3 : tt;
#pragma unroll 1
        for (int st = st_lo; st <= st_hi; ++st) {
            f32x16 pm = st_tile<128>(L + MO_KS + (32 * st + r) * 272 + hh * 16, qf);
            if (st == tt) {
#pragma unroll
                for (int rg = 0; rg < 4; ++rg) {
                    const int s0 = 32 * st + 8 * rg + 4 * hh;
                    const f32x4 es = *(const LAS f32x4*)(ES + dir * 128 + s0);
#pragma unroll
                    for (int e = 0; e < 4; ++e) {
                        const int s = s0 + e; const bool ok = dir ? (s >= t) : (s <= t);
                        const float pv = ok ? pm[4 * rg + e] * __builtin_amdgcn_exp2f(Ft + es[e]) : 0.f;
                        pm[4 * rg + e] = pv; rowsum += pv;
                    }
                }
            } else {
#pragma unroll
                for (int rg = 0; rg < 4; ++rg) {
                    const f32x4 es = *(const LAS f32x4*)(ES + dir * 128 + 32 * st + 8 * rg + 4 * hh);
#pragma unroll
                    for (int e = 0; e < 4; ++e) { const float pv = pm[4 * rg + e] * __builtin_amdgcn_exp2f(Ft + es[e]); pm[4 * rg + e] = pv; rowsum += pv; }
                }
            }
#pragma unroll
            for (int s2 = 0; s2 < 2; ++s2) {
                const bf16x8 pb = pack8(pm, s2);
#pragma unroll
                for (int vt = 0; vt < 2; ++vt) num[vt] = mfma32(tr_pair(L + MO_VS + vb + (32 * st + 16 * s2) * 288 + (64 * vh + 32 * vt) * 2, 8 * 288), pb, num[vt]);
            }
        }
        rowsum += __shfl_xor(rowsum, 32);
        const float den = at * qn + rowsum, dinv = 1.0f / fmaxf(fabsf(den), 1.0f);
        hs[0] = hs[0] + num[0] * dinv; hs[1] = hs[1] + num[1] * dinv;
    }
    }
    {
    const size_t tok = tok0 + t;
    u32x2 mw[8];
#pragma unroll
    for (int i = 0; i < 8; ++i) mw[i] = *(const u32x2*)(MOg + tok * 512 + hd * 128 + 64 * vh + 32 * (i >> 2) + 8 * (i & 3) + 4 * hh);
    float ss = 0.f;
#pragma unroll
    for (int i = 0; i < 16; ++i) ss += hs[0][i] * hs[0][i] + hs[1][i] * hs[1][i];
    ss += __shfl_xor(ss, 32);
    if (hh == 0) XS[wave * 32 + r] = ss;
    __syncthreads();
    const float rinv = 1.0f / sqrtf((ss + XS[(wave ^ 4) * 32 + r]) * (1.0f / 128.0f) + EPS);
    LAS unsigned char* stg = L + MO_KS + wave * OST_BYTES;
    bf16* obase = MIX + (tok0 + 32 * tt) * 1024 + 512 + hd * 128 + 64 * vh;
#pragma unroll
    for (int vt = 0; vt < 2; ++vt) { u32x2 ow[4];
#pragma unroll
        for (int rg = 0; rg < 4; ++rg) {
            const int v = 64 * vh + 32 * vt + 8 * rg + 4 * hh;
            const f32x4 og = *(const LAS f32x4*)(OG + v);
            const u32x2 m_ = mw[vt * 4 + rg];
            const float m0 = bflo(m_.x), m1 = bfhi(m_.x), m2 = bflo(m_.y), m3 = bfhi(m_.y);
            const float o0 = hs[vt][4 * rg] * rinv * og[0] * sigmoid_f(m0), o1 = hs[vt][4 * rg + 1] * rinv * og[1] * sigmoid_f(m1);
            const float o2 = hs[vt][4 * rg + 2] * rinv * og[2] * sigmoid_f(m2), o3 = hs[vt][4 * rg + 3] * rinv * og[3] * sigmoid_f(m3);
            ow[rg].x = pk2(o0, o1); ow[rg].y = pk2(o2, o3);
        }
        stage_store_32x32(stg, ow, obase + 32 * vt, 1024, lane); }
    }
}
constexpr int SEL_VALS = 0, SEL_HIST = 32768, SEL_MISC = 32768 + 1024, SEL_WSUM = SEL_MISC + 64;
__device__ __forceinline__ void select_unit(Frame& F, int u) {
    const int tid = F.tid, lane = F.lane, wave = F.wave;
    LAS unsigned* vals = (LAS unsigned*)(F.lds + SEL_VALS); LAS unsigned* hist = (LAS unsigned*)(F.lds + SEL_HIST); LAS unsigned* misc = (LAS unsigned*)(F.lds + SEL_MISC); LAS unsigned* wsum = (LAS unsigned*)(F.lds + SEL_WSUM);
    const float* AFF = wsp<float>(F, WS_AFF) + (size_t)u * SEQ;
    int* IDX = wsp<int>(F, WS_IDX) + (size_t)u * CAP; float* GV = wsp<float>(F, WS_GVAL) + (size_t)u * CAP; int* SLOT = wsp<int>(F, WS_SLOT);
    float* RE = wsp<float>(F, WS_RINVE) + (size_t)u * CAP; const float* RINV2 = wsp<float>(F, WS_RINV2) + (size_t)(u >> 4) * SEQ;
    const int b = u >> 4, e = u & 15;
    __syncthreads();
    unsigned mine[16];
#pragma unroll
    for (int i = 0; i < 4; ++i) { const u32x4 v = *(const u32x4*)(AFF + 16 * tid + 4 * i); mine[4 * i] = v.x; mine[4 * i + 1] = v.y; mine[4 * i + 2] = v.z; mine[4 * i + 3] = v.w; }
    unsigned prefix = 0u, mask = 0u, kk = CAP;
#pragma unroll 1
    for (int pass = 0; pass < 4; ++pass) {
        const int shift = 24 - 8 * pass;
        if (tid < 256) hist[tid] = 0u;
        __syncthreads();
#pragma unroll
        for (int i = 0; i < 16; ++i) if ((mine[i] & mask) == prefix) __hip_atomic_fetch_add(&hist[(mine[i] >> shift) & 255u], 1u, __ATOMIC_RELAXED, __HIP_MEMORY_SCOPE_WORKGROUP);
        __syncthreads();
        if (wave == 0) {
            const unsigned h0 = hist[4 * lane], h1 = hist[4 * lane + 1], h2 = hist[4 * lane + 2], h3 = hist[4 * lane + 3];
            const unsigned ls = h0 + h1 + h2 + h3;
            unsigned incl = ls;
#pragma unroll
            for (int o = 1; o < 64; o <<= 1) { const unsigned t = __shfl_down(incl, o); if (lane + o < 64) incl += t; }
            const unsigned above = incl - ls;
            const unsigned a3 = above, a2 = above + h3, a1 = a2 + h2, a0 = a1 + h1;
            int d = -1; unsigned ab = 0u;
            if (a3 < kk && kk <= a3 + h3) { d = 4 * lane + 3; ab = a3; }
            else if (a2 < kk && kk <= a2 + h2) { d = 4 * lane + 2; ab = a2; }
            else if (a1 < kk && kk <= a1 + h1) { d = 4 * lane + 1; ab = a1; }
            else if (a0 < kk && kk <= a0 + h0) { d = 4 * lane; ab = a0; }
            if (d >= 0) { misc[0] = (unsigned)d; misc[1] = ab; }
        }
        __syncthreads();
        prefix |= misc[0] << shift; mask |= 255u << shift; kk -= misc[1];
    }
    unsigned cg = 0u, ce = 0u;
#pragma unroll
    for (int i = 0; i < 16; ++i) { cg += mine[i] > prefix ? 1u : 0u; ce += mine[i] == prefix ? 1u : 0u; }
    unsigned pk = cg | (ce << 16), incl = pk;
#pragma unroll
    for (int o = 1; o < 64; o <<= 1) { const unsigned t = __shfl_up(incl, o); if (lane >= o) incl += t; }
    if (lane == 63) wsum[wave] = incl;
    __syncthreads();
    unsigned base = 0u;
#pragma unroll
    for (int w = 0; w < 8; ++w) if (w < wave) base += wsum[w];
    unsigned excl = base + incl - pk;
    unsigned ng = excl & 0xffffu, ne = excl >> 16;
    const unsigned ngt_total = CAP - kk;
#pragma unroll
    for (int i = 0; i < 16; ++i) {
        const int s = 16 * tid + i; int slot = -1;
        if (mine[i] > prefix) { slot = (int)ng; ++ng; }
        else if (mine[i] == prefix) { if (ne < kk) slot = (int)(ngt_total + ne); ++ne; }
        if (slot >= 0) { IDX[slot] = s; GV[slot] = __builtin_bit_cast(float, mine[i]); RE[slot] = RINV2[s]; }
        SLOT[(size_t)u * SEQ + s] = slot;
    }
}
__device__ __forceinline__ void phase_gather(Frame& F) {
    const int gw = F.bid * 8 + F.wave, NGW = F.G * 8, lane = F.lane;
    const int* IDX = wsp<int>(F, WS_IDX); const bf16* X2B = wsp<bf16>(F, WS_X2B); bf16* XE = wsp<bf16>(F, WS_XE); const float* RINV2 = wsp<float>(F, WS_RINV2); float* RE = wsp<float>(F, WS_RINVE);
    for (int row = gw; row < XROWS; row += NGW) {
        const int b = row >> 14; const size_t tok = (size_t)b * SEQ + IDX[row];
        const u32x4* src = (const u32x4*)(X2B + tok * 1024) + lane; u32x4* dst = (u32x4*)(XE + (size_t)row * 1024) + lane;
        const u32x4 v0 = src[0], v1 = src[64];
        dst[0] = v0; dst[64] = v1;
        if (lane == 0) RE[row] = RINV2[tok];
    }
}
__device__ __forceinline__ void phase_combine(Frame& F) {
    const int gw = F.bid * 8 + F.wave, NGW = F.G * 8, lane = F.lane;
    const int* SLOT = wsp<int>(F, WS_SLOT); const bf16* Y = wsp<bf16>(F, WS_Y); const bf16* X2B = wsp<bf16>(F, WS_X2B);
    for (int grp = gw; grp < T / 8; grp += NGW) {
        const int tok0 = grp * 8, b = tok0 >> 13, s0 = tok0 & (SEQ - 1);
        const u32x2 sl = *(const u32x2*)(SLOT + ((size_t)(b * 16 + (lane & 15)) * SEQ + s0 + 2 * (lane >> 4)));
#pragma unroll
        for (int jj = 0; jj < 8; ++jj) {
            const int tok = tok0 + jj;
            const int mys = (jj & 1) ? (int)sl.y : (int)sl.x;
            const u32x4* xr = (const u32x4*)(X2B + (size_t)tok * 1024) + 2 * lane;
            const u32x4 x0 = xr[0], x1 = xr[1];
            f32x4 a0 = {bflo(x0.x), bfhi(x0.x), bflo(x0.y), bfhi(x0.y)}, a1 = {bflo(x0.z), bfhi(x0.z), bflo(x0.w), bfhi(x0.w)};
            f32x4 a2 = {bflo(x1.x), bfhi(x1.x), bflo(x1.y), bfhi(x1.y)}, a3 = {bflo(x1.z), bfhi(x1.z), bflo(x1.w), bfhi(x1.w)};
#pragma unroll 1
            for (int e = 0; e < 16; ++e) {
                const int slot = __shfl(mys, e + 16 * (jj >> 1));
                if (slot >= 0) {
                    const u32x4* y = (const u32x4*)(Y + ((size_t)(b * 16 + e) * CAP + slot) * 1024) + 2 * lane;
                    const u32x4 y0 = y[0], y1 = y[1];
                    a0[0] += bflo(y0.x); a0[1] += bfhi(y0.x); a0[2] += bflo(y0.y); a0[3] += bfhi(y0.y);
                    a1[0] += bflo(y0.z); a1[1] += bfhi(y0.z); a1[2] += bflo(y0.w); a1[3] += bfhi(y0.w);
                    a2[0] += bflo(y1.x); a2[1] += bfhi(y1.x); a2[2] += bflo(y1.y); a2[3] += bfhi(y1.y);
                    a3[0] += bflo(y1.z); a3[1] += bfhi(y1.z); a3[2] += bflo(y1.w); a3[3] += bfhi(y1.w);
                }
            }
            f32x4* o = (f32x4*)(F.out + (size_t)tok * 1024) + 4 * lane;
            o[0] = a0; o[1] = a1; o[2] = a2; o[3] = a3;
        }
    }
}
struct Args { const float* in[25]; float* out; unsigned char* ws; };
constexpr int MISC_OFF = LDS_BYTES - 64;
constexpr int CW_BAR = 4096;
__global__ void __launch_bounds__(512, 2) hymba_fwd(Args args) {
    extern __shared__ __attribute__((aligned(16))) unsigned char lds_raw[];
    cg::grid_group grid = cg::this_grid();
    Frame F;
    F.lds = (LAS unsigned char*)lds_raw;
    F.tid = threadIdx.x; F.lane = F.tid & 63; F.wave = __builtin_amdgcn_readfirstlane(F.tid >> 6); F.bid = blockIdx.x; F.G = gridDim.x;
    F.out = args.out; F.ws = args.ws;
    const int G = F.G, bid = F.bid;
    if (F.tid < 16) ((LAS unsigned*)(F.lds + MISC_OFF))[F.tid] = 0u;
    __syncthreads();
    if (bid == 0) for (int i = F.tid; i < XCD_BAR_WORDS; i += 512) ((unsigned*)(F.ws + WS_CTL) + CW_BAR)[i] = 0u;
#define GSYNC() xcd_barrier(xbar)
#define LAUNDER() do { asm volatile("" : "+v"(F.tid)); F.lane = F.tid & 63; } while (0)

    LAUNDER(); prep_weights(F);
    LAUNDER(); prep_small(F);
    LAUNDER(); prep_rows(F);
    grid.sync();
    const XcdBarrier xbar = xcd_barrier_post((unsigned*)(F.ws + WS_CTL) + CW_BAR, (volatile LAS unsigned*)(F.lds + MISC_OFF));
    LAUNDER(); phase_gates(F, G > 64 ? 32 : 0);
    LAUNDER(); {
        pg8::Gemm g{wsp<bf16>(F, WS_MEMN), wsp<bf16>(F, WS_WKV), BATCH * MEMT, 1024, 1024}; pg8::StaticOrder S; S.init(BATCH * MEMT, 1024, G, bid);
        pg8::EpiHead128<false> E{wsp<bf16>(F, WS_KVM), 1024, nullptr, wsp<float>(F, WS_SSQMK), 2, BATCH * MEMT};
        pg8::gemm_phase<pg8::EpiHead128<false>, pg8::StaticOrder, true, true>(F.lds, g, S, E);
    }
    LAUNDER(); {
        pg8::Gemm g{wsp<bf16>(F, WS_XB), wsp<bf16>(F, WS_WIN), T, INW_G, 1024}; pg8::StaticOrder S; S.init(T, INW_G, G, bid);
        pg8::EpiInProj E{F.ws};
        pg8::gemm_phase<pg8::EpiInProj, pg8::StaticOrder, true, true>(F.lds, g, S, E);
    }
    GSYNC();
    LAUNDER(); phase_conv(F);
    LAUNDER(); phase_gatescan(F);
    LAUNDER(); for (int u = bid; u < BATCH * 64 * 2; u += G) { const int kvh = u & 1, qb = (u >> 1) & 63, b = u >> 7; wattn_unit(F, b, qb, kvh); }
    GSYNC();
    LAUNDER(); for (int v = bid; v < BATCH * 4 * 2 * 4; v += G) { const int u = (((v >> 5) << 3 | (v & 7)) << 2) | ((v >> 3) & 3); mlstm_state_unit(F, u); }
    GSYNC();
    LAUNDER(); for (int u = bid; u < BATCH * 64 * 4; u += G) mlstm_out_unit(F, u);
    GSYNC();
    LAUNDER(); {
        pg8::Gemm g{wsp<bf16>(F, WS_MIX), wsp<bf16>(F, WS_WOUT), T, 1024, 1024}; pg8::StaticOrder S; S.init(T, 1024, G, bid);
        pg8::EpiResid<true> E{wsp<bf16>(F, WS_XB), wsp<bf16>(F, WS_X1B), wsp<float>(F, WS_SSQ1)};
        pg8::gemm_phase<pg8::EpiResid<true>, pg8::StaticOrder, true, true>(F.lds, g, S, E);
    }
    GSYNC();
    LAUNDER(); {
        pg8::Gemm g{wsp<bf16>(F, WS_X1B), wsp<bf16>(F, WS_WMQ), T, 512, 1024}; pg8::StaticOrder S; S.init(T, 512, G, bid);
        pg8::EpiHead128<true> E{wsp<bf16>(F, WS_QM), 512, wsp<float>(F, WS_SSQ1), wsp<float>(F, WS_SSQQ), 2, T};
        pg8::gemm_phase<pg8::EpiHead128<true>, pg8::StaticOrder, true, true>(F.lds, g, S, E);
    }
    GSYNC();
    LAUNDER(); xattn_phase(F);
    GSYNC();
    {
        pg8::Gemm g{wsp<bf16>(F, WS_OM), wsp<bf16>(F, WS_WMO), T, 1024, 512}; pg8::StaticOrder S; S.init(T, 1024, G, bid);
        pg8::EpiResid<true> E{wsp<bf16>(F, WS_X1B), wsp<bf16>(F, WS_X2B), nullptr};
        pg8::gemm_phase<pg8::EpiResid<true>, pg8::StaticOrder, true, true>(F.lds, g, S, E);
    }
    GSYNC();
    LAUNDER(); phase_router(F);
    GSYNC();
    LAUNDER(); for (int u = bid; u < BATCH * NEXP; u += G) select_unit(F, u);
    GSYNC();
    LAUNDER(); {
        pg8::Gemm g{wsp<bf16>(F, WS_X2B), wsp<bf16>(F, WS_WGU), XROWS, NEXP * 2048, 1024}; pg8::ExpertOrder<8> S{G, bid};
        pg8::EpiGateUp E{wsp<bf16>(F, WS_HID), wsp<float>(F, WS_RINVE)};
        pg8::gemm_phase<pg8::EpiGateUp, pg8::ExpertOrder<8>, true, true, true>(F.lds, g, S, E, wsp<int>(F, WS_IDX));
    }
    GSYNC();
    LAUNDER(); {
        pg8::Gemm g{wsp<bf16>(F, WS_HID), wsp<bf16>(F, WS_WD), XROWS, NEXP * 1024, 1024}; pg8::ExpertOrder<4> S{G, bid};
        pg8::EpiDown E{wsp<bf16>(F, WS_Y), wsp<float>(F, WS_GVAL)};
        pg8::gemm_phase<pg8::EpiDown, pg8::ExpertOrder<4>, true, true>(F.lds, g, S, E);
    }
    GSYNC();
    LAUNDER(); phase_combine(F);
}

extern "C" void kernel_launch(void* const* d_in, const int* in_sizes, int n_in, void* d_out, int out_size, void* d_ws, size_t ws_size, hipStream_t stream) {
    static int grid = 0;
    if (grid == 0) {
        if (n_in != 25 || in_sizes[0] != T * DM || out_size != T * DM || ws_size < WS_END) { fprintf(stderr, "kernel_launch: unexpected shapes (n_in %d, in0 %d, out %d, ws %zu); nothing launched\n", n_in, n_in > 0 ? in_sizes[0] : -1, out_size, ws_size); grid = -1; return; }
        int dev = 0, cus = 0, per_cu = 0;
        if (hipGetDevice(&dev) != hipSuccess || hipDeviceGetAttribute(&cus, hipDeviceAttributeMultiprocessorCount, dev) != hipSuccess) { grid = -1; return; }
        if (hipFuncSetAttribute((const void*)hymba_fwd, hipFuncAttributeMaxDynamicSharedMemorySize, LDS_BYTES) != hipSuccess) { fprintf(stderr, "kernel_launch: hipFuncSetAttribute failed\n"); grid = -1; return; }
        if (hipOccupancyMaxActiveBlocksPerMultiprocessor(&per_cu, (const void*)hymba_fwd, 512, LDS_BYTES) != hipSuccess || per_cu < 1) { fprintf(stderr, "kernel_launch: occupancy query says %d blocks per CU\n", per_cu); (void)hipGetLastError(); per_cu = 1; }
        grid = cus;
        fprintf(stderr, "kernel_launch: %d CUs, %d blocks/CU by the occupancy query, grid %d, ws %zu\n", cus, per_cu, grid, ws_size);
    }
    if (grid < 0) return;
    Args a{};
    for (int i = 0; i < 25; ++i) a.in[i] = (const float*)d_in[i];
    a.out = (float*)d_out; a.ws = (unsigned char*)d_ws;
    void* kargs[] = {&a};
    const hipError_t e = hipLaunchCooperativeKernel((const void*)hymba_fwd, dim3(grid), dim3(512), kargs, LDS_BYTES, stream);
    if (e != hipSuccess) fprintf(stderr, "kernel_launch: cooperative launch failed: %s (grid %d)\n", hipGetErrorString(e), grid);
}
```

```cpp
#include <hip/hip_runtime.h>
#include <hip/hip_cooperative_groups.h>
#include <cstdio>
#include <cstdint>
namespace cg = cooperative_groups;
namespace pg8 {
#define PG8_LAS __attribute__((address_space(3)))
typedef unsigned short bf16_t;
typedef short bf16x8 __attribute__((ext_vector_type(8)));
typedef float f32x4 __attribute__((ext_vector_type(4)));
typedef unsigned u32x4 __attribute__((ext_vector_type(4)));
constexpr int BM = 256, BK = 64, HALF = 128, HTB = HALF * BK * 2  , STAGE_BYTES = 8 * HTB, NXCD = 8, WGM = 8;

__host__ __device__ __forceinline__ int lds_byte(int r, int c) { const int st = (r >> 4) * 2 + (c >> 5), rr = r & 15, cc = c & 31, ob = rr * 64 + cc * 2; return st * 1024 + (ob ^ (((ob >> 9) & 1) << 5)); }
__host__ __device__ __forceinline__ void stage_rc(int b, int& R, int& C) { const int st = b / 1024, sb = b % 1024, swz = sb ^ (((sb >> 9) & 1) << 5); R = (st >> 1) * 16 + swz / 64; C = (st & 1) * 32 + (swz % 64) / 2; }
__host__ __device__ __forceinline__ int perm32(int rho) { const int n = rho >> 4, i = rho & 15; return 8 * (i >> 2) + 4 * n + (i & 3); }

struct Unit { int pm, pn; };
struct Gemm { const bf16_t* A; const bf16_t* Bt; int M, N, K; };

struct StaticOrder {
    int nM, nN, nwg, G, c;
    __host__ __device__ void init(int M, int N, int G_, int c_) { nM = M / BM; nN = N / BM; nwg = nM * nN; G = G_; c = c_; }
    __host__ __device__ bool next(int i, Unit& u) const {
        const long L = (long)i * G + c; if (L >= nwg) return false;
        int wgid = (int)L; { const int q = nwg / NXCD, r = nwg % NXCD, xcd = wgid % NXCD, off = wgid / NXCD; wgid = (xcd < r ? xcd * (q + 1) : r * (q + 1) + (xcd - r) * q) + off; }
        const int nig = WGM * nN, gid = wgid / nig, fm = gid * WGM, gsz = (nM - fm) < WGM ? (nM - fm) : WGM;
        u.pm = fm + ((wgid % nig) % gsz); u.pn = (wgid % nig) / gsz; return true;
    }
    __device__ __forceinline__ void a_ready(const Unit&) const {}
    __device__ __forceinline__ void done(const Unit&) const {}
};

__device__ __forceinline__ unsigned cvt_pk_bf16(float lo, float hi) { unsigned r; asm volatile("v_cvt_pk_bf16_f32 %0, %1, %2" : "=v"(r) : "v"(lo), "v"(hi)); return r; }
typedef float f32x2 __attribute__((ext_vector_type(2)));
__device__ __forceinline__ f32x2 gelu_pk(f32x2 v) {
    const f32x2 av = __builtin_elementwise_abs(v), d = av * 0.2316418882f + 1.0f;
    f32x2 t; t.x = __builtin_amdgcn_rcpf(d.x); t.y = __builtin_amdgcn_rcpf(d.y);
    f32x2 q = t * 0.5307027145f + (-0.7265760135f); q = q * t + 0.7107068705f; q = q * t + (-0.142248368f); q = q * t + 0.127414796f; q = q * t;
    const f32x2 s = (v * v) * (-0.72134752044f);
    f32x2 e; e.x = __builtin_amdgcn_exp2f(s.x); e.y = __builtin_amdgcn_exp2f(s.y);
    const f32x2 m = v * (q * e), r = v - m;
    f32x2 o; o.x = v.x < 0.f ? m.x : r.x; o.y = v.y < 0.f ? m.y : r.y; return o;
}

template <int ACT  > struct EpiBf16 {
    static constexpr bool PERM = true, AFTER_DRAIN = false; static_assert(ACT == 0 || ACT == 1, "EpiBf16: ACT is 0 (none) or 1 (gelu_pk)");
    bf16_t* O; int ldc; const float* bias; int split_cols; size_t split_stride; float scale0;
    __device__ __forceinline__ void operator()(const f32x4 (&acc)[2][2][4][2], const Unit& u, int wr, int wc, int fr, int fq) const {
        const int row0 = u.pm * BM + wr * 64 + fr; int colt = u.pn * BM; bf16_t* base = O;
        float sc = 1.f; if (split_cols) { const int t = colt / split_cols; base += (size_t)t * split_stride; colt -= t * split_cols; if (t == 0) sc = scale0; }
        const int col0 = colt + wc * 32 + 8 * fq, bcol0 = u.pn * BM + wc * 32 + 8 * fq;
        f32x4 bv[2][2];
#pragma unroll
        for (int bj = 0; bj < 2; ++bj)
#pragma unroll
            for (int n = 0; n < 2; ++n) bv[bj][n] = bias ? *(const f32x4*)(bias + bcol0 + bj * HALF + 4 * n) : (f32x4){0.f, 0.f, 0.f, 0.f};
#pragma unroll
        for (int ai = 0; ai < 2; ++ai)
#pragma unroll
            for (int m = 0; m < 4; ++m) { bf16_t* rowp = base + (size_t)(row0 + ai * HALF + m * 16) * ldc + col0;
#pragma unroll
                for (int bj = 0; bj < 2; ++bj) { f32x4 v0 = acc[ai][bj][m][0] + bv[bj][0], v1 = acc[ai][bj][m][1] + bv[bj][1];
                    if (ACT == 1) { f32x2 a = gelu_pk((f32x2){v0[0], v0[1]}), b = gelu_pk((f32x2){v0[2], v0[3]}), c = gelu_pk((f32x2){v1[0], v1[1]}), d = gelu_pk((f32x2){v1[2], v1[3]});
                        v0 = (f32x4){a.x, a.y, b.x, b.y}; v1 = (f32x4){c.x, c.y, d.x, d.y}; }
                    v0 = v0 * sc; v1 = v1 * sc; u32x4 w; w.x = cvt_pk_bf16(v0[0], v0[1]); w.y = cvt_pk_bf16(v0[2], v0[3]); w.z = cvt_pk_bf16(v1[0], v1[1]); w.w = cvt_pk_bf16(v1[2], v1[3]);
                    *(u32x4*)(rowp + bj * HALF) = w; } }
    }
};
template <class Epi, class Sched, bool ALIGN_EPI = false, bool SP2 = false, bool GATHER = false>
__device__ __forceinline__ void gemm_phase(PG8_LAS unsigned char* lds, const Gemm g, const Sched& S, const Epi& E, const int* gidx = nullptr) {
    static_assert(!GATHER || SP2, "GATHER is wired into the SP2 loop only");
    int tid_ = threadIdx.x; asm volatile("" : "+v"(tid_));
    const int tid = tid_, wid = __builtin_amdgcn_readfirstlane(tid >> 6), lane = tid & 63, wr = wid >> 2, wc = wid & 3, fr = lane & 15, fq = lane >> 4;
    const int K = g.K, nt = K / BK;
    unsigned voffA[2], voffB[2];
#pragma unroll
    for (int i = 0; i < 2; ++i) { int R, C; stage_rc(tid * 16 + i * 8192, R, C); const int Rb = Epi::PERM ? ((R & ~31) + perm32(R & 31)) : R;
        voffA[i] = (unsigned)(R * K + C) * 2u; voffB[i] = (unsigned)(Rb * K + C) * 2u; }
    unsigned gC[2][2], gN[2][2]; int gRaw[2][2];
#define PG8_GRAW(pm_) do { _Pragma("unroll") for (int h_ = 0; h_ < 2; ++h_) _Pragma("unroll") for (int i_ = 0; i_ < 2; ++i_) { int R_, C_; stage_rc(tid * 16 + i_ * 8192, R_, C_); const int row_ = (pm_) * BM + h_ * HALF + R_; \
        gRaw[h_][i_] = (row_ >> 14) * 8192 + gidx[row_]; } } while (0)
#define PG8_GOFF(dst) do { _Pragma("unroll") for (int h_ = 0; h_ < 2; ++h_) _Pragma("unroll") for (int i_ = 0; i_ < 2; ++i_) { int R_, C_; stage_rc(tid * 16 + i_ * 8192, R_, C_); \
        dst[h_][i_] = ((unsigned)gRaw[h_][i_] * (unsigned)K + (unsigned)C_) * 2u; } } while (0)
    const size_t kstep = (size_t)(BK * 2);
    const size_t hstep = (size_t)HALF * K * 2;
    const size_t tstep = 2 * hstep;
    const unsigned ldsw = (unsigned)wid * 1024u;
    const int aoff = lds_byte(wr * 64 + fr, fq * 8), boff = lds_byte(wc * 32 + fr, fq * 8);
#define PG8_SA(b, h) (((b) * 2 + (h)) * HTB)
#define PG8_SB(b, h) ((4 + (b) * 2 + (h)) * HTB)
#define PG8_STAGE(bufoff, gbase, voff) do { _Pragma("unroll") for (int _i = 0; _i < 2; ++_i) \
        __builtin_amdgcn_global_load_lds((const unsigned*)((const char*)(gbase) + (voff)[_i]), (PG8_LAS unsigned*)(lds + (bufoff) + ldsw + _i * 8192), 16, 0, 0); } while (0)
#define PG8_STAGE_A(bufoff, aptr, h, nx) do { if constexpr (GATHER) { _Pragma("unroll") for (int _i = 0; _i < 2; ++_i) { const unsigned o_ = (nx) ? gN[h][_i] : gC[h][_i]; \
        __builtin_amdgcn_global_load_lds((const unsigned*)((const char*)(aptr) + o_), (PG8_LAS unsigned*)(lds + (bufoff) + ldsw + _i * 8192), 16, 0, 0); } } \
    else { PG8_STAGE(bufoff, (aptr) + (h) * hstep, voffA); } } while (0)
#define PG8_LDA(dst, b, h) do { _Pragma("unroll") for (int m = 0; m < 4; ++m) _Pragma("unroll") for (int k = 0; k < 2; ++k) dst[m][k] = *(const PG8_LAS bf16x8*)(lds + PG8_SA(b, h) + aoff + m * 2048 + k * 1024); } while (0)
#define PG8_LDB(dst, b, h) do { _Pragma("unroll") for (int n = 0; n < 2; ++n) _Pragma("unroll") for (int k = 0; k < 2; ++k) dst[n][k] = *(const PG8_LAS bf16x8*)(lds + PG8_SB(b, h) + boff + n * 2048 + k * 1024); } while (0)
#define PG8_MMA(ai, bj, At, Bt) do { __builtin_amdgcn_s_setprio(1); _Pragma("unroll") for (int m = 0; m < 4; ++m) _Pragma("unroll") for (int n = 0; n < 2; ++n) _Pragma("unroll") for (int k = 0; k < 2; ++k) \
        acc[ai][bj][m][n] = __builtin_amdgcn_mfma_f32_16x16x32_bf16(Bt[n][k], At[m][k], acc[ai][bj][m][n], 0, 0, 0); __builtin_amdgcn_s_setprio(0); } while (0)
#define PG8_WAIT_V(n) asm volatile("s_waitcnt vmcnt(" #n ")" ::: "memory")
#define PG8_WAIT_L(n) asm volatile("s_waitcnt lgkmcnt(" #n ")" ::: "memory")
#define PG8_BAR __builtin_amdgcn_s_barrier()
#define PG8_SCHED __builtin_amdgcn_sched_barrier(0)
    Unit cur, nxt; int ui = 0;
    if (!S.next(0, cur)) return;
    f32x4 acc[2][2][4][2];
#pragma unroll
    for (int a = 0; a < 2; ++a)
#pragma unroll
        for (int b = 0; b < 2; ++b)
#pragma unroll
            for (int m = 0; m < 4; ++m)
#pragma unroll
                for (int n = 0; n < 2; ++n) acc[a][b][m][n] = (f32x4){0.f, 0.f, 0.f, 0.f};
    bf16x8 At[4][2], B0[2][2], B1[2][2];
    const char* cA = GATHER ? (const char*)g.A : (const char*)g.A + (size_t)cur.pm * tstep; const char* cB = (const char*)g.Bt + (size_t)cur.pn * tstep;
    if constexpr (GATHER) { PG8_GRAW(cur.pm); PG8_GOFF(gC); PG8_GOFF(gN); }
    S.a_ready(cur);
    E.prefetch(cur, wr, fr);
    if constexpr (SP2) {
        PG8_STAGE(PG8_SB(0, 0), cB, voffB); PG8_STAGE(PG8_SB(0, 1), cB + hstep, voffB); PG8_STAGE_A(PG8_SA(0, 0), cA, 0, false); PG8_STAGE_A(PG8_SA(0, 1), cA, 1, false);
        if (wr == 1) PG8_BAR;
        PG8_WAIT_V(2); PG8_BAR;
        PG8_STAGE(PG8_SB(1, 0), cB + kstep, voffB); PG8_STAGE_A(PG8_SA(1, 0), cA + kstep, 0, false); PG8_STAGE(PG8_SB(1, 1), cB + hstep + kstep, voffB);
        PG8_WAIT_V(6); PG8_BAR;
    } else {
        PG8_STAGE(PG8_SB(0, 0), cB, voffB); PG8_STAGE(PG8_SA(0, 0), cA, voffA); PG8_STAGE(PG8_SB(0, 1), cB + hstep, voffB); PG8_STAGE(PG8_SA(0, 1), cA + hstep, voffA);
        if (wr == 1) PG8_BAR;
        PG8_WAIT_V(4); PG8_BAR;
        PG8_STAGE(PG8_SB(1, 0), cB + kstep, voffB); PG8_STAGE(PG8_SA(1, 0), cA + kstep, voffA); PG8_STAGE(PG8_SB(1, 1), cB + hstep + kstep, voffB);
        PG8_WAIT_V(6); PG8_BAR;
    }
    for (;;) {
        const bool has_next = S.next(ui + 1, nxt);
        if constexpr (GATHER) { if (has_next) PG8_GRAW(nxt.pm); }
        const char* nA = (has_next && !GATHER) ? (const char*)g.A + (size_t)nxt.pm * tstep : cA; const char* nB = has_next ? (const char*)g.Bt + (size_t)nxt.pn * tstep : cB;
        for (int t = 0; t < nt; t += 2) {
            const bool last = (t == nt - 2);
            const char* a1 = cA + (size_t)(t + 1) * kstep;
            const char* a2 = last ? nA : cA + (size_t)(t + 2) * kstep; const char* b2 = last ? nB : cB + (size_t)(t + 2) * kstep;
            const char* a3 = a2 + kstep; const char* b3 = b2 + kstep;
            if constexpr (GATHER) { if (last) { if (has_next) PG8_GOFF(gN); else { gN[0][0] = gC[0][0]; gN[0][1] = gC[0][1]; gN[1][0] = gC[1][0]; gN[1][1] = gC[1][1]; } } }
            if (last && has_next) S.a_ready(nxt);
            if constexpr (SP2) {
            PG8_LDB(B0, 0, 0); PG8_LDB(B1, 0, 1); PG8_SCHED; PG8_LDA(At, 0, 0); PG8_STAGE_A(PG8_SA(1, 1), a1, 1, false);
            PG8_WAIT_V(8); PG8_WAIT_L(0); PG8_BAR; PG8_MMA(0, 0, At, B0); PG8_MMA(0, 1, At, B1); PG8_BAR; PG8_SCHED;
            PG8_LDA(At, 0, 1); PG8_STAGE(PG8_SB(0, 0), b2, voffB); PG8_STAGE(PG8_SB(0, 1), b2 + hstep, voffB); PG8_STAGE_A(PG8_SA(0, 0), a2, 0, last);
            PG8_WAIT_V(8); PG8_WAIT_L(0); PG8_BAR; PG8_MMA(1, 0, At, B0); PG8_MMA(1, 1, At, B1); PG8_BAR; PG8_SCHED;
            PG8_LDB(B0, 1, 0); PG8_LDB(B1, 1, 1); PG8_SCHED; PG8_LDA(At, 1, 0); PG8_STAGE_A(PG8_SA(0, 1), a2, 1, last);
            PG8_WAIT_V(8); PG8_WAIT_L(0); PG8_BAR; PG8_MMA(0, 0, At, B0); PG8_MMA(0, 1, At, B1); PG8_BAR; PG8_SCHED;
            PG8_LDA(At, 1, 1); PG8_STAGE(PG8_SB(1, 0), b3, voffB); PG8_STAGE(PG8_SB(1, 1), b3 + hstep, voffB); PG8_STAGE_A(PG8_SA(1, 0), a3, 0, last);
            PG8_WAIT_V(8); PG8_WAIT_L(0); PG8_BAR; PG8_MMA(1, 0, At, B0); PG8_MMA(1, 1, At, B1); PG8_BAR; PG8_SCHED;
            } else {
            PG8_LDB(B0, 0, 0); PG8_SCHED; PG8_LDA(At, 0, 0); PG8_STAGE(PG8_SA(1, 1), a1 + hstep, voffA);
            PG8_WAIT_L(8); PG8_BAR; PG8_WAIT_L(0); PG8_MMA(0, 0, At, B0); PG8_BAR; PG8_SCHED;
            PG8_LDB(B1, 0, 1); PG8_STAGE(PG8_SB(0, 0), b2, voffB);
            PG8_BAR; PG8_WAIT_L(0); PG8_MMA(0, 1, At, B1); PG8_BAR;
            PG8_LDA(At, 0, 1); PG8_STAGE(PG8_SA(0, 0), a2, voffA);
            PG8_BAR; PG8_WAIT_L(0); PG8_MMA(1, 0, At, B0); PG8_BAR; PG8_SCHED;
            PG8_STAGE(PG8_SB(0, 1), b2 + hstep, voffB);
            PG8_WAIT_V(6); PG8_BAR; PG8_MMA(1, 1, At, B1); PG8_BAR;
            PG8_LDB(B0, 1, 0); PG8_SCHED; PG8_LDA(At, 1, 0); PG8_STAGE(PG8_SA(0, 1), a2 + hstep, voffA);
            PG8_WAIT_L(8); PG8_BAR; PG8_WAIT_L(0); PG8_MMA(0, 0, At, B0); PG8_BAR; PG8_SCHED;
            PG8_LDB(B1, 1, 1); PG8_STAGE(PG8_SB(1, 0), b3, voffB);
            PG8_BAR; PG8_WAIT_L(0); PG8_MMA(0, 1, At, B1); PG8_BAR;
            PG8_LDA(At, 1, 1); PG8_STAGE(PG8_SA(1, 0), a3, voffA);
            PG8_BAR; PG8_WAIT_L(0); PG8_MMA(1, 0, At, B0); PG8_BAR; PG8_SCHED;
            PG8_STAGE(PG8_SB(1, 1), b3 + hstep, voffB);
            PG8_WAIT_V(6); PG8_BAR; PG8_MMA(1, 1, At, B1); PG8_BAR;
            }
        }
        if constexpr (ALIGN_EPI) { if (wr == 0) PG8_BAR; }
        if constexpr (!Epi::AFTER_DRAIN) { E(acc, cur, wr, wc, fr, fq); S.done(cur); }
        if (!has_next) break;
#pragma unroll
        for (int a = 0; a < 2; ++a)
#pragma unroll
            for (int b = 0; b < 2; ++b)
#pragma unroll
                for (int m = 0; m < 4; ++m)
#pragma unroll
                    for (int n = 0; n < 2; ++n) acc[a][b][m][n] = (f32x4){0.f, 0.f, 0.f, 0.f};
        cur = nxt; cA = nA; cB = nB; ++ui;
        E.prefetch(cur, wr, fr);
        if constexpr (GATHER) { gC[0][0] = gN[0][0]; gC[0][1] = gN[0][1]; gC[1][0] = gN[1][0]; gC[1][1] = gN[1][1]; }
        if constexpr (ALIGN_EPI) { if (wr == 1) PG8_BAR; }
    }
    PG8_WAIT_V(0);
    if constexpr (!ALIGN_EPI) { if (wr == 0) PG8_BAR; }
    PG8_BAR;
    if constexpr (Epi::AFTER_DRAIN) { E.fused(acc, cur, wr, wc, fr, fq, lds, wid, lane); S.done(cur); }
#undef PG8_SA
#undef PG8_SB
#undef PG8_STAGE
#undef PG8_STAGE_A
#undef PG8_GRAW
#undef PG8_GOFF
#undef PG8_LDA
#undef PG8_LDB
#undef PG8_MMA
#undef PG8_WAIT_V
#undef PG8_WAIT_L
#undef PG8_BAR
#undef PG8_SCHED
}
}
constexpr int BATCH = 8, SEQ = 8192, DM = 1024, T = BATCH * SEQ;
constexpr int INW = 2832, INW_G = 2816;
constexpr int NEXP = 16, CAP = 1024, FF = 1024, MEMT = 256;
constexpr int XROWS = BATCH * NEXP * CAP;
constexpr float EPS = 1e-6f;
constexpr float LOG2E = 1.4426950408889634f;

#define GAS __attribute__((address_space(1)))
#define LAS __attribute__((address_space(3)))
typedef unsigned short bf16;
typedef unsigned u32x4 __attribute__((ext_vector_type(4)));
typedef unsigned u32x2 __attribute__((ext_vector_type(2)));
typedef float f32x4 __attribute__((ext_vector_type(4)));
typedef float f32x2 __attribute__((ext_vector_type(2)));
typedef float f32x16 __attribute__((ext_vector_type(16)));
typedef short bf16x8 __attribute__((ext_vector_type(8)));
typedef short bf16x4 __attribute__((ext_vector_type(4)));

constexpr size_t MiB = 1u << 20;
constexpr size_t WS_CTL = 0;
constexpr size_t WS_GATES = 1 * MiB;
constexpr size_t WS_SSQAQ = 5 * MiB;
constexpr size_t WS_SSQAK = 9 * MiB;
constexpr size_t WS_SSQ1 = 10 * MiB;
constexpr size_t WS_SSQQ = 14 * MiB;
constexpr size_t WS_SSQ2 = 18 * MiB;
constexpr size_t WS_AFF = 22 * MiB;
constexpr size_t WS_SLOT = 26 * MiB;
constexpr size_t WS_N0 = 30 * MiB;
constexpr size_t WS_MEMN = 32 * MiB;
constexpr size_t WS_KVM = 36 * MiB;
constexpr size_t WS_SSQMK = 40 * MiB;
constexpr size_t WS_RINV2 = 40 * MiB + 256 * 1024;
constexpr size_t WS_IDX = 40 * MiB + 512 * 1024;
constexpr size_t WS_GVAL = 41 * MiB;
constexpr size_t WS_RINVE = 41 * MiB + 512 * 1024;
constexpr size_t WS_WST = 43 * MiB;
constexpr size_t WS_FTA = 45 * MiB;
constexpr size_t WS_RINVX = 47 * MiB + 64 * 1024;
constexpr size_t WS_DEC = 47 * MiB;
constexpr size_t WS_ESA = 60 * MiB;
constexpr size_t WS_WG16 = 42 * MiB;
constexpr size_t WS_WRHI = 42 * MiB + 64 * 1024;
constexpr size_t WS_WRLO = 42 * MiB + 128 * 1024;
constexpr size_t WS_WIN = 48 * MiB;
constexpr size_t WS_WOUT = 54 * MiB;
constexpr size_t WS_WMQ = 56 * MiB;
constexpr size_t WS_WKV = 57 * MiB;
constexpr size_t WS_WMO = 59 * MiB;
constexpr size_t WS_WGU = 64 * MiB;
constexpr size_t WS_WD = 128 * MiB;
constexpr size_t WS_A = 160 * MiB;
constexpr size_t WS_AQ = WS_A, WS_AK = WS_A + 64 * MiB, WS_AV = WS_A + 80 * MiB, WS_MQ = WS_A + 96 * MiB, WS_MK = WS_A + 160 * MiB, WS_MV = WS_A + 224 * MiB, WS_MO = WS_A + 288 * MiB;
constexpr size_t WS_XE = WS_A, WS_Y = WS_A;
constexpr size_t WS_B = 512 * MiB;
constexpr size_t WS_XN = WS_B, WS_MIX = WS_B, WS_QM = WS_B, WS_OM = WS_B + 64 * MiB;
constexpr size_t WS_C = 640 * MiB;
constexpr size_t WS_C0 = WS_C, WS_X1B = WS_C;
constexpr size_t WS_X2B = 768 * MiB;
constexpr size_t WS_HID = WS_B;
constexpr size_t WS_QC = 768 * MiB, WS_KC = 832 * MiB;
constexpr size_t WS_XB = 896 * MiB;
constexpr size_t WS_END = 1024 * MiB;

constexpr int LDS_BYTES = 155648;

__device__ __forceinline__ unsigned f2bf(float f) { unsigned u = __builtin_bit_cast(unsigned, f); return (u + 0x7fffu + ((u >> 16) & 1u)) >> 16; }
typedef __bf16 hwbf16x2 __attribute__((ext_vector_type(2)));
__device__ __forceinline__ unsigned pk2(float lo, float hi) { const f32x2 v = {lo, hi}; return __builtin_bit_cast(unsigned, __builtin_convertvector(v, hwbf16x2)); }
__device__ __forceinline__ float bf2f(unsigned short h) { return __builtin_bit_cast(float, (unsigned)h << 16); }
__device__ __forceinline__ float bflo(unsigned w) { return __builtin_bit_cast(float, w << 16); }
__device__ __forceinline__ float bfhi(unsigned w) { return __builtin_bit_cast(float, w & 0xffff0000u); }
__device__ __forceinline__ float wave_sum(float v) {
#pragma unroll
    for (int o = 1; o < 64; o <<= 1) v += __shfl_xor(v, o);
    return v;
}
__device__ __forceinline__ f32x16 mfma32(bf16x8 a, bf16x8 b, f32x16 c) { return __builtin_amdgcn_mfma_f32_32x32x16_bf16(a, b, c, 0, 0, 0); }
__device__ __forceinline__ f32x4 mfma16(bf16x8 a, bf16x8 b, f32x4 c) { return __builtin_amdgcn_mfma_f32_16x16x32_bf16(a, b, c, 0, 0, 0); }
#define LDS_WAIT() asm volatile("s_waitcnt lgkmcnt(0)" ::: "memory")

enum { I_X = 0, I_MEM, I_NORM_MIX_G, I_W_IN, I_ATT_Q_G, I_ATT_K_G, I_ATT_SINK, I_CONV_W, I_CONV_B, I_GATE_B, I_ML_OUT_G, I_W_OUT, I_NORM_MEM_G, I_MEM_KV_G,
       I_W_MEM_Q, I_W_MEM_KV, I_MEM_Q_G, I_MEM_K_G, I_W_MEM_O, I_NORM_FFN_G, I_W_ROUTER, I_B_ROUTER, I_W_GATE, I_W_UP, I_W_DOWN };
#define CAS __attribute__((address_space(4)))
struct Frame {
    LAS unsigned char* lds;
    int tid, lane, wave, bid, G;
    float* out; unsigned char* ws;
};
__device__ __forceinline__ const float* inp(int i) { const volatile CAS unsigned long long* ka = (const volatile CAS unsigned long long*)__builtin_amdgcn_kernarg_segment_ptr(); return (const float*)(const GAS float*)ka[i]; }
template <class Tp> __device__ __forceinline__ Tp* wsp(const Frame& F, size_t off) { return (Tp*)(GAS Tp*)(F.ws + off); }

namespace pg8 {
struct EpiInProj {
    static constexpr bool PERM = true, AFTER_DRAIN = false;
    unsigned char* ws; mutable float rpre[8];
    __device__ __forceinline__ void prefetch(const Unit& u, int wr, int fr) const { const float* rx = (const float*)(ws + WS_RINVX) + u.pm * BM + wr * 64 + fr;
#pragma unroll
        for (int i = 0; i < 8; ++i) rpre[i] = rx[(i >> 2) * HALF + (i & 3) * 16]; }
    __device__ __forceinline__ void operator()(const f32x4 (&acc)[2][2][4][2], const Unit& u, int wr, int wc, int fr, int fq) const {
        const int pn = u.pn;
        bf16_t* base[2]; int ld[2];
        if (pn < 2) { base[0] = (bf16_t*)(ws + WS_AQ) + 256 * pn; base[1] = base[0] + 128; ld[0] = ld[1] = 512; }
        else if (pn == 2) { base[0] = (bf16_t*)(ws + WS_AK); base[1] = (bf16_t*)(ws + WS_AV); ld[0] = ld[1] = 128; }
        else { const int s = (pn - 3) >> 1; base[0] = (bf16_t*)(ws + WS_MQ + (size_t)s * (64u << 20)) + 256 * ((pn - 3) & 1); base[1] = base[0] + 128; ld[0] = ld[1] = 512; }
        const int row0 = u.pm * BM + wr * 64 + fr, cw = wc * 32 + 8 * fq;
        float* sq = (float*)(ws + WS_SSQAQ); float* sk = (float*)(ws + WS_SSQAK);
#pragma unroll
        for (int ai = 0; ai < 2; ++ai)
#pragma unroll
            for (int m = 0; m < 4; ++m) {
                const int row = row0 + ai * HALF + m * 16; const float rs = rpre[ai * 4 + m];
#pragma unroll
                for (int bj = 0; bj < 2; ++bj) {
                    const f32x4 v0 = acc[ai][bj][m][0] * rs, v1 = acc[ai][bj][m][1] * rs;
                    u32x4 w; w.x = cvt_pk_bf16(v0[0], v0[1]); w.y = cvt_pk_bf16(v0[2], v0[3]); w.z = cvt_pk_bf16(v1[0], v1[1]); w.w = cvt_pk_bf16(v1[2], v1[3]);
                    *(GAS u32x4*)(base[bj] + (size_t)row * ld[bj] + cw) = w;
                    if (pn < 2 || (pn == 2 && bj == 0)) {
                        float s = (v0[0] * v0[0] + v0[1] * v0[1]) + (v0[2] * v0[2] + v0[3] * v0[3]) + (v1[0] * v1[0] + v1[1] * v1[1]) + (v1[2] * v1[2] + v1[3] * v1[3]);
                        s += __shfl_xor(s, 16); s += __shfl_xor(s, 32);
                        if (fq == 0) { if (pn < 2) sq[(size_t)((pn * 4 + bj * 2 + (wc >> 1)) * 2 + (wc & 1)) * T + row] = s; else sk[(size_t)wc * T + row] = s; }
                    }
                }
            }
    }
};
template <bool ROWSCALE> struct EpiHead128 {
    static constexpr bool PERM = true, AFTER_DRAIN = false;
    bf16_t* O; int ldc; const float* ssq_in; float* ssq_out; int nssq_tiles; int nrows;
    mutable float rpre[8];
    __device__ __forceinline__ void prefetch(const Unit& u, int wr, int fr) const {
        if (ROWSCALE) {
#pragma unroll
            for (int i = 0; i < 8; ++i) { const int row = u.pm * BM + wr * 64 + fr + (i >> 2) * HALF + (i & 3) * 16;
                float t = 0.f;
#pragma unroll
                for (int q = 0; q < 16; ++q) t += ssq_in[(size_t)q * nrows + row];
                rpre[i] = 1.0f / sqrtf(t * (1.0f / 1024.0f) + 1e-6f); }
        }
    }
    __device__ __forceinline__ void operator()(const f32x4 (&acc)[2][2][4][2], const Unit& u, int wr, int wc, int fr, int fq) const {
        const int row0 = u.pm * BM + wr * 64 + fr, col0 = u.pn * BM + wc * 32 + 8 * fq;
#pragma unroll
        for (int ai = 0; ai < 2; ++ai)
#pragma unroll
            for (int m = 0; m < 4; ++m) {
                const int row = row0 + ai * HALF + m * 16;
                const float rs = ROWSCALE ? rpre[ai * 4 + m] : 1.f;
#pragma unroll
                for (int bj = 0; bj < 2; ++bj) {
                    const f32x4 v0 = acc[ai][bj][m][0] * rs, v1 = acc[ai][bj][m][1] * rs;
                    u32x4 w; w.x = cvt_pk_bf16(v0[0], v0[1]); w.y = cvt_pk_bf16(v0[2], v0[3]); w.z = cvt_pk_bf16(v1[0], v1[1]); w.w = cvt_pk_bf16(v1[2], v1[3]);
                    *(u32x4*)(O + (size_t)row * ldc + col0 + bj * HALF) = w;
                    if (u.pn < nssq_tiles) {
                        float s = (v0[0] * v0[0] + v0[1] * v0[1]) + (v0[2] * v0[2] + v0[3] * v0[3]) + (v1[0] * v1[0] + v1[1] * v1[1]) + (v1[2] * v1[2] + v1[3] * v1[3]);
                        s += __shfl_xor(s, 16); s += __shfl_xor(s, 32);
                        if (fq == 0) ssq_out[(size_t)((2 * u.pn + bj) * 4 + wc) * nrows + row] = s;
                    }
                }
            }
    }
};
template <bool BASE_BF16> struct EpiResid {
    static constexpr bool PERM = true, AFTER_DRAIN = false;
    const void* base; bf16_t* outb; float* ssq;
    __device__ __forceinline__ void prefetch(const Unit&, int, int) const {}
    __device__ __forceinline__ void operator()(const f32x4 (&acc)[2][2][4][2], const Unit& u, int wr, int wc, int fr, int fq) const {
        const int row0 = u.pm * BM + wr * 64 + fr, col0 = u.pn * BM + wc * 32 + 8 * fq;
#pragma unroll
        for (int ai = 0; ai < 2; ++ai)
#pragma unroll
            for (int m = 0; m < 4; ++m) {
                const int row = row0 + ai * HALF + m * 16; const size_t off = (size_t)row * 1024 + col0;
                float s = 0.f;
#pragma unroll
                for (int bj = 0; bj < 2; ++bj) {
                    f32x4 b0, b1;
                    if (BASE_BF16) { const u32x4 bw = *(const u32x4*)((const bf16_t*)base + off + bj * HALF);
                        b0[0] = __builtin_bit_cast(float, bw.x << 16); b0[1] = __builtin_bit_cast(float, bw.x & 0xffff0000u); b0[2] = __builtin_bit_cast(float, bw.y << 16); b0[3] = __builtin_bit_cast(float, bw.y & 0xffff0000u);
                        b1[0] = __builtin_bit_cast(float, bw.z << 16); b1[1] = __builtin_bit_cast(float, bw.z & 0xffff0000u); b1[2] = __builtin_bit_cast(float, bw.w << 16); b1[3] = __builtin_bit_cast(float, bw.w & 0xffff0000u); }
                    else { b0 = *(const f32x4*)((const float*)base + off + bj * HALF); b1 = *(const f32x4*)((const float*)base + off + bj * HALF + 4); }
                    const f32x4 v0 = acc[ai][bj][m][0] + b0, v1 = acc[ai][bj][m][1] + b1;
                    u32x4 w; w.x = cvt_pk_bf16(v0[0], v0[1]); w.y = cvt_pk_bf16(v0[2], v0[3]); w.z = cvt_pk_bf16(v1[0], v1[1]); w.w = cvt_pk_bf16(v1[2], v1[3]);
                    *(u32x4*)(outb + off + bj * HALF) = w;
                    s += (v0[0] * v0[0] + v0[1] * v0[1]) + (v0[2] * v0[2] + v0[3] * v0[3]) + (v1[0] * v1[0] + v1[1] * v1[1]) + (v1[2] * v1[2] + v1[3] * v1[3]);
                }
                s += __shfl_xor(s, 16); s += __shfl_xor(s, 32);
                if (ssq != nullptr && fq == 0) ssq[(size_t)(u.pn * 4 + wc) * T + row] = s;
            }
    }
};
struct EpiGateUp {
    static constexpr bool PERM = true, AFTER_DRAIN = false;
    bf16_t* H; const float* rinv; mutable float rpre[8];
    __device__ __forceinline__ void prefetch(const Unit& u, int wr, int fr) const { const float* p = rinv + u.pm * BM + wr * 64 + fr;
#pragma unroll
        for (int i = 0; i < 8; ++i) rpre[i] = p[(i >> 2) * HALF + (i & 3) * 16]; }
    __device__ __forceinline__ void operator()(const f32x4 (&acc)[2][2][4][2], const Unit& u, int wr, int wc, int fr, int fq) const {
        const int row0 = u.pm * BM + wr * 64 + fr, col0 = (u.pn & 7) * 128 + wc * 32 + 8 * fq;
#pragma unroll
        for (int ai = 0; ai < 2; ++ai)
#pragma unroll
            for (int m = 0; m < 4; ++m) {
                const int row = row0 + ai * HALF + m * 16; const float r = rpre[ai * 4 + m];
                float h[8];
#pragma unroll
                for (int n = 0; n < 2; ++n)
#pragma unroll
                    for (int e = 0; e < 4; ++e) { const float g = acc[ai][0][m][n][e] * r, up = acc[ai][1][m][n][e] * r;
                        const float sg = g * __builtin_amdgcn_rcpf(1.0f + __builtin_amdgcn_exp2f(-g * 1.4426950408889634f)); h[n * 4 + e] = sg * up; }
                u32x4 w; w.x = cvt_pk_bf16(h[0], h[1]); w.y = cvt_pk_bf16(h[2], h[3]); w.z = cvt_pk_bf16(h[4], h[5]); w.w = cvt_pk_bf16(h[6], h[7]);
                *(u32x4*)(H + (size_t)row * 1024 + col0) = w;
            }
    }
};
struct EpiDown {
    static constexpr bool PERM = true, AFTER_DRAIN = false;
    bf16_t* Y; const float* gval; mutable float rpre[8];
    __device__ __forceinline__ void prefetch(const Unit& u, int wr, int fr) const { const float* p = gval + u.pm * BM + wr * 64 + fr;
#pragma unroll
        for (int i = 0; i < 8; ++i) rpre[i] = p[(i >> 2) * HALF + (i & 3) * 16]; }
    __device__ __forceinline__ void operator()(const f32x4 (&acc)[2][2][4][2], const Unit& u, int wr, int wc, int fr, int fq) const {
        const int row0 = u.pm * BM + wr * 64 + fr, col0 = (u.pn & 3) * BM + wc * 32 + 8 * fq;
#pragma unroll
        for (int ai = 0; ai < 2; ++ai)
#pragma unroll
            for (int m = 0; m < 4; ++m) {
                const int row = row0 + ai * HALF + m * 16; const float r = rpre[ai * 4 + m];
#pragma unroll
                for (int bj = 0; bj < 2; ++bj) {
                    const f32x4 v0 = acc[ai][bj][m][0] * r, v1 = acc[ai][bj][m][1] * r;
                    u32x4 w; w.x = cvt_pk_bf16(v0[0], v0[1]); w.y = cvt_pk_bf16(v0[2], v0[3]); w.z = cvt_pk_bf16(v1[0], v1[1]); w.w = cvt_pk_bf16(v1[2], v1[3]);
                    *(u32x4*)(Y + (size_t)row * 1024 + col0 + bj * HALF) = w;
                }
            }
    }
};
template <int NT> struct ExpertOrder {
    int G, c;
    __device__ bool next(int i, Unit& u) const {
        constexpr int UPG = 4 * NT, NU = 128 * UPG;
        const long L = (long)i * G + c; if (L >= NU) return false;
        const int xcd = (int)(L % 8), off = (int)(L / 8), idx = xcd * (NU / 8) + off;
        const int g = idx / UPG, w = idx % UPG, e = g >> 3, b = g & 7;
        u.pm = (b * 16 + e) * 4 + (w & 3); u.pn = e * NT + (w >> 2); return true;
    }
    __device__ __forceinline__ void a_ready(const Unit&) const {}
    __device__ __forceinline__ void done(const Unit&) const {}
};
}
#define XB_TMO      128
#define XB_XCNT(j)  (256  + 64 * (j))
#define XB_XSUB(j)  (1280 + 64 * (j))
#define XB_XGEN(j)  (2304 + 64 * (j))
#define XB_TOP      3328
#define XB_TOPGEN   3392
#define XCD_BAR_WORDS 3456
#define XB_SPIN_CAP (1u << 18)

__device__ __forceinline__ unsigned xb_ld(unsigned* p)              { return __hip_atomic_load(p, __ATOMIC_RELAXED, __HIP_MEMORY_SCOPE_AGENT); }
__device__ __forceinline__ unsigned xb_add(unsigned* p, unsigned v) { return __hip_atomic_fetch_add(p, v, __ATOMIC_RELAXED, __HIP_MEMORY_SCOPE_AGENT); }
__device__ __forceinline__ unsigned xb_xcc_id() { return (unsigned)__builtin_amdgcn_s_getreg((3 << 11) | 20) & 0xFu; }
#define XB_SPIN(cond, bar) do { unsigned _sp = 0; while (cond) { __builtin_amdgcn_s_sleep(1); \
    if ((++_sp & 255u) == 0u) { if (xb_ld(&(bar)[XB_TMO])) break; if (_sp > XB_SPIN_CAP) { atomicAdd(&(bar)[XB_TMO], 1u); break; } } } } while (0)

struct XcdBarrier {
    unsigned* bar; unsigned x;
    volatile LAS unsigned* st;
};

__device__ __forceinline__ XcdBarrier xcd_barrier_post(unsigned* bar, volatile LAS unsigned* st) {
    XcdBarrier b; b.bar = bar; b.x = xb_xcc_id(); b.st = st;
    if (threadIdx.x == 0) (void)xb_add(&bar[XB_XCNT(b.x)], 1u);
    return b;
}
__device__ __forceinline__ void xcd_barrier_complete(unsigned* bar, unsigned x, unsigned& nloc, unsigned& nx) {
    const unsigned G = gridDim.x * gridDim.y * gridDim.z;
    unsigned sum, cnt, mine, sp = 0u;
    for (;;) {
        sum = 0u; cnt = 0u; mine = 0u;
#pragma unroll
        for (unsigned j = 0; j < 16; ++j) { const unsigned c = xb_ld(&bar[XB_XCNT(j)]); sum += c; cnt += (c > 0u) ? 1u : 0u; mine = (j == x) ? c : mine; }
        if (sum == G) break;
        __builtin_amdgcn_s_sleep(1);
        if ((++sp & 255u) == 0u) { if (xb_ld(&bar[XB_TMO])) break; if (sp > XB_SPIN_CAP) { atomicAdd(&bar[XB_TMO], 1u); break; } }
    }
    nloc = mine > 0u ? mine : 1u; nx = cnt > 0u ? cnt : 1u;
}

__device__ __forceinline__ void xcd_barrier(const XcdBarrier& b) {
    asm volatile("s_waitcnt vmcnt(0)" ::: "memory");
    __syncthreads();
    if (threadIdx.x == 0) {
        unsigned* bar = b.bar;
        __builtin_amdgcn_s_waitcnt(0);
        unsigned nloc = b.st[0], nx = b.st[1];
        if (nloc == 0u) { xcd_barrier_complete(bar, b.x, nloc, nx); b.st[0] = nloc; b.st[1] = nx; }
        const unsigned old = xb_add(&bar[XB_XSUB(b.x)], 1u);
        const unsigned gen = old / nloc;
        if (old + 1u == (gen + 1u) * nloc) {
            __builtin_amdgcn_fence(__ATOMIC_RELEASE, "agent");
            asm volatile("s_waitcnt vmcnt(0)" ::: "memory");
            const unsigned og = xb_add(&bar[XB_TOP], 1u);
            const unsigned tg = og / nx;
            if (og + 1u == (tg + 1u) * nx) xb_add(&bar[XB_TOPGEN], 1u);
            else XB_SPIN(xb_ld(&bar[XB_TOPGEN]) == tg, bar);
            __builtin_amdgcn_fence(__ATOMIC_ACQUIRE, "agent");
            xb_add(&bar[XB_XGEN(b.x)], 1u);
            asm volatile("s_waitcnt vmcnt(0)" ::: "memory");
        } else {
            XB_SPIN(xb_ld(&bar[XB_XGEN(b.x)]) == gen, bar);
            __builtin_amdgcn_fence(__ATOMIC_ACQUIRE, "agent");
            asm volatile("s_waitcnt vmcnt(0)" ::: "memory");
        }
    }
    __syncthreads();
}

template <class RowMap> __device__ __forceinline__ void tr_tile(const float* W, int N, int k0, int n0, bf16* WT, int K, const float* kscale, LAS unsigned char* tile, int lane, RowMap rowmap) {
    const int ksub = lane >> 4, n4 = (lane & 15) * 4;
    const float* src = W + (size_t)(k0 + ksub) * N + n0 + n4;
    f32x4 v[16];
#pragma unroll
    for (int i = 0; i < 16; ++i) v[i] = *(const f32x4*)(src + (size_t)(4 * i) * N);
    if (kscale) {
#pragma unroll
        for (int i = 0; i < 16; ++i) v[i] = v[i] * kscale[k0 + 4 * i + ksub];
    }
    LAS unsigned short* t = (LAS unsigned short*)tile;
#pragma unroll
    for (int i = 0; i < 16; ++i) { const unsigned p0 = pk2(v[i][0], v[i][1]), p1 = pk2(v[i][2], v[i][3]); const int k = 4 * i + ksub;
        t[(n4 + 0) * 72 + k] = (unsigned short)(p0 & 0xffffu); t[(n4 + 1) * 72 + k] = (unsigned short)(p0 >> 16);
        t[(n4 + 2) * 72 + k] = (unsigned short)(p1 & 0xffffu); t[(n4 + 3) * 72 + k] = (unsigned short)(p1 >> 16); }
    LDS_WAIT(); asm volatile("" ::: "memory");
    const int ch = lane & 7;
#pragma unroll
    for (int j = 0; j < 8; ++j) { const int n = (lane >> 3) + 8 * j;
        const u32x4 o = *(const LAS u32x4*)(tile + n * 144 + ch * 16);
        *(u32x4*)(WT + (size_t)rowmap(n0 + n) * K + k0 + 8 * ch) = o; }
    LDS_WAIT(); asm volatile("" ::: "memory");
}
struct RowId { __device__ __forceinline__ int operator()(int n) const { return n; } };
struct RowOff { int off; __device__ __forceinline__ int operator()(int n) const { return off + n; } };
struct RowGateUp { int e, which; __device__ __forceinline__ int operator()(int n) const { return e * 2048 + 256 * (n >> 7) + 128 * which + (n & 127); } };
__device__ __forceinline__ void rms_row_to_bf16(const float* xrow, const float* g, bf16* orow, int lane) {
    const f32x4* xr = (const f32x4*)xrow + lane; const f32x4* gr = (const f32x4*)g + lane;
    f32x4 v[4]; float s = 0.f;
#pragma unroll
    for (int j = 0; j < 4; ++j) { v[j] = xr[64 * j]; s += (v[j][0] * v[j][0] + v[j][1] * v[j][1]) + (v[j][2] * v[j][2] + v[j][3] * v[j][3]); }
    const float r = 1.0f / sqrtf(wave_sum(s) * (1.0f / 1024.0f) + EPS);
    u32x2* o8 = (u32x2*)orow + lane;
#pragma unroll
    for (int j = 0; j < 4; ++j) { const f32x4 gg = gr[64 * j]; u32x2 w; w.x = pk2(v[j][0] * r * gg[0], v[j][1] * r * gg[1]); w.y = pk2(v[j][2] * r * gg[2], v[j][3] * r * gg[3]); o8[64 * j] = w; }
}
__device__ __forceinline__ void x_row2_to_bf16(const float* xrow, bf16* orow, float* rinv, int lane) {
    const f32x4* xr = (const f32x4*)xrow + lane;
    f32x4 v[8]; float s0 = 0.f, s1 = 0.f;
#pragma unroll
    for (int j = 0; j < 8; ++j) v[j] = xr[64 * j];
    u32x2* o8 = (u32x2*)orow + lane;
#pragma unroll
    for (int j = 0; j < 8; ++j) { u32x2 w; w.x = pk2(v[j][0], v[j][1]); w.y = pk2(v[j][2], v[j][3]); o8[64 * j] = w; }
#pragma unroll
    for (int j = 0; j < 4; ++j) { s0 += (v[j][0] * v[j][0] + v[j][1] * v[j][1]) + (v[j][2] * v[j][2] + v[j][3] * v[j][3]);
                                  s1 += (v[j + 4][0] * v[j + 4][0] + v[j + 4][1] * v[j + 4][1]) + (v[j + 4][2] * v[j + 4][2] + v[j + 4][3] * v[j + 4][3]); }
#pragma unroll
    for (int o = 1; o < 64; o <<= 1) { s0 += __shfl_xor(s0, o); s1 += __shfl_xor(s1, o); }
    if (lane == 0) { rinv[0] = 1.0f / sqrtf(s0 * (1.0f / 1024.0f) + EPS); rinv[1] = 1.0f / sqrtf(s1 * (1.0f / 1024.0f) + EPS); }
}
__device__ __forceinline__ void prep_weights(Frame& F) {
    const float* w_in = inp(I_W_IN); const float* norm_ffn_g = inp(I_NORM_FFN_G);
    const int gw = F.bid * 8 + F.wave, NGW = F.G * 8, lane = F.lane;
    LAS unsigned char* tile = F.lds + F.wave * 9216;
    constexpr int I_IN = 16 * 44, I_OUT = 16 * 16, I_MQ = 16 * 8, I_KV = 16 * 16, I_MO = 8 * 16, I_EX = 16 * 16 * 16;
    constexpr int NITEMS = I_IN + I_OUT + I_MQ + I_KV + I_MO + 3 * I_EX;
    for (int it = gw; it < NITEMS; it += NGW) {
        int r = it;
        if (r < I_IN) { const int kb = r / 44, nb = r % 44; tr_tile(w_in, INW, 64 * kb, 64 * nb, wsp<bf16>(F, WS_WIN), 1024, inp(I_NORM_MIX_G), tile, lane, RowId{}); continue; } r -= I_IN;
        if (r < I_OUT) { const int kb = r / 16, nb = r % 16; tr_tile(inp(I_W_OUT), 1024, 64 * kb, 64 * nb, wsp<bf16>(F, WS_WOUT), 1024, nullptr, tile, lane, RowId{}); continue; } r -= I_OUT;
        if (r < I_MQ) { const int kb = r / 8, nb = r % 8; tr_tile(inp(I_W_MEM_Q), 512, 64 * kb, 64 * nb, wsp<bf16>(F, WS_WMQ), 1024, inp(I_NORM_MEM_G), tile, lane, RowId{}); continue; } r -= I_MQ;
        if (r < I_KV) { const int kb = r / 16, nb = r % 16; tr_tile(inp(I_W_MEM_KV), 1024, 64 * kb, 64 * nb, wsp<bf16>(F, WS_WKV), 1024, nullptr, tile, lane, RowId{}); continue; } r -= I_KV;
        if (r < I_MO) { const int kb = r / 16, nb = r % 16; tr_tile(inp(I_W_MEM_O), 1024, 64 * kb, 64 * nb, wsp<bf16>(F, WS_WMO), 512, nullptr, tile, lane, RowId{}); continue; } r -= I_MO;
        if (r < 2 * I_EX) {
            const int which = r / I_EX; const int q = r % I_EX; const int e = q / 256, kb = (q % 256) / 16, nb = q % 16;
            const float* W = (which ? inp(I_W_UP) : inp(I_W_GATE)) + (size_t)e * 1024 * 1024;
            tr_tile(W, 1024, 64 * kb, 64 * nb, wsp<bf16>(F, WS_WGU), 1024, norm_ffn_g, tile, lane, RowGateUp{e, which}); continue; }
        r -= 2 * I_EX;
        { const int e = r / 256, kb = (r % 256) / 16, nb = r % 16;
          tr_tile(inp(I_W_DOWN) + (size_t)e * 1024 * 1024, 1024, 64 * kb, 64 * nb, wsp<bf16>(F, WS_WD), 1024, nullptr, tile, lane, RowOff{e * 1024}); }
    }
}
__device__ __forceinline__ void prep_small(Frame& F) {
    const float* w_in = inp(I_W_IN); const float* norm_ffn_g = inp(I_NORM_FFN_G); const float* norm_mix_g = inp(I_NORM_MIX_G);
    {
        const int gt = F.bid * 512 + F.tid, NGT = F.G * 512; const float* w_router = inp(I_W_ROUTER);
        for (int it = gt; it < 2 * 16 * 128; it += NGT) {
            const int which = it >> 11, q = it & 2047, n = q >> 7, c = q & 127;
            float v[8];
#pragma unroll
            for (int j = 0; j < 8; ++j) { const int k = 8 * c + j; v[j] = which ? w_router[(size_t)k * 16 + n] * norm_ffn_g[k] : w_in[(size_t)k * INW + INW_G + n] * norm_mix_g[k]; }
            u32x4 hi; hi.x = pk2(v[0], v[1]); hi.y = pk2(v[2], v[3]); hi.z = pk2(v[4], v[5]); hi.w = pk2(v[6], v[7]);
            if (!which) *(u32x4*)(wsp<bf16>(F, WS_WG16) + n * 1024 + 8 * c) = hi;
            else {
                *(u32x4*)(wsp<bf16>(F, WS_WRHI) + n * 1024 + 8 * c) = hi;
                float l[8]; const unsigned hw[4] = {hi.x, hi.y, hi.z, hi.w};
#pragma unroll
                for (int j = 0; j < 8; ++j) l[j] = v[j] - ((j & 1) ? bfhi(hw[j >> 1]) : bflo(hw[j >> 1]));
                u32x4 lo; lo.x = pk2(l[0], l[1]); lo.y = pk2(l[2], l[3]); lo.z = pk2(l[4], l[5]); lo.w = pk2(l[6], l[7]);
                *(u32x4*)(wsp<bf16>(F, WS_WRLO) + n * 1024 + 8 * c) = lo;
            }
        }
    }
}
__device__ __forceinline__ void prep_rows(Frame& F) {
    const int gw = F.bid * 8 + F.wave, NGW = F.G * 8, lane = F.lane;
    { const float* x = inp(I_X); bf16* XB = wsp<bf16>(F, WS_XB); float* RX = wsp<float>(F, WS_RINVX);
    for (int m = 2 * gw; m < T; m += 2 * NGW) x_row2_to_bf16(x + (size_t)m * 1024, XB + (size_t)m * 1024, RX + m, lane); }
    { const float* mem = inp(I_MEM); const float* g = inp(I_MEM_KV_G);
    for (int m = gw; m < BATCH * MEMT; m += NGW) rms_row_to_bf16(mem + (size_t)m * 1024, g, wsp<bf16>(F, WS_MEMN) + (size_t)m * 1024, lane); }
}

__device__ __forceinline__ void phase_gates(Frame& F, int first_block) {
    const int gw = (F.bid - first_block) * 8 + F.wave, NGW = (F.G - first_block) * 8, lane = F.lane, r16 = lane & 15, kg = lane >> 4;
    if (F.bid < first_block) return;
    const bf16* XN = wsp<bf16>(F, WS_XB); const float* RX = wsp<float>(F, WS_RINVX); const bf16* WG = wsp<bf16>(F, WS_WG16) + r16 * 1024 + 8 * kg; float* GA = wsp<float>(F, WS_GATES);
    const float gb = inp(I_GATE_B)[r16];
    for (int task = gw; task < T / 16; task += NGW) {
        const bf16* a = XN + (size_t)(task * 16 + r16) * 1024 + 8 * kg;
        f32x4 acc = {0.f, 0.f, 0.f, 0.f};
#pragma unroll 8
        for (int s = 0; s < 32; ++s) { const bf16x8 av = *(const bf16x8*)(a + 32 * s), bv = *(const bf16x8*)(WG + 32 * s); acc = mfma16(av, bv, acc); }
#pragma unroll
        for (int r = 0; r < 4; ++r) GA[(size_t)(task * 16 + 4 * kg + r) * 16 + r16] = acc[r] * RX[task * 16 + 4 * kg + r] + gb;
    }
}
__device__ __forceinline__ void phase_router(Frame& F) {
    const int gw = F.bid * 8 + F.wave, NGW = F.G * 8, lane = F.lane, r16 = lane & 15, kg = lane >> 4;
    const bf16* WH = wsp<bf16>(F, WS_WRHI) + r16 * 1024 + 8 * kg; const bf16* WL = wsp<bf16>(F, WS_WRLO) + r16 * 1024 + 8 * kg;
    float* AFF = wsp<float>(F, WS_AFF); float* RINV2 = wsp<float>(F, WS_RINV2); const bf16* X2B = wsp<bf16>(F, WS_X2B);
    const float br = inp(I_B_ROUTER)[r16];
    for (int task = gw; task < T / 16; task += NGW) {
        const bf16* a = X2B + (size_t)(task * 16 + r16) * 1024 + 8 * kg;
        f32x4 acc = {0.f, 0.f, 0.f, 0.f}; float ss = 0.f;
#pragma unroll 8
        for (int s = 0; s < 32; ++s) {
            const u32x4 xw = *(const u32x4*)(a + 32 * s);
            const float x0 = bflo(xw.x), x1 = bfhi(xw.x), x2 = bflo(xw.y), x3 = bfhi(xw.y), x4 = bflo(xw.z), x5 = bfhi(xw.z), x6 = bflo(xw.w), x7 = bfhi(xw.w);
            ss += (x0 * x0 + x1 * x1) + (x2 * x2 + x3 * x3) + (x4 * x4 + x5 * x5) + (x6 * x6 + x7 * x7);
            const bf16x8 av = __builtin_bit_cast(bf16x8, xw);
            const bf16x8 bh = *(const bf16x8*)(WH + 32 * s), bl = *(const bf16x8*)(WL + 32 * s);
            acc = mfma16(av, bh, acc); acc = mfma16(av, bl, acc);
        }
        ss += __shfl_xor(ss, 16); ss += __shfl_xor(ss, 32);
        const float rinv = 1.0f / sqrtf(ss * (1.0f / 1024.0f) + EPS);
        if (kg == 0) RINV2[task * 16 + r16] = rinv;
        f32x4 p;
#pragma unroll
        for (int r = 0; r < 4; ++r) {
            const float rr = __shfl(rinv, 4 * kg + r);
            const float lg = acc[r] * rr + br;
            float mx = lg;
#pragma unroll
            for (int o = 1; o < 16; o <<= 1) mx = fmaxf(mx, __shfl_xor(mx, o));
            const float ex = __expf(lg - mx); float sm = ex;
#pragma unroll
            for (int o = 1; o < 16; o <<= 1) sm += __shfl_xor(sm, o);
            p[r] = ex / sm;
        }
        const int t0 = task * 16 + 4 * kg, b = t0 >> 13, s0 = t0 & 8191;
        *(f32x4*)(AFF + ((size_t)(b * 16 + r16) << 13) + s0) = p;
    }
}
template <int D> __device__ __forceinline__ f32x16 st_tile(const LAS unsigned char* kp, const bf16x8* qf) {
    f32x16 acc;
#pragma unroll
    for (int i = 0; i < 16; ++i) acc[i] = 0.f;
#pragma unroll
    for (int ks = 0; ks < D / 16; ++ks) acc = mfma32(*(const LAS bf16x8*)(kp + ks * 32), qf[ks], acc);
    return acc;
}
__device__ __forceinline__ bf16x8 pack8(const f32x16& p, int s) {
    u32x4 w; w.x = pk2(p[8 * s + 0], p[8 * s + 1]); w.y = pk2(p[8 * s + 2], p[8 * s + 3]); w.z = pk2(p[8 * s + 4], p[8 * s + 5]); w.w = pk2(p[8 * s + 6], p[8 * s + 7]);
    return __builtin_bit_cast(bf16x8, w);
}
__device__ __forceinline__ bf16x8 vt_frag(const LAS unsigned char* vp) {
    const u32x2 a = *(const LAS u32x2*)vp, b = *(const LAS u32x2*)(vp + 16);
    const u32x4 w = {a.x, a.y, b.x, b.y};
    return __builtin_bit_cast(bf16x8, w);
}

typedef short v4i16 __attribute__((ext_vector_type(4)));
__device__ __forceinline__ bf16x8 tr_pair(const LAS unsigned char* p, int second) {
    const v4i16 a = __builtin_amdgcn_ds_read_tr16_b64_v4i16((LAS v4i16*)p), b = __builtin_amdgcn_ds_read_tr16_b64_v4i16((LAS v4i16*)(p + second));
    return (bf16x8){a[0], a[1], a[2], a[3], b[0], b[1], b[2], b[3]};
}
__device__ __forceinline__ int vfrag_base(int lane, int rs) { const int i = lane & 15, g = lane >> 4; return (4 * (g >> 1) + (i >> 2)) * rs + (16 * (g & 1) + 4 * (i & 3)) * 2; }

constexpr int OST_BYTES = 32 * 72;
__device__ __forceinline__ void stage_store_32x32(LAS unsigned char* stg, const u32x2 (&w)[4], bf16* gbase, int ld, int lane) {
    const int r = lane & 31, h = lane >> 5;
#pragma unroll
    for (int rg = 0; rg < 4; ++rg) *(LAS u32x2*)(stg + r * 72 + (8 * rg + 4 * h) * 2) = w[rg];
    LDS_WAIT();
#pragma unroll
    for (int ps = 0; ps < 2; ++ps) { const int row = (lane >> 2) + 16 * ps, ch = lane & 3;
        const u32x2 a = *(const LAS u32x2*)(stg + row * 72 + ch * 16), b = *(const LAS u32x2*)(stg + row * 72 + ch * 16 + 8);
        const u32x4 v = {a.x, a.y, b.x, b.y};
        *(u32x4*)(gbase + (size_t)row * ld + ch * 8) = v; }
    LDS_WAIT();
}

constexpr int WA_KS = 144, WA_VS = 192;
constexpr int WA_K_OFF = 0, WA_V_OFF = 384 * WA_KS;
__host__ __device__ constexpr int wa_kind(int rel) { return rel == 0 ? 0 : rel < 4 ? 1 : rel == 4 ? 2 : rel < 8 ? 3 : 4; }
template <int KIND> __device__ __forceinline__ void wa_softmax(f32x16& s, float rq, float nslope2, int dist0, float kill, float& m, float& l, f32x16 (&o)[2]) {
    const float b0 = nslope2 * (float)dist0 + kill, nb0 = -(nslope2 * (float)dist0) + kill;
    float tmax = -INFINITY;
#pragma unroll
    for (int reg = 0; reg < 16; ++reg) {
        const int off = (reg & 3) + 8 * (reg >> 2);
        float v;
        if (KIND == 0 || KIND == 1) v = __builtin_fmaf(s[reg], rq, __builtin_fmaf(nslope2, -(float)off, b0));
        else if (KIND == 3 || KIND == 4) v = __builtin_fmaf(s[reg], rq, __builtin_fmaf(nslope2, (float)off, nb0));
        else { const int dist = dist0 - off; v = __builtin_fmaf(s[reg], rq, nslope2 * (float)(dist < 0 ? -dist : dist)) + kill; }
        if (KIND == 0) v = (dist0 - off <= 128) ? v : -INFINITY;
        if (KIND == 4) v = (dist0 - off >= -128) ? v : -INFINITY;
        s[reg] = v; tmax = fmaxf(tmax, v);
    }
    tmax = fmaxf(tmax, __shfl_xor(tmax, 32));
    if (__any(tmax > m + 8.0f)) {
        const float mn = fmaxf(m, tmax), f = __builtin_amdgcn_exp2f(m - mn);
        o[0] = o[0] * f; o[1] = o[1] * f; l *= f; m = mn;
    }
#pragma unroll
    for (int reg = 0; reg < 16; ++reg) { const float p = __builtin_amdgcn_exp2f(s[reg] - m); l += p; s[reg] = p; }
}
template <int KA, int KB> __device__ __forceinline__ void wa_step(const LAS unsigned char* kp, const LAS unsigned char* vtile, const bf16x8 (&qfA)[4], const bf16x8 (&qfB)[4], float rqA, float rqB,
                                                                  float nslope2, int dist0A, float killA, float killB,
                                                                  float& mA, float& lA, f32x16 (&oA)[2], float& mB, float& lB, f32x16 (&oB)[2]) {
    bf16x8 kf[4];
#pragma unroll
    for (int ks = 0; ks < 4; ++ks) kf[ks] = *(const LAS bf16x8*)(kp + ks * 32);
    f32x16 sA, sB;
#pragma unroll
    for (int i = 0; i < 16; ++i) { sA[i] = 0.f; sB[i] = 0.f; }
#pragma unroll
    for (int ks = 0; ks < 4; ++ks) { if (KA >= 0) sA = mfma32(kf[ks], qfA[ks], sA); if (KB >= 0) sB = mfma32(kf[ks], qfB[ks], sB); }
    if (KA >= 0) wa_softmax<(KA >= 0 ? KA : 1)>(sA, rqA, nslope2, dist0A, killA, mA, lA, oA);
    if (KB >= 0) wa_softmax<(KB >= 0 ? KB : 1)>(sB, rqB, nslope2, dist0A + 32, killB, mB, lB, oB);
#pragma unroll
    for (int s2 = 0; s2 < 2; ++s2) {
        bf16x8 vf[2];
#pragma unroll
        for (int dt = 0; dt < 2; ++dt) vf[dt] = tr_pair(vtile + 16 * s2 * WA_VS + dt * 64, 8 * WA_VS);
        if (KA >= 0) { const bf16x8 pb = pack8(sA, s2);
#pragma unroll
            for (int dt = 0; dt < 2; ++dt) oA[dt] = mfma32(vf[dt], pb, oA[dt]); }
        if (KB >= 0) { const bf16x8 pb = pack8(sB, s2);
#pragma unroll
            for (int dt = 0; dt < 2; ++dt) oB[dt] = mfma32(vf[dt], pb, oB[dt]); }
    }
}
__device__ __forceinline__ void wattn_unit(Frame& F, int b, int qb, int kvh) {
    const int tid = F.tid, lane = F.lane, wave = F.wave, r = lane & 31, h = lane >> 5;
    LAS unsigned char* Ks = F.lds + WA_K_OFF; LAS unsigned char* VS = F.lds + WA_V_OFF;
    const bf16* AK = wsp<bf16>(F, WS_AK); const bf16* AV = wsp<bf16>(F, WS_AV); const bf16* AQ = wsp<bf16>(F, WS_AQ);
    const float* SSK = wsp<float>(F, WS_SSQAK); const float* SSQ = wsp<float>(F, WS_SSQAQ); bf16* MIX = wsp<bf16>(F, WS_MIX);
    const int kpos0 = qb * 128 - 128; const float* sinkp = inp(I_ATT_SINK);
    __syncthreads();
    {
        const int ch = tid & 7; float gs[8]; const float* akg = inp(I_ATT_K_G); const float* aqg = inp(I_ATT_Q_G);
#pragma unroll
        for (int j = 0; j < 8; ++j) gs[j] = akg[ch * 8 + j] * aqg[ch * 8 + j] * (0.125f * LOG2E);
        u32x4 kraw[6], vraw[6]; float s0[6], s1[6];
#pragma unroll
        for (int i = 0; i < 6; ++i) {
            const int key = (tid >> 3) + 64 * i, kp = kpos0 + key, kpc = kp < 0 ? 0 : (kp >= SEQ ? SEQ - 1 : kp); const size_t tok = (size_t)b * SEQ + kpc;
            kraw[i] = *(const u32x4*)(AK + tok * 128 + kvh * 64 + ch * 8); vraw[i] = *(const u32x4*)(AV + tok * 128 + kvh * 64 + ch * 8);
            s0[i] = SSK[(size_t)(2 * kvh) * T + tok]; s1[i] = SSK[(size_t)(2 * kvh + 1) * T + tok];
        }
#pragma unroll
        for (int i = 0; i < 6; ++i) {
            const int key = (tid >> 3) + 64 * i, kp = kpos0 + key; const bool ok = kp >= 0 && kp < SEQ;
            const float rk = ok ? 1.0f / sqrtf((s0[i] + s1[i]) * (1.0f / 64.0f) + EPS) : 0.f;
            const u32x4 raw = kraw[i]; u32x4 w;
            w.x = pk2(bflo(raw.x) * rk * gs[0], bfhi(raw.x) * rk * gs[1]); w.y = pk2(bflo(raw.y) * rk * gs[2], bfhi(raw.y) * rk * gs[3]);
            w.z = pk2(bflo(raw.z) * rk * gs[4], bfhi(raw.z) * rk * gs[5]); w.w = pk2(bflo(raw.w) * rk * gs[6], bfhi(raw.w) * rk * gs[7]);
            *(LAS u32x4*)(Ks + key * WA_KS + ch * 16) = w;
            u32x4 vv = vraw[i]; if (!ok) vv = (u32x4){0u, 0u, 0u, 0u};
            *(LAS u32x4*)(VS + key * WA_VS + ch * 16) = vv;
        }
    }
    __syncthreads();
    const int vb = vfrag_base(lane, WA_VS);
    {
        const int g = wave >> 1, jqA = 2 * (wave & 1), hq = kvh * 4 + g, qiA = 32 * jqA + r;
        const size_t tokA = (size_t)b * SEQ + qb * 128 + qiA, tokB = tokA + 32;
        bf16x8 qfA[4], qfB[4];
#pragma unroll
        for (int ks = 0; ks < 4; ++ks) { qfA[ks] = *(const bf16x8*)(AQ + tokA * 512 + hq * 64 + 16 * ks + 8 * h); qfB[ks] = *(const bf16x8*)(AQ + tokB * 512 + hq * 64 + 16 * ks + 8 * h); }
        const float rqA = 1.0f / sqrtf((SSQ[(size_t)(2 * hq) * T + tokA] + SSQ[(size_t)(2 * hq + 1) * T + tokA]) * (1.0f / 64.0f) + EPS);
        const float rqB = 1.0f / sqrtf((SSQ[(size_t)(2 * hq) * T + tokB] + SSQ[(size_t)(2 * hq + 1) * T + tokB]) * (1.0f / 64.0f) + EPS);
        const float nslope2 = -__builtin_amdgcn_exp2f(-(float)(hq + 1)) * LOG2E, sink2 = sinkp[hq] * LOG2E;
        float mA = sink2, lA = 0.f, mB = sink2, lB = 0.f;
        f32x16 oA[2], oB[2];
#pragma unroll
        for (int i = 0; i < 16; ++i) { oA[0][i] = 0.f; oA[1][i] = 0.f; oB[0][i] = 0.f; oB[1][i] = 0.f; }
        const int kv_lo = (qb == 0) ? 4 : 0, kv_hi = (qb == 63) ? 7 : 11;
        const LAS unsigned char* kp0 = Ks + r * WA_KS + h * 16;
#define WA_STEP(rel, KA_, KB_) do { const int kt = jqA + (rel); const float kill = (kt < kv_lo || kt > kv_hi) ? -INFINITY : 0.f; \
            wa_step<KA_, KB_>(kp0 + kt * 32 * WA_KS, VS + vb + kt * 32 * WA_VS, qfA, qfB, rqA, rqB, nslope2, qiA + 128 - 32 * kt - 4 * h, kill, kill, mA, lA, oA, mB, lB, oB); } while (0)
        WA_STEP(0, wa_kind(0), -1);
        WA_STEP(1, wa_kind(1), wa_kind(0)); WA_STEP(2, wa_kind(2), wa_kind(1)); WA_STEP(3, wa_kind(3), wa_kind(2)); WA_STEP(4, wa_kind(4), wa_kind(3));
        WA_STEP(5, wa_kind(5), wa_kind(4)); WA_STEP(6, wa_kind(6), wa_kind(5)); WA_STEP(7, wa_kind(7), wa_kind(6)); WA_STEP(8, wa_kind(8), wa_kind(7));
        WA_STEP(9, -1, wa_kind(8));
#undef WA_STEP
        lA += __shfl_xor(lA, 32); lA += __builtin_amdgcn_exp2f(sink2 - mA);
        lB += __shfl_xor(lB, 32); lB += __builtin_amdgcn_exp2f(sink2 - mB);
        const float invA = __builtin_amdgcn_rcpf(lA), invB = __builtin_amdgcn_rcpf(lB);
        bf16* obase = MIX + ((size_t)b * SEQ + qb * 128 + 32 * jqA) * 1024 + hq * 64;
        LAS unsigned char* stg = F.lds + WA_V_OFF + 384 * WA_VS + wave * OST_BYTES;
#pragma unroll
        for (int dt = 0; dt < 2; ++dt) { u32x2 w[4];
#pragma unroll
            for (int rg = 0; rg < 4; ++rg) { w[rg].x = pk2(oA[dt][4 * rg] * invA, oA[dt][4 * rg + 1] * invA); w[rg].y = pk2(oA[dt][4 * rg + 2] * invA, oA[dt][4 * rg + 3] * invA); }
            stage_store_32x32(stg, w, obase + dt * 32, 1024, lane);
#pragma unroll
            for (int rg = 0; rg < 4; ++rg) { w[rg].x = pk2(oB[dt][4 * rg] * invB, oB[dt][4 * rg + 1] * invB); w[rg].y = pk2(oB[dt][4 * rg + 2] * invB, oB[dt][4 * rg + 3] * invB); }
            stage_store_32x32(stg, w, obase + (size_t)32 * 1024 + dt * 32, 1024, lane); }
    }
}

constexpr int XA_KS = 272, XA_VS = 520;
constexpr int XA_K_OFF = 0, XA_V_OFF = 256 * XA_KS;
__device__ __forceinline__ void xattn_phase(Frame& F) {
    const int tid = F.tid, lane = F.lane, wave = F.wave, r = lane & 31, h = lane >> 5;
    LAS unsigned char* Ks = F.lds + XA_K_OFF; LAS unsigned char* VT = F.lds + XA_V_OFF;
    const bf16* KVM = wsp<bf16>(F, WS_KVM); const float* SSK = wsp<float>(F, WS_SSQMK); const bf16* QM = wsp<bf16>(F, WS_QM); const float* SSQ = wsp<float>(F, WS_SSQQ);
    bf16* OM = wsp<bf16>(F, WS_OM);
    const int nunits = BATCH * 4 * 32;
    const int per = (nunits + F.G - 1) / F.G;
    int cur_bh = -1;
#pragma unroll 1
    for (int ui = 0; ui < per; ++ui) {
        const int u = F.bid * per + ui; if (u >= nunits) break;
        const int bh = u >> 5, qblk = u & 31, b = bh >> 2, hd = bh & 3;
        if (bh != cur_bh) {
            cur_bh = bh;
            __syncthreads();
            const int ch = tid & 15; float gs[8]; const float* mkg = inp(I_MEM_K_G); const float* mqg = inp(I_MEM_Q_G);
#pragma unroll
            for (int j = 0; j < 8; ++j) gs[j] = mkg[ch * 8 + j] * mqg[ch * 8 + j] * (0.08838834764831845f * LOG2E);
#pragma unroll
            for (int i = 0; i < 8; ++i) {
                const int key = (tid >> 4) + 32 * i; const size_t row = (size_t)b * MEMT + key;
                const u32x4 raw = *(const u32x4*)(KVM + row * 1024 + hd * 128 + ch * 8);
                const float* sp = SSK + (size_t)(hd * 4) * (BATCH * MEMT) + row;
                const float rk = 1.0f / sqrtf(((sp[0] + sp[BATCH * MEMT]) + (sp[2 * BATCH * MEMT] + sp[3 * BATCH * MEMT])) * (1.0f / 128.0f) + EPS);
                u32x4 w;
                w.x = pk2(bflo(raw.x) * rk * gs[0], bfhi(raw.x) * rk * gs[1]); w.y = pk2(bflo(raw.y) * rk * gs[2], bfhi(raw.y) * rk * gs[3]);
                w.z = pk2(bflo(raw.z) * rk * gs[4], bfhi(raw.z) * rk * gs[5]); w.w = pk2(bflo(raw.w) * rk * gs[6], bfhi(raw.w) * rk * gs[7]);
                *(LAS u32x4*)(Ks + key * XA_KS + ch * 16) = w;
            }
#pragma unroll
            for (int i = 0; i < 8; ++i) {
                const int idx = tid + 512 * i, key = idx & 255, vc = idx >> 8;
                const u32x4 raw = *(const u32x4*)(KVM + ((size_t)b * MEMT + key) * 1024 + 512 + hd * 128 + vc * 8);
                LAS unsigned short* vt = (LAS unsigned short*)(VT + (vc * 8) * XA_VS + key * 2);
                const unsigned rw[4] = {raw.x, raw.y, raw.z, raw.w};
#pragma unroll
                for (int j = 0; j < 8; ++j) vt[j * (XA_VS / 2)] = (unsigned short)((j & 1) ? (rw[j >> 1] >> 16) : (rw[j >> 1] & 0xffffu));
            }
            __syncthreads();
        }
        const size_t tok = (size_t)b * SEQ + qblk * 256 + wave * 32 + r;
        bf16x8 qf[8];
#pragma unroll
        for (int ks = 0; ks < 8; ++ks) qf[ks] = *(const bf16x8*)(QM + tok * 512 + hd * 128 + 16 * ks + 8 * h);
        const float* sp = SSQ + (size_t)(hd * 4) * T + tok;
        const float rq = 1.0f / sqrtf(((sp[0] + sp[T]) + (sp[2 * (size_t)T] + sp[3 * (size_t)T])) * (1.0f / 128.0f) + EPS);
        const LAS unsigned char* kp0 = Ks + r * XA_KS + h * 16;
        float m = -INFINITY, l = 0.f;
        f32x16 o[4];
#pragma unroll
        for (int i = 0; i < 16; ++i) { o[0][i] = 0.f; o[1][i] = 0.f; o[2][i] = 0.f; o[3][i] = 0.f; }
#pragma unroll 1
        for (int kt = 0; kt < 8; ++kt) {
            bf16x8 vf[2][4];
#pragma unroll
            for (int s2 = 0; s2 < 2; ++s2)
#pragma unroll
                for (int dt = 0; dt < 4; ++dt) vf[s2][dt] = vt_frag(VT + (dt * 32 + r) * XA_VS + (kt * 32 + 16 * s2 + 4 * h) * 2);
            f32x16 s = st_tile<128>(kp0 + kt * 32 * XA_KS, qf);
            float tmax = -INFINITY;
#pragma unroll
            for (int reg = 0; reg < 16; ++reg) { s[reg] *= rq; tmax = fmaxf(tmax, s[reg]); }
            tmax = fmaxf(tmax, __shfl_xor(tmax, 32));
            if (__any(tmax > m + 8.0f)) {
                const float mn = fmaxf(m, tmax), f = __builtin_amdgcn_exp2f(m - mn);
                o[0] = o[0] * f; o[1] = o[1] * f; o[2] = o[2] * f; o[3] = o[3] * f; l *= f; m = mn;
            }
#pragma unroll
            for (int reg = 0; reg < 16; ++reg) { const float p = __builtin_amdgcn_exp2f(s[reg] - m); l += p; s[reg] = p; }
#pragma unroll
            for (int s2 = 0; s2 < 2; ++s2) {
                const bf16x8 pb = pack8(s, s2);
#pragma unroll
                for (int dt = 0; dt < 4; ++dt) o[dt] = mfma32(vf[s2][dt], pb, o[dt]);
            }
        }
        l += __shfl_xor(l, 32);
        const float inv = __builtin_amdgcn_rcpf(l);
        bf16* obase = OM + ((size_t)b * SEQ + qblk * 256 + wave * 32) * 512 + hd * 128;
        LAS unsigned char* stg = F.lds + XA_V_OFF + 128 * XA_VS + wave * OST_BYTES;
#pragma unroll
        for (int dt = 0; dt < 4; ++dt) { u32x2 w[4];
#pragma unroll
            for (int rg = 0; rg < 4; ++rg) { w[rg].x = pk2(o[dt][4 * rg] * inv, o[dt][4 * rg + 1] * inv); w[rg].y = pk2(o[dt][4 * rg + 2] * inv, o[dt][4 * rg + 3] * inv); }
            stage_store_32x32(stg, w, obase + dt * 32, 512, lane); }
    }
}
__device__ __forceinline__ float logsig2(float f) { return (fminf(f, 0.f) - log1pf(expf(-fabsf(f)))) * LOG2E; }
__device__ __forceinline__ float wave_incl_scan(float v, int lane) {
#pragma unroll
    for (int o = 1; o < 64; o <<= 1) { const float t = __shfl_up(v, o); if (lane >= o) v += t; }
    return v;
}
__device__ __forceinline__ float silu_f(float x) { return x * __builtin_amdgcn_rcpf(1.0f + __builtin_amdgcn_exp2f(-x * LOG2E)); }
__device__ __forceinline__ float sigmoid_f(float x) { return __builtin_amdgcn_rcpf(1.0f + __builtin_amdgcn_exp2f(-x * LOG2E)); }

__device__ __forceinline__ void phase_conv(Frame& F) {
    const bf16* MQ = wsp<bf16>(F, WS_MQ); const bf16* MK = wsp<bf16>(F, WS_MK); bf16* QC = wsp<bf16>(F, WS_QC); bf16* KC = wsp<bf16>(F, WS_KC);
    const float* conv_w = inp(I_CONV_W); const float* conv_b = inp(I_CONV_B);
    const int gt = F.bid * 512 + F.tid, NGT = F.G * 512;
#pragma unroll 1
    for (int it = gt; it < (T / 4) * 128; it += NGT) {
        const int cc = it & 127, rg = it >> 7, tok0 = rg * 4, pos0 = tok0 & (SEQ - 1), which = cc >> 6, col = (cc & 63) * 8, ch = which * 512 + col;
        const bf16* src = (which ? MK : MQ) + col;
        u32x4 rw[6];
#pragma unroll
        for (int d = 0; d < 6; ++d) { const int pp = pos0 + d - 1; const bool ok = pp >= 0 && pp < SEQ; rw[d] = *(const u32x4*)(src + (size_t)(ok ? tok0 + d - 1 : tok0) * 512); if (!ok) rw[d] = (u32x4){0u, 0u, 0u, 0u}; }
        const f32x4 w0a = *(const f32x4*)(conv_w + ch), w0b = *(const f32x4*)(conv_w + ch + 4), w1a = *(const f32x4*)(conv_w + 1024 + ch), w1b = *(const f32x4*)(conv_w + 1024 + ch + 4);
        const f32x4 w2a = *(const f32x4*)(conv_w + 2048 + ch), w2b = *(const f32x4*)(conv_w + 2048 + ch + 4), bba = *(const f32x4*)(conv_b + ch), bbb = *(const f32x4*)(conv_b + ch + 4);
        const float sc = which ? 0.08838834764831845f : 1.0f;
        float y[4][8];
#pragma unroll
        for (int j = 0; j < 8; ++j) {
            const float w0 = j < 4 ? w0a[j & 3] : w0b[j & 3], w1 = j < 4 ? w1a[j & 3] : w1b[j & 3], w2 = j < 4 ? w2a[j & 3] : w2b[j & 3], bb = j < 4 ? bba[j & 3] : bbb[j & 3];
            float xv[6];
#pragma unroll
            for (int d = 0; d < 6; ++d) { const unsigned wd = (j >> 1) == 0 ? rw[d].x : (j >> 1) == 1 ? rw[d].y : (j >> 1) == 2 ? rw[d].z : rw[d].w; xv[d] = (j & 1) ? bfhi(wd) : bflo(wd); }
#pragma unroll
            for (int rr = 0; rr < 4; ++rr) y[rr][j] = silu_f(bb + w0 * xv[rr] + w1 * xv[rr + 1] + w2 * xv[rr + 2]) * sc;
        }
        bf16* dst = (which ? KC : QC) + col;
#pragma unroll
        for (int rr = 0; rr < 4; ++rr) { u32x4 w; w.x = pk2(y[rr][0], y[rr][1]); w.y = pk2(y[rr][2], y[rr][3]); w.z = pk2(y[rr][4], y[rr][5]); w.w = pk2(y[rr][6], y[rr][7]);
            *(u32x4*)(dst + (size_t)(tok0 + rr) * 512) = w; }
    }
}
__device__ __forceinline__ void phase_gatescan(Frame& F) {
    const int gw = F.bid * 8 + F.wave, NGW = F.G * 8, lane = F.lane;
    const float* GA = wsp<float>(F, WS_GATES); float* WST = wsp<float>(F, WS_WST); float* FTA = wsp<float>(F, WS_FTA); float* ESA = wsp<float>(F, WS_ESA); float* DEC = wsp<float>(F, WS_DEC);
#pragma unroll 1
    for (int task = gw; task < BATCH * 64 * 4 * 2; task += NGW) {
        const int dir = task & 1, hd = (task >> 1) & 3, bc = task >> 3; const size_t tok0 = (size_t)bc * 128;
        const float* g = GA + (tok0 + 2 * lane) * 16 + dir * 8 + hd;
        const float i0 = g[0] * LOG2E, i1 = g[16] * LOG2E, l0 = logsig2(g[4]), l1 = logsig2(g[20]);
        const float incl = wave_incl_scan(l0 + l1, lane), tot = __shfl(incl, 63);
        float F0, F1;
        if (!dir) { F1 = incl; F0 = incl - l1; } else { F0 = tot - incl + l0 + l1; F1 = tot - incl + l1; }
        const size_t o = (size_t)(dir * 4 + hd) * T + tok0 + 2 * lane;
        *(f32x2*)(FTA + o) = (f32x2){F0, F1}; *(f32x2*)(ESA + o) = (f32x2){i0 - F0, i1 - F1};
        *(f32x2*)(WST + o) = (f32x2){__builtin_amdgcn_exp2f(tot - F0 + i0), __builtin_amdgcn_exp2f(tot - F1 + i1)};
        if (lane == 0) DEC[task] = __builtin_amdgcn_exp2f(tot);
    }
}

constexpr int MS_KW_STRIDE = 96, MS_VT_STRIDE = 288;
constexpr int MS_KW_BYTES = 128 * MS_KW_STRIDE, MS_VT_BYTES = 128 * MS_VT_STRIDE, MS_BUF = MS_KW_BYTES + MS_VT_BYTES;
__device__ __forceinline__ void mlstm_state_unit(Frame& F, int u) {
    const int tid = F.tid, lane = F.lane, wave = F.wave;
    const int ksl = u & 3, dir = (u >> 2) & 1, hd = (u >> 3) & 3, b = u >> 5;
    const bf16* KC = wsp<bf16>(F, WS_KC); const bf16* MV = wsp<bf16>(F, WS_MV); const float* WST = wsp<float>(F, WS_WST); const float* DEC = wsp<float>(F, WS_DEC);
    bf16* C0 = wsp<bf16>(F, WS_C0); float* N0 = wsp<float>(F, WS_N0);
    const int krow = tid >> 2, kch = tid & 3, kcol = hd * 128 + ksl * 32 + kch * 8;
    f32x4 acc[2], nacc[2];
#pragma unroll
    for (int i = 0; i < 2; ++i) { acc[i] = (f32x4){0.f, 0.f, 0.f, 0.f}; nacc[i] = (f32x4){0.f, 0.f, 0.f, 0.f}; }
    const bf16x8 ones = {0x3F80, 0x3F80, 0x3F80, 0x3F80, 0x3F80, 0x3F80, 0x3F80, 0x3F80};
    const int tg = lane >> 4, ti = lane & 15, tq = ti >> 2, tp = ti & 3;
    const int aoff = (8 * tg + tq) * MS_KW_STRIDE + (4 * tp) * 2, boff = (8 * tg + tq) * MS_VT_STRIDE + (16 * wave + 4 * tp) * 2;
    u32x4 krA, vrA[4], krB, vrB[4]; float wA, wB, dA, dB;
#define MS_LOAD(kr, vr, wv, dv, c) do { const size_t tok0_ = (size_t)b * SEQ + (c) * 128; \
        kr = *(const u32x4*)(KC + (tok0_ + krow) * 512 + kcol); wv = WST[(size_t)(dir * 4 + hd) * T + tok0_ + krow]; dv = DEC[((((size_t)b * 64 + (c)) * 4 + hd) * 2) + dir]; \
        _Pragma("unroll") for (int i_ = 0; i_ < 4; ++i_) { const int idx_ = tid + 512 * i_; vr[i_] = *(const u32x4*)(MV + (tok0_ + (idx_ >> 4)) * 512 + hd * 128 + (idx_ & 15) * 8); } } while (0)
#define MS_STEP(kr, vr, wv, dv, ci) do { \
        const int c = dir ? 63 - (ci) : (ci), buf = (ci) & 1; \
        LAS unsigned char* KW = F.lds + buf * MS_BUF; LAS unsigned char* VT = KW + MS_KW_BYTES; \
        const float dec = dv; \
        { u32x4 w_; w_.x = pk2(bflo(kr.x) * wv, bfhi(kr.x) * wv); w_.y = pk2(bflo(kr.y) * wv, bfhi(kr.y) * wv); w_.z = pk2(bflo(kr.z) * wv, bfhi(kr.z) * wv); w_.w = pk2(bflo(kr.w) * wv, bfhi(kr.w) * wv); \
          *(LAS u32x4*)(KW + krow * MS_KW_STRIDE + kch * 16) = w_; \
          _Pragma("unroll") for (int i = 0; i < 4; ++i) { const int idx = tid + 512 * i; *(LAS u32x4*)(VT + (idx >> 4) * MS_VT_STRIDE + (idx & 15) * 16) = vr[i]; } } \
        if ((ci) + 2 < 64) MS_LOAD(kr, vr, wv, dv, dir ? 61 - (ci) : (ci) + 2);     \
        __syncthreads(); \
        {   \
            const size_t unit4 = (((size_t)b * 64 + c) * 4 + hd) * 2 + dir; \
            bf16* cdst = C0 + unit4 * 16384 + ksl * 4096 + (16 * wave + (lane & 15)) * 32 + 4 * (lane >> 4); \
            _Pragma("unroll") for (int kt = 0; kt < 2; ++kt) { u32x2 w; w.x = pk2(acc[kt][0], acc[kt][1]); w.y = pk2(acc[kt][2], acc[kt][3]); *(u32x2*)(cdst + 16 * kt) = w; } \
            if (wave == 0 && (lane & 15) == 0) { \
                _Pragma("unroll") for (int kt = 0; kt < 2; ++kt) *(f32x4*)(N0 + unit4 * 128 + ksl * 32 + 16 * kt + 4 * (lane >> 4)) = nacc[kt]; } \
        } \
        _Pragma("unroll") for (int kt = 0; kt < 2; ++kt) { acc[kt] = acc[kt] * dec; nacc[kt] = nacc[kt] * dec; } \
        _Pragma("unroll") for (int ks = 0; ks < 4; ++ks) { \
            const bf16x8 bv = tr_pair(VT + boff + 32 * ks * MS_VT_STRIDE, 4 * MS_VT_STRIDE); \
            _Pragma("unroll") for (int kt = 0; kt < 2; ++kt) { \
                const bf16x8 av = tr_pair(KW + aoff + 32 * ks * MS_KW_STRIDE + 32 * kt, 4 * MS_KW_STRIDE); \
                acc[kt] = mfma16(av, bv, acc[kt]); nacc[kt] = mfma16(av, ones, nacc[kt]); } } \
    } while (0)
    MS_LOAD(krA, vrA, wA, dA, dir ? 63 : 0);
    MS_LOAD(krB, vrB, wB, dB, dir ? 62 : 1);
    __syncthreads();
#pragma unroll 1
    for (int ci = 0; ci < 64; ci += 2) {
        MS_STEP(krA, vrA, wA, dA, ci);
        MS_STEP(krB, vrB, wB, dB, ci + 1);
    }
#undef MS_STEP
#undef MS_LOAD
}

constexpr int MO_KS = 0, MO_VS = 34816, MO_C0 = 71680, MO_FT = 141312, MO_ES = 142336, MO_N0 = 143360, MO_XS = 144384, MO_OG = 145408;
__device__ __forceinline__ void mlstm_out_unit(Frame& F, int u) {
    const int tid = F.tid, lane = F.lane, wave = F.wave, r = lane & 31, hh = lane >> 5;
    const int hd = u & 3, c = (u >> 2) & 63, b = u >> 8;
    const size_t tok0 = (size_t)b * SEQ + c * 128;
    const bf16* MV = wsp<bf16>(F, WS_MV); const bf16* MOg = wsp<bf16>(F, WS_MO);
    const bf16* C0 = wsp<bf16>(F, WS_C0); const float* N0 = wsp<float>(F, WS_N0); bf16* MIX = wsp<bf16>(F, WS_MIX);
    LAS unsigned char* L = F.lds;
    LAS float* FT = (LAS float*)(L + MO_FT); LAS float* ES = (LAS float*)(L + MO_ES); LAS float* N0s = (LAS float*)(L + MO_N0); LAS float* XS = (LAS float*)(L + MO_XS); LAS float* OG = (LAS float*)(L + MO_OG);
    const size_t unit4 = (((size_t)b * 64 + c) * 4 + hd) * 2;
    const int tt = wave & 3, vh = wave >> 2, t = 32 * tt + r;
    bf16x8 qf[8];
    {
    __syncthreads();
    u32x4 kst[4], vst[4], cst[8];
    {
        const bf16* KC = wsp<bf16>(F, WS_KC);
#pragma unroll
        for (int i = 0; i < 4; ++i) { const int idx = tid + 512 * i, row = idx >> 4, ch = idx & 15;
            kst[i] = *(const u32x4*)(KC + (tok0 + row) * 512 + hd * 128 + ch * 8); vst[i] = *(const u32x4*)(MV + (tok0 + row) * 512 + hd * 128 + ch * 8); }
#pragma unroll
        for (int i = 0; i < 8; ++i) cst[i] = *(const u32x4*)(C0 + unit4 * 16384 + (size_t)(tid + 512 * i) * 8);
    }
    float ftv = 0.f, esv = 0.f, n0v = 0.f;
    if (tid < 256) { const int dir = tid >> 7, pos = tid & 127; const size_t o = (size_t)(dir * 4 + hd) * T + tok0 + pos;
        ftv = wsp<float>(F, WS_FTA)[o]; esv = wsp<float>(F, WS_ESA)[o]; n0v = N0[(unit4 + dir) * 128 + pos]; }
#pragma unroll
    for (int ks = 0; ks < 8; ++ks) qf[ks] = *(const bf16x8*)(wsp<bf16>(F, WS_QC) + (tok0 + t) * 512 + hd * 128 + 16 * ks + 8 * hh);
#pragma unroll
    for (int i = 0; i < 4; ++i) { const int idx = tid + 512 * i, row = idx >> 4, ch = idx & 15;
        *(LAS u32x4*)(L + MO_KS + row * 272 + ch * 16) = kst[i]; *(LAS u32x4*)(L + MO_VS + row * 288 + ch * 16) = vst[i]; }
#pragma unroll
    for (int i = 0; i < 8; ++i) { const int cidx = tid + 512 * i, dir = cidx >> 11, ksl = (cidx >> 9) & 3, v = (cidx >> 2) & 127, kq = cidx & 3;
        *(LAS u32x4*)(L + MO_C0 + dir * 34816 + v * 272 + (ksl * 32 + kq * 8) * 2) = cst[i]; }
    if (tid >= 384) OG[tid - 384] = inp(I_ML_OUT_G)[hd * 128 + tid - 384];
    if (tid < 256) { FT[tid] = ftv; ES[tid] = esv; ((LAS unsigned short*)N0s)[tid] = (unsigned short)pk2(n0v, 0.f); }
    __syncthreads();
    }
    const int vb = vfrag_base(lane, 288);
    f32x16 hs[2];
    {
#pragma unroll
    for (int i = 0; i < 16; ++i) { hs[0][i] = 0.f; hs[1][i] = 0.f; }
#pragma unroll 1
    for (int dir = 0; dir < 2; ++dir) {
        const float Ft = FT[dir * 128 + t], at = __builtin_amdgcn_exp2f(Ft);
        float qn;
        { f32x16 qa;
#pragma unroll
          for (int i = 0; i < 16; ++i) qa[i] = 0.f;
#pragma unroll
          for (int ks = 0; ks < 8; ++ks) qa = mfma32(*(const LAS bf16x8*)((const LAS unsigned char*)N0s + dir * 256 + (16 * ks + 8 * hh) * 2), qf[ks], qa);
          qn = qa[0]; }
        f32x16 num[2];
        const LAS unsigned char* c0 = L + MO_C0 + dir * 34816 + (64 * vh + r) * 272 + 16 * hh;
#pragma unroll
        for (int vt = 0; vt < 2; ++vt) {
#pragma unroll
            for (int i = 0; i < 16; ++i) num[vt][i] = 0.f;
#pragma unroll
            for (int ks = 0; ks < 8; ++ks) num[vt] = mfma32(*(const LAS bf16x8*)(c0 + vt * 32 * 272 + 32 * ks), qf[ks], num[vt]);
            num[vt] = num[vt] * at;
        }
        float rowsum = 0.f;
        const int st_lo = dir ? tt : 0, st_hi = dir ? 3 : tt;
#pragma unroll 1
        for (int st = st_lo; st <= st_hi; ++st) {
            f32x16 pm = st_tile<128>(L + MO_KS + (32 * st + r) * 272 + hh * 16, qf);
            if (st == tt) {
#pragma unroll
                for (int rg = 0; rg < 4; ++rg) {
                    const int s0 = 32 * st + 8 * rg + 4 * hh;
                    const f32x4 es = *(const LAS f32x4*)(ES + dir * 128 + s0);
#pragma unroll
                    for (int e = 0; e < 4; ++e) {
                        const int s = s0 + e; const bool ok = dir ? (s >= t) : (s <= t);
                        const float pv = ok ? pm[4 * rg + e] * __builtin_amdgcn_exp2f(Ft + es[e]) : 0.f;
                        pm[4 * rg + e] = pv; rowsum += pv;
                    }
                }
            } else {
#pragma unroll
                for (int rg = 0; rg < 4; ++rg) {
                    const f32x4 es = *(const LAS f32x4*)(ES + dir * 128 + 32 * st + 8 * rg + 4 * hh);
#pragma unroll
                    for (int e = 0; e < 4; ++e) { const float pv = pm[4 * rg + e] * __builtin_amdgcn_exp2f(Ft + es[e]); pm[4 * rg + e] = pv; rowsum += pv; }
                }
            }
#pragma unroll
            for (int s2 = 0; s2 < 2; ++s2) {
                const bf16x8 pb = pack8(pm, s2);
#pragma unroll
                for (int vt = 0; vt < 2; ++vt) num[vt] = mfma32(tr_pair(L + MO_VS + vb + (32 * st + 16 * s2) * 288 + (64 * vh + 32 * vt) * 2, 8 * 288), pb, num[vt]);
            }
        }
        rowsum += __shfl_xor(rowsum, 32);
        const float den = at * qn + rowsum, dinv = 1.0f / fmaxf(fabsf(den), 1.0f);
        hs[0] = hs[0] + num[0] * dinv; hs[1] = hs[1] + num[1] * dinv;
    }
    }
    {
    const size_t tok = tok0 + t;
    u32x2 mw[8];
#pragma unroll
    for (int i = 0; i < 8; ++i) mw[i] = *(const u32x2*)(MOg + tok * 512 + hd * 128 + 64 * vh + 32 * (i >> 2) + 8 * (i & 3) + 4 * hh);
    float ss = 0.f;
#pragma unroll
    for (int i = 0; i < 16; ++i) ss += hs[0][i] * hs[0][i] + hs[1][i] * hs[1][i];
    ss += __shfl_xor(ss, 32);
    if (hh == 0) XS[wave * 32 + r] = ss;
    __syncthreads();
    const float rinv = 1.0f / sqrtf((ss + XS[(wave ^ 4) * 32 + r]) * (1.0f / 128.0f) + EPS);
    LAS unsigned char* stg = L + MO_KS + wave * OST_BYTES;
    bf16* obase = MIX + (tok0 + 32 * tt) * 1024 + 512 + hd * 128 + 64 * vh;
#pragma unroll
    for (int vt = 0; vt < 2; ++vt) { u32x2 ow[4];
#pragma unroll
        for (int rg = 0; rg < 4; ++rg) {
            const int v = 64 * vh + 32 * vt + 8 * rg + 4 * hh;
            const f32x4 og = *(const LAS f32x4*)(OG + v);
            const u32x2 m_ = mw[vt * 4 + rg];
            const float m0 = bflo(m_.x), m1 = bfhi(m_.x), m2 = bflo(m_.y), m3 = bfhi(m_.y);
            const float o0 = hs[vt][4 * rg] * rinv * og[0] * sigmoid_f(m0), o1 = hs[vt][4 * rg + 1] * rinv * og[1] * sigmoid_f(m1);
            const float o2 = hs[vt][4 * rg + 2] * rinv * og[2] * sigmoid_f(m2), o3 = hs[vt][4 * rg + 3] * rinv * og[3] * sigmoid_f(m3);
            ow[rg].x = pk2(o0, o1); ow[rg].y = pk2(o2, o3);
        }
        stage_store_32x32(stg, ow, obase + 32 * vt, 1024, lane); }
    }
}
constexpr int SEL_VALS = 0, SEL_HIST = 32768, SEL_MISC = 32768 + 1024, SEL_WSUM = SEL_MISC + 64;
__device__ __forceinline__ void select_unit(Frame& F, int u) {
    const int tid = F.tid, lane = F.lane, wave = F.wave;
    LAS unsigned* vals = (LAS unsigned*)(F.lds + SEL_VALS); LAS unsigned* hist = (LAS unsigned*)(F.lds + SEL_HIST); LAS unsigned* misc = (LAS unsigned*)(F.lds + SEL_MISC); LAS unsigned* wsum = (LAS unsigned*)(F.lds + SEL_WSUM);
    const float* AFF = wsp<float>(F, WS_AFF) + (size_t)u * SEQ;
    int* IDX = wsp<int>(F, WS_IDX) + (size_t)u * CAP; float* GV = wsp<float>(F, WS_GVAL) + (size_t)u * CAP; int* SLOT = wsp<int>(F, WS_SLOT);
    float* RE = wsp<float>(F, WS_RINVE) + (size_t)u * CAP; const float* RINV2 = wsp<float>(F, WS_RINV2) + (size_t)(u >> 4) * SEQ;
    const int b = u >> 4, e = u & 15;
    __syncthreads();
    unsigned mine[16];
#pragma unroll
    for (int i = 0; i < 4; ++i) { const u32x4 v = *(const u32x4*)(AFF + 16 * tid + 4 * i); mine[4 * i] = v.x; mine[4 * i + 1] = v.y; mine[4 * i + 2] = v.z; mine[4 * i + 3] = v.w; }
    unsigned prefix = 0u, mask = 0u, kk = CAP;
#pragma unroll 1
    for (int pass = 0; pass < 4; ++pass) {
        const int shift = 24 - 8 * pass;
        if (tid < 256) hist[tid] = 0u;
        __syncthreads();
#pragma unroll
        for (int i = 0; i < 16; ++i) if ((mine[i] & mask) == prefix) __hip_atomic_fetch_add(&hist[(mine[i] >> shift) & 255u], 1u, __ATOMIC_RELAXED, __HIP_MEMORY_SCOPE_WORKGROUP);
        __syncthreads();
        if (wave == 0) {
            const unsigned h0 = hist[4 * lane], h1 = hist[4 * lane + 1], h2 = hist[4 * lane + 2], h3 = hist[4 * lane + 3];
            const unsigned ls = h0 + h1 + h2 + h3;
            unsigned incl = ls;
#pragma unroll
            for (int o = 1; o < 64; o <<= 1) { const unsigned t = __shfl_down(incl, o); if (lane + o < 64) incl += t; }
            const unsigned above = incl - ls;
            const unsigned a3 = above, a2 = above + h3, a1 = a2 + h2, a0 = a1 + h1;
            int d = -1; unsigned ab = 0u;
            if (a3 < kk && kk <= a3 + h3) { d = 4 * lane + 3; ab = a3; }
            else if (a2 < kk && kk <= a2 + h2) { d = 4 * lane + 2; ab = a2; }
            else if (a1 < kk && kk <= a1 + h1) { d = 4 * lane + 1; ab = a1; }
            else if (a0 < kk && kk <= a0 + h0) { d = 4 * lane; ab = a0; }
            if (d >= 0) { misc[0] = (unsigned)d; misc[1] = ab; }
        }
        __syncthreads();
        prefix |= misc[0] << shift; mask |= 255u << shift; kk -= misc[1];
    }
    unsigned cg = 0u, ce = 0u;
#pragma unroll
    for (int i = 0; i < 16; ++i) { cg += mine[i] > prefix ? 1u : 0u; ce += mine[i] == prefix ? 1u : 0u; }
    unsigned pk = cg | (ce << 16), incl = pk;
#pragma unroll
    for (int o = 1; o < 64; o <<= 1) { const unsigned t = __shfl_up(incl, o); if (lane >= o) incl += t; }
    if (lane == 63) wsum[wave] = incl;
    __syncthreads();
    unsigned base = 0u;
#pragma unroll
    for (int w = 0; w < 8; ++w) if (w < wave) base += wsum[w];
    unsigned excl = base + incl - pk;
    unsigned ng = excl & 0xffffu, ne = excl >> 16;
    const unsigned ngt_total = CAP - kk;
#pragma unroll
    for (int i = 0; i < 16; ++i) {
        const int s = 16 * tid + i; int slot = -1;
        if (mine[i] > prefix) { slot = (int)ng; ++ng; }
        else if (mine[i] == prefix) { if (ne < kk) slot = (int)(ngt_total + ne); ++ne; }
        if (slot >= 0) { IDX[slot] = s; GV[slot] = __builtin_bit_cast(float, mine[i]); RE[slot] = RINV2[s]; }
        SLOT[(size_t)u * SEQ + s] = slot;
    }
}
__device__ __forceinline__ void phase_gather(Frame& F) {
    const int gw = F.bid * 8 + F.wave, NGW = F.G * 8, lane = F.lane;
    const int* IDX = wsp<int>(F, WS_IDX); const bf16* X2B = wsp<bf16>(F, WS_X2B); bf16* XE = wsp<bf16>(F, WS_XE); const float* RINV2 = wsp<float>(F, WS_RINV2); float* RE = wsp<float>(F, WS_RINVE);
    for (int row = gw; row < XROWS; row += NGW) {
        const int b = row >> 14; const size_t tok = (size_t)b * SEQ + IDX[row];
        const u32x4* src = (const u32x4*)(X2B + tok * 1024) + lane; u32x4* dst = (u32x4*)(XE + (size_t)row * 1024) + lane;
        const u32x4 v0 = src[0], v1 = src[64];
        dst[0] = v0; dst[64] = v1;
        if (lane == 0) RE[row] = RINV2[tok];
    }
}
__device__ __forceinline__ void phase_combine(Frame& F) {
    const int gw = F.bid * 8 + F.wave, NGW = F.G * 8, lane = F.lane;
    const int* SLOT = wsp<int>(F, WS_SLOT); const bf16* Y = wsp<bf16>(F, WS_Y); const bf16* X2B = wsp<bf16>(F, WS_X2B);
    for (int grp = gw; grp < T / 8; grp += NGW) {
        const int tok0 = grp * 8, b = tok0 >> 13, s0 = tok0 & (SEQ - 1);
        const u32x2 sl = *(const u32x2*)(SLOT + ((size_t)(b * 16 + (lane & 15)) * SEQ + s0 + 2 * (lane >> 4)));
#pragma unroll
        for (int jj = 0; jj < 8; ++jj) {
            const int tok = tok0 + jj;
            const int mys = (jj & 1) ? (int)sl.y : (int)sl.x;
            const u32x4* xr = (const u32x4*)(X2B + (size_t)tok * 1024) + 2 * lane;
            const u32x4 x0 = xr[0], x1 = xr[1];
            f32x4 a0 = {bflo(x0.x), bfhi(x0.x), bflo(x0.y), bfhi(x0.y)}, a1 = {bflo(x0.z), bfhi(x0.z), bflo(x0.w), bfhi(x0.w)};
            f32x4 a2 = {bflo(x1.x), bfhi(x1.x), bflo(x1.y), bfhi(x1.y)}, a3 = {bflo(x1.z), bfhi(x1.z), bflo(x1.w), bfhi(x1.w)};
#pragma unroll 1
            for (int e = 0; e < 16; ++e) {
                const int slot = __shfl(mys, e + 16 * (jj >> 1));
                if (slot >= 0) {
                    const u32x4* y = (const u32x4*)(Y + ((size_t)(b * 16 + e) * CAP + slot) * 1024) + 2 * lane;
                    const u32x4 y0 = y[0], y1 = y[1];
                    a0[0] += bflo(y0.x); a0[1] += bfhi(y0.x); a0[2] += bflo(y0.y); a0[3] += bfhi(y0.y);
                    a1[0] += bflo(y0.z); a1[1] += bfhi(y0.z); a1[2] += bflo(y0.w); a1[3] += bfhi(y0.w);
                    a2[0] += bflo(y1.x); a2[1] += bfhi(y1.x); a2[2] += bflo(y1.y); a2[3] += bfhi(y1.y);
                    a3[0] += bflo(y1.z); a3[1] += bfhi(y1.z); a3[2] += bflo(y1.w); a3[3] += bfhi(y1.w);
                }
            }
            f32x4* o = (f32x4*)(F.out + (size_t)tok * 1024) + 4 * lane;
            o[0] = a0; o[1] = a1; o[2] = a2; o[3] = a3;
        }
    }
}
struct Args { const float* in[25]; float* out; unsigned char* ws; };
constexpr int MISC_OFF = LDS_BYTES - 64;
constexpr int CW_BAR = 4096;
__global__ void __launch_bounds__(512, 2) hymba_fwd(Args args) {
    extern __shared__ __attribute__((aligned(16))) unsigned char lds_raw[];
    cg::grid_group grid = cg::this_grid();
    Frame F;
    F.lds = (LAS unsigned char*)lds_raw;
    F.tid = threadIdx.x; F.lane = F.tid & 63; F.wave = __builtin_amdgcn_readfirstlane(F.tid >> 6); F.bid = blockIdx.x; F.G = gridDim.x;
    F.out = args.out; F.ws = args.ws;
    const int G = F.G, bid = F.bid;
    if (F.tid < 16) ((LAS unsigned*)(F.lds + MISC_OFF))[F.tid] = 0u;
    __syncthreads();
    if (bid == 0) for (int i = F.tid; i < XCD_BAR_WORDS; i += 512) ((unsigned*)(F.ws + WS_CTL) + CW_BAR)[i] = 0u;
#define GSYNC() xcd_barrier(xbar)
#define LAUNDER() do { asm volatile("" : "+v"(F.tid)); F.lane = F.tid & 63; } while (0)

    LAUNDER(); prep_weights(F);
    LAUNDER(); prep_small(F);
    LAUNDER(); prep_rows(F);
    grid.sync();
    const XcdBarrier xbar = xcd_barrier_post((unsigned*)(F.ws + WS_CTL) + CW_BAR, (volatile LAS unsigned*)(F.lds + MISC_OFF));
    LAUNDER(); phase_gates(F, G > 64 ? 32 : 0);
    LAUNDER(); {
        pg8::Gemm g{wsp<bf16>(F, WS_MEMN), wsp<bf16>(F, WS_WKV), BATCH * MEMT, 1024, 1024}; pg8::StaticOrder S; S.init(BATCH * MEMT, 1024, G, bid);
        pg8::EpiHead128<false> E{wsp<bf16>(F, WS_KVM), 1024, nullptr, wsp<float>(F, WS_SSQMK), 2, BATCH * MEMT};
        pg8::gemm_phase<pg8::EpiHead128<false>, pg8::StaticOrder, true, true>(F.lds, g, S, E);
    }
    LAUNDER(); {
        pg8::Gemm g{wsp<bf16>(F, WS_XB), wsp<bf16>(F, WS_WIN), T, INW_G, 1024}; pg8::StaticOrder S; S.init(T, INW_G, G, bid);
        pg8::EpiInProj E{F.ws};
        pg8::gemm_phase<pg8::EpiInProj, pg8::StaticOrder, true, true>(F.lds, g, S, E);
    }
    GSYNC();
    LAUNDER(); phase_conv(F);
    LAUNDER(); phase_gatescan(F);
    LAUNDER(); for (int u = bid; u < BATCH * 64 * 2; u += G) { const int kvh = u & 1, qb = (u >> 1) & 63, b = u >> 7; wattn_unit(F, b, qb, kvh); }
    GSYNC();
    LAUNDER(); for (int v = bid; v < BATCH * 4 * 2 * 4; v += G) { const int u = (((v >> 5) << 3 | (v & 7)) << 2) | ((v >> 3) & 3); mlstm_state_unit(F, u); }
    GSYNC();
    LAUNDER(); for (int u = bid; u < BATCH * 64 * 4; u += G) mlstm_out_unit(F, u);
    GSYNC();
    LAUNDER(); {
        pg8::Gemm g{wsp<bf16>(F, WS_MIX), wsp<bf16>(F, WS_WOUT), T, 1024, 1024}; pg8::StaticOrder S; S.init(T, 1024, G, bid);
        pg8::EpiResid<true> E{wsp<bf16>(F, WS_XB), wsp<bf16>(F, WS_X1B), wsp<float>(F, WS_SSQ1)};
        pg8::gemm_phase<pg8::EpiResid<true>, pg8::StaticOrder, true, true>(F.lds, g, S, E);
    }
    GSYNC();
    LAUNDER(); {
        pg8::Gemm g{wsp<bf16>(F, WS_X1B), wsp<bf16>(F, WS_WMQ), T, 512, 1024}; pg8::StaticOrder S; S.init(T, 512, G, bid);
        pg8::EpiHead128<true> E{wsp<bf16>(F, WS_QM), 512, wsp<float>(F, WS_SSQ1), wsp<float>(F, WS_SSQQ), 2, T};
        pg8::gemm_phase<pg8::EpiHead128<true>, pg8::StaticOrder, true, true>(F.lds, g, S, E);
    }
    GSYNC();
    LAUNDER(); xattn_phase(F);
    GSYNC();
    {
        pg8::Gemm g{wsp<bf16>(F, WS_OM), wsp<bf16>(F, WS_WMO), T, 1024, 512}; pg8::StaticOrder S; S.init(T, 1024, G, bid);
        pg8::EpiResid<true> E{wsp<bf16>(F, WS_X1B), wsp<bf16>(F, WS_X2B), nullptr};
        pg8::gemm_phase<pg8::EpiResid<true>, pg8::StaticOrder, true, true>(F.lds, g, S, E);
    }
    GSYNC();
    LAUNDER(); phase_router(F);
    GSYNC();
    LAUNDER(); for (int u = bid; u < BATCH * NEXP; u += G) select_unit(F, u);
    GSYNC();
    LAUNDER(); {
        pg8::Gemm g{wsp<bf16>(F, WS_X2B), wsp<bf16>(F, WS_WGU), XROWS, NEXP * 2048, 1024}; pg8::ExpertOrder<8> S{G, bid};
        pg8::EpiGateUp E{wsp<bf16>(F, WS_HID), wsp<float>(F, WS_RINVE)};
        pg8::gemm_phase<pg8::EpiGateUp, pg8::ExpertOrder<8>, true, true, true>(F.lds, g, S, E, wsp<int>(F, WS_IDX));
    }
    GSYNC();
    LAUNDER(); {
        pg8::Gemm g{wsp<bf16>(F, WS_HID), wsp<bf16>(F, WS_WD), XROWS, NEXP * 1024, 1024}; pg8::ExpertOrder<4> S{G, bid};
        pg8::EpiDown E{wsp<bf16>(F, WS_Y), wsp<float>(F, WS_GVAL)};
        pg8::gemm_phase<pg8::EpiDown, pg8::ExpertOrder<4>, true, true>(F.lds, g, S, E);
    }
    GSYNC();
    LAUNDER(); phase_combine(F);
}

extern "C" void kernel_launch(void* const* d_in, const int* in_sizes, int n_in, void* d_out, int out_size, void* d_ws, size_t ws_size, hipStream_t stream) {
    static int grid = 0;
    if (grid == 0) {
        if (n_in != 25 || in_sizes[0] != T * DM || out_size != T * DM || ws_size < WS_END) { fprintf(stderr, "kernel_launch: unexpected shapes (n_in %d, in0 %d, out %d, ws %zu); nothing launched\n", n_in, n_in > 0 ? in_sizes[0] : -1, out_size, ws_size); grid = -1; return; }
        int dev = 0, cus = 0, per_cu = 0;
        if (hipGetDevice(&dev) != hipSuccess || hipDeviceGetAttribute(&cus, hipDeviceAttributeMultiprocessorCount, dev) != hipSuccess) { grid = -1; return; }
        if (hipFuncSetAttribute((const void*)hymba_fwd, hipFuncAttributeMaxDynamicSharedMemorySize, LDS_BYTES) != hipSuccess) { fprintf(stderr, "kernel_launch: hipFuncSetAttribute failed\n"); grid = -1; return; }
        if (hipOccupancyMaxActiveBlocksPerMultiprocessor(&per_cu, (const void*)hymba_fwd, 512, LDS_BYTES) != hipSuccess || per_cu < 1) { fprintf(stderr, "kernel_launch: occupancy query says %d blocks per CU\n", per_cu); (void)hipGetLastError(); per_cu = 1; }
        grid = cus;
        fprintf(stderr, "kernel_launch: %d CUs, %d blocks/CU by the occupancy query, grid %d, ws %zu\n", cus, per_cu, grid, ws_size);
    }
    if (grid < 0) return;
    Args a{};
    for (int i = 0; i < 25; ++i) a.in[i] = (const float*)d_in[i];
    a.out = (float*)d_out; a.ws = (unsigned char*)d_ws;
    void* kargs[] = {&a};
    const hipError_t e = hipLaunchCooperativeKernel((const void*)hymba_fwd, dim3(grid), dim3(512), kargs, LDS_BYTES, stream);
    if (e != hipSuccess) fprintf(stderr, "kernel_launch: cooperative launch failed: %s (grid %d)\n", hipGetErrorString(e), grid);
}
```

```cpp
#include <hip/hip_runtime.h>
#include <hip/hip_cooperative_groups.h>
#include <cstdio>
#include <cstdint>
namespace cg = cooperative_groups;
namespace pg8 {
#define PG8_LAS __attribute__((address_space(3)))
typedef unsigned short bf16_t;
typedef short bf16x8 __attribute__((ext_vector_type(8)));
typedef float f32x4 __attribute__((ext_vector_type(4)));
typedef unsigned u32x4 __attribute__((ext_vector_type(4)));
typedef float f32x8 __attribute__((ext_vector_type(8)));
typedef int i32x4 __attribute__((ext_vector_type(4)));
typedef int i32x8 __attribute__((ext_vector_type(8)));
template <bool F8> struct Frag;
template <> struct Frag<false> { bf16x8 v[2]; __device__ __forceinline__ void set(int k, bf16x8 x) { v[k] = x; } };
template <> struct Frag<true> { i32x8 v; __device__ __forceinline__ void set(int k, bf16x8 x) { if (k == 0) v.lo = __builtin_bit_cast(i32x4, x); else v.hi = __builtin_bit_cast(i32x4, x); } };
constexpr int BM = 256, BK = 64, HALF = 128, HTB = HALF * BK * 2  , STAGE_BYTES = 8 * HTB, NXCD = 8, WGM = 8;

__host__ __device__ __forceinline__ int lds_byte(int r, int c) { const int st = (r >> 4) * 2 + (c >> 5), rr = r & 15, cc = c & 31, ob = rr * 64 + cc * 2; return st * 1024 + (ob ^ (((ob >> 9) & 1) << 5)); }
__host__ __device__ __forceinline__ void stage_rc(int b, int& R, int& C) { const int st = b / 1024, sb = b % 1024, swz = sb ^ (((sb >> 9) & 1) << 5); R = (st >> 1) * 16 + swz / 64; C = (st & 1) * 32 + (swz % 64) / 2; }
__host__ __device__ __forceinline__ int perm32(int rho) { const int n = rho >> 4, i = rho & 15; return 8 * (i >> 2) + 4 * n + (i & 3); }

struct Unit { int pm, pn; };
struct Gemm { const bf16_t* A; const bf16_t* Bt; int M, N, K; int wave; };
__device__ __forceinline__ int fresh_lane() { unsigned ones = ~0u; asm volatile("" : "+s"(ones)); return (int)__builtin_amdgcn_mbcnt_hi(ones, __builtin_amdgcn_mbcnt_lo(ones, 0u)); }

struct StaticOrder {
    int nM, nN, nwg, G, c;
    __host__ __device__ void init(int M, int N, int G_, int c_) { nM = M / BM; nN = N / BM; nwg = nM * nN; G = G_; c = c_; }
    __host__ __device__ bool next(int i, Unit& u) const {
        const long L = (long)i * G + c; if (L >= nwg) return false;
        int wgid = (int)L; { const int q = nwg / NXCD, r = nwg % NXCD, xcd = wgid % NXCD, off = wgid / NXCD; wgid = (xcd < r ? xcd * (q + 1) : r * (q + 1) + (xcd - r) * q) + off; }
        const int nig = WGM * nN, gid = wgid / nig, fm = gid * WGM, gsz = (nM - fm) < WGM ? (nM - fm) : WGM;
        u.pm = fm + ((wgid % nig) % gsz); u.pn = (wgid % nig) / gsz; return true;
    }
    __device__ __forceinline__ void a_ready(const Unit&) const {}
    __device__ __forceinline__ void done(const Unit&) const {}
};

__device__ __forceinline__ unsigned cvt_pk_bf16(float lo, float hi) { unsigned r; asm volatile("v_cvt_pk_bf16_f32 %0, %1, %2" : "=v"(r) : "v"(lo), "v"(hi)); return r; }
__device__ __forceinline__ unsigned cvt_pk4_fp8(float a, float b, float c, float d) {
    a = __builtin_amdgcn_fmed3f(a, -448.f, 448.f); b = __builtin_amdgcn_fmed3f(b, -448.f, 448.f); c = __builtin_amdgcn_fmed3f(c, -448.f, 448.f); d = __builtin_amdgcn_fmed3f(d, -448.f, 448.f);
    const int r = __builtin_amdgcn_cvt_pk_fp8_f32(a, b, 0, false); return (unsigned)__builtin_amdgcn_cvt_pk_fp8_f32(c, d, r, true); }
typedef float f32x2 __attribute__((ext_vector_type(2)));
__device__ __forceinline__ f32x2 gelu_pk(f32x2 v) {
    const f32x2 av = __builtin_elementwise_abs(v), d = av * 0.2316418882f + 1.0f;
    f32x2 t; t.x = __builtin_amdgcn_rcpf(d.x); t.y = __builtin_amdgcn_rcpf(d.y);
    f32x2 q = t * 0.5307027145f + (-0.7265760135f); q = q * t + 0.7107068705f; q = q * t + (-0.142248368f); q = q * t + 0.127414796f; q = q * t;
    const f32x2 s = (v * v) * (-0.72134752044f);
    f32x2 e; e.x = __builtin_amdgcn_exp2f(s.x); e.y = __builtin_amdgcn_exp2f(s.y);
    const f32x2 m = v * (q * e), r = v - m;
    f32x2 o; o.x = v.x < 0.f ? m.x : r.x; o.y = v.y < 0.f ? m.y : r.y; return o;
}

template <int ACT  > struct EpiBf16 {
    static constexpr bool PERM = true, AFTER_DRAIN = false; static_assert(ACT == 0 || ACT == 1, "EpiBf16: ACT is 0 (none) or 1 (gelu_pk)");
    bf16_t* O; int ldc; const float* bias; int split_cols; size_t split_stride; float scale0;
    __device__ __forceinline__ void operator()(const f32x4 (&acc)[2][2][4][2], const Unit& u, int wr, int wc, int fr, int fq) const {
        const int row0 = u.pm * BM + wr * 64 + fr; int colt = u.pn * BM; bf16_t* base = O;
        float sc = 1.f; if (split_cols) { const int t = colt / split_cols; base += (size_t)t * split_stride; colt -= t * split_cols; if (t == 0) sc = scale0; }
        const int col0 = colt + wc * 32 + 8 * fq, bcol0 = u.pn * BM + wc * 32 + 8 * fq;
        f32x4 bv[2][2];
#pragma unroll
        for (int bj = 0; bj < 2; ++bj)
#pragma unroll
            for (int n = 0; n < 2; ++n) bv[bj][n] = bias ? *(const f32x4*)(bias + bcol0 + bj * HALF + 4 * n) : (f32x4){0.f, 0.f, 0.f, 0.f};
#pragma unroll
        for (int ai = 0; ai < 2; ++ai)
#pragma unroll
            for (int m = 0; m < 4; ++m) { bf16_t* rowp = base + (size_t)(row0 + ai * HALF + m * 16) * ldc + col0;
#pragma unroll
                for (int bj = 0; bj < 2; ++bj) { f32x4 v0 = acc[ai][bj][m][0] + bv[bj][0], v1 = acc[ai][bj][m][1] + bv[bj][1];
                    if (ACT == 1) { f32x2 a = gelu_pk((f32x2){v0[0], v0[1]}), b = gelu_pk((f32x2){v0[2], v0[3]}), c = gelu_pk((f32x2){v1[0], v1[1]}), d = gelu_pk((f32x2){v1[2], v1[3]});
                        v0 = (f32x4){a.x, a.y, b.x, b.y}; v1 = (f32x4){c.x, c.y, d.x, d.y}; }
                    v0 = v0 * sc; v1 = v1 * sc; u32x4 w; w.x = cvt_pk_bf16(v0[0], v0[1]); w.y = cvt_pk_bf16(v0[2], v0[3]); w.z = cvt_pk_bf16(v1[0], v1[1]); w.w = cvt_pk_bf16(v1[2], v1[3]);
                    *(u32x4*)(rowp + bj * HALF) = w; } }
    }
};
template <class Epi, class Sched, bool ALIGN_EPI = false, bool SP2 = false, bool GATHER = false, int F8W = 0>
__device__ __forceinline__ void gemm_phase(PG8_LAS unsigned char* lds, const Gemm g, const Sched& S, const Epi& E, const int* gidx = nullptr) {
    static_assert(!GATHER || SP2, "GATHER is wired into the SP2 loop only");
    int wid_ = g.wave; asm volatile("" : "+s"(wid_));
    int tid_ = wid_ * 64 + fresh_lane(); asm volatile("" : "+v"(tid_));
    const int tid = tid_, wid = wid_, lane = tid & 63, wr = wid >> 2, wc = wid & 3, fr = lane & 15, fq = lane >> 4;
    const int K = g.K, nt = K / BK;
    unsigned voffA[2], voffB[2];
#pragma unroll
    for (int i = 0; i < 2; ++i) { int R, C; stage_rc(tid * 16 + i * 8192, R, C); const int Rb = Epi::PERM ? ((R & ~31) + perm32(R & 31)) : R;
        voffA[i] = (unsigned)(R * K + C) * 2u; voffB[i] = (unsigned)(Rb * K + C) * 2u; }
    const unsigned rslot = (unsigned)(size_t)(lds + STAGE_BYTES + 8192) + (unsigned)wid * 1024u;
    unsigned gC[2][2];
    const unsigned gslot = (unsigned)(size_t)(lds + STAGE_BYTES) + (unsigned)wid * 1024u;
#define PG8_TFRESH() int t_ = wid * 64 + fresh_lane(); asm volatile("" : "+v"(t_))
#define PG8_GFIRST(pm_) do { PG8_TFRESH(); _Pragma("unroll") for (int h_ = 0; h_ < 2; ++h_) _Pragma("unroll") for (int i_ = 0; i_ < 2; ++i_) { int R_, C_; stage_rc(t_ * 16 + i_ * 8192, R_, C_); \
        const int row_ = (pm_) * BM + h_ * HALF + R_; gC[h_][i_] = ((unsigned)((row_ >> 14) * 8192 + gidx[row_]) * (unsigned)K + (unsigned)C_) * 2u; } } while (0)
#define PG8_GISSUE(pm_) do { PG8_TFRESH(); _Pragma("unroll") for (int h_ = 0; h_ < 2; ++h_) _Pragma("unroll") for (int i_ = 0; i_ < 2; ++i_) { int R_, C_; stage_rc(t_ * 16 + i_ * 8192, R_, C_); \
        const unsigned vo_ = (unsigned)((pm_) * BM + h_ * HALF + R_) * 4u; \
        asm volatile("s_mov_b32 m0, %2\n\ts_nop 0\n\tglobal_load_lds_dword %0, %1" :: "v"(vo_), "s"(gidx), "s"(gslot + (unsigned)((h_ * 2 + i_) * 256)) : "memory", "m0"); } } while (0)
#define PG8_GTAKE(pm_) do { PG8_TFRESH(); _Pragma("unroll") for (int h_ = 0; h_ < 2; ++h_) _Pragma("unroll") for (int i_ = 0; i_ < 2; ++i_) { int R_, C_; stage_rc(t_ * 16 + i_ * 8192, R_, C_); \
        const int row_ = (pm_) * BM + h_ * HALF + R_; const unsigned raw_ = *(const PG8_LAS unsigned*)(lds + STAGE_BYTES + wid * 1024 + (h_ * 2 + i_) * 256 + (t_ & 63) * 4); \
        gC[h_][i_] = ((unsigned)((row_ >> 14) * 8192 + (int)raw_) * (unsigned)K + (unsigned)C_) * 2u; } } while (0)
    const size_t kstep = (size_t)(BK * 2);
    const size_t hstep = (size_t)HALF * K * 2;
    const size_t tstep = 2 * hstep;
    const unsigned ldsw = (unsigned)wid * 1024u;
    const int aoff = lds_byte(wr * 64 + fr, fq * 8), boff = lds_byte(wc * 32 + fr, fq * 8);
#define PG8_SA(b, h) (((b) * 2 + (h)) * HTB)
#define PG8_SB(b, h) ((4 + (b) * 2 + (h)) * HTB)
#define PG8_GLDS(voff32, gbase, ldsaddr) asm volatile("s_mov_b32 m0, %2\n\ts_nop 0\n\tglobal_load_lds_dwordx4 %0, %1" :: "v"(voff32), "s"(gbase), "s"(ldsaddr) : "memory", "m0")
#define PG8_STAGE(bufoff, gbase, voff) do { const char* gb_ = (const char*)(gbase); const unsigned la_ = (unsigned)(size_t)(lds + (bufoff)) + ldsw; \
        PG8_GLDS((voff)[0], gb_, la_); PG8_GLDS((voff)[1], gb_, la_ + 8192u); } while (0)
#define PG8_STAGE_A(bufoff, aptr, h, nx) do { if constexpr (GATHER) { const char* gb_ = (const char*)(aptr); const unsigned la_ = (unsigned)(size_t)(lds + (bufoff)) + ldsw; \
        PG8_GLDS(gC[h][0], gb_, la_); PG8_GLDS(gC[h][1], gb_, la_ + 8192u); } \
    else { PG8_STAGE(bufoff, (aptr) + (h) * hstep, voffA); } } while (0)
#define PG8_LDA(dst, b, h) do { _Pragma("unroll") for (int m = 0; m < 4; ++m) _Pragma("unroll") for (int k = 0; k < 2; ++k) dst[m].set(k, *(const PG8_LAS bf16x8*)(lds + PG8_SA(b, h) + aoff + m * 2048 + k * 1024)); } while (0)
#define PG8_LDB(dst, b, h) do { _Pragma("unroll") for (int n = 0; n < 2; ++n) _Pragma("unroll") for (int k = 0; k < 2; ++k) dst[n].set(k, *(const PG8_LAS bf16x8*)(lds + PG8_SB(b, h) + boff + n * 2048 + k * 1024)); } while (0)
#define PG8_MMA(ai, bj, At, Bt) do { __builtin_amdgcn_s_setprio(1); _Pragma("unroll") for (int m = 0; m < 4; ++m) _Pragma("unroll") for (int n = 0; n < 2; ++n) { \
        if constexpr (F8W != 0) acc[ai][bj][m][n] = __builtin_amdgcn_mfma_scale_f32_16x16x128_f8f6f4(Bt[n].v, At[m].v, acc[ai][bj][m][n], 0, 0, 0, 0, 0, 0);   \
        else { _Pragma("unroll") for (int k = 0; k < 2; ++k) acc[ai][bj][m][n] = __builtin_amdgcn_mfma_f32_16x16x32_bf16(Bt[n].v[k], At[m].v[k], acc[ai][bj][m][n], 0, 0, 0); } } __builtin_amdgcn_s_setprio(0); } while (0)
#define PG8_WAIT_V(n) asm volatile("s_waitcnt vmcnt(" #n ")" ::: "memory")
#define PG8_WAIT_L(n) asm volatile("s_waitcnt lgkmcnt(" #n ")" ::: "memory")
#define PG8_BAR __builtin_amdgcn_s_barrier()
#define PG8_SCHED __builtin_amdgcn_sched_barrier(0)
    Unit cur, nxt; int ui = 0;
    if (!S.next(0, cur)) return;
    f32x4 acc[2][2][4][2];
#define PG8_ZERO() do { _Pragma("unroll") for (int a = 0; a < 2; ++a) _Pragma("unroll") for (int b = 0; b < 2; ++b) _Pragma("unroll") for (int m = 0; m < 4; ++m) _Pragma("unroll") for (int n = 0; n < 2; ++n) \
        acc[a][b][m][n] = (f32x4){0.f, 0.f, 0.f, 0.f}; } while (0)
    PG8_ZERO();
    Frag<(F8W != 0)> At[4], B0[2], B1[2];
    const char* cA = GATHER ? (const char*)g.A : (const char*)g.A + (size_t)cur.pm * tstep; const char* cB = (const char*)g.Bt + (size_t)cur.pn * tstep;
    if constexpr (GATHER) { PG8_GFIRST(cur.pm); }
    S.a_ready(cur);
    E.prefetch(cur, wr, fr, rslot);
    if constexpr (SP2) {
        PG8_STAGE(PG8_SB(0, 0), cB, voffB); PG8_STAGE(PG8_SB(0, 1), cB + hstep, voffB); PG8_STAGE_A(PG8_SA(0, 0), cA, 0, false); PG8_STAGE_A(PG8_SA(0, 1), cA, 1, false);
        if (wr == 1) PG8_BAR;
        PG8_WAIT_V(2); PG8_BAR;
        PG8_STAGE(PG8_SB(1, 0), cB + kstep, voffB); PG8_STAGE_A(PG8_SA(1, 0), cA + kstep, 0, false); PG8_STAGE(PG8_SB(1, 1), cB + hstep + kstep, voffB);
        PG8_WAIT_V(6); PG8_BAR;
    } else {
        PG8_STAGE(PG8_SB(0, 0), cB, voffB); PG8_STAGE(PG8_SA(0, 0), cA, voffA); PG8_STAGE(PG8_SB(0, 1), cB + hstep, voffB); PG8_STAGE(PG8_SA(0, 1), cA + hstep, voffA);
        if (wr == 1) PG8_BAR;
        PG8_WAIT_V(4); PG8_BAR;
        PG8_STAGE(PG8_SB(1, 0), cB + kstep, voffB); PG8_STAGE(PG8_SA(1, 0), cA + kstep, voffA); PG8_STAGE(PG8_SB(1, 1), cB + hstep + kstep, voffB);
        PG8_WAIT_V(6); PG8_BAR;
    }
    for (;;) {
        const bool has_next = S.next(ui + 1, nxt);
        if constexpr (GATHER) { if (has_next) PG8_GISSUE(nxt.pm); }
        const char* nA = (has_next && !GATHER) ? (const char*)g.A + (size_t)nxt.pm * tstep : cA; const char* nB = has_next ? (const char*)g.Bt + (size_t)nxt.pn * tstep : cB;
#pragma unroll 1
        for (int t = 0; t < nt; t += 2) {
            const bool last = (t == nt - 2);
            const char* a1 = cA + (size_t)(t + 1) * kstep;
            const char* a2 = last ? nA : cA + (size_t)(t + 2) * kstep; const char* b2 = last ? nB : cB + (size_t)(t + 2) * kstep;
            const char* a3 = a2 + kstep; const char* b3 = b2 + kstep;
            if (last && has_next) S.a_ready(nxt);
            if constexpr (SP2) {
            PG8_LDB(B0, 0, 0); PG8_LDB(B1, 0, 1); PG8_SCHED; PG8_LDA(At, 0, 0); PG8_STAGE_A(PG8_SA(1, 1), a1, 1, false);
            if constexpr (GATHER) { if (last && has_next) PG8_GTAKE(nxt.pm); }
            PG8_WAIT_V(8); PG8_WAIT_L(0); PG8_BAR; PG8_MMA(0, 0, At, B0); PG8_MMA(0, 1, At, B1); PG8_BAR; PG8_SCHED;
            PG8_LDA(At, 0, 1); PG8_STAGE(PG8_SB(0, 0), b2, voffB); PG8_STAGE(PG8_SB(0, 1), b2 + hstep, voffB); PG8_STAGE_A(PG8_SA(0, 0), a2, 0, last);
            PG8_WAIT_V(8); PG8_WAIT_L(0); PG8_BAR; PG8_MMA(1, 0, At, B0); PG8_MMA(1, 1, At, B1); PG8_BAR; PG8_SCHED;
            PG8_LDB(B0, 1, 0); PG8_LDB(B1, 1, 1); PG8_SCHED; PG8_LDA(At, 1, 0); PG8_STAGE_A(PG8_SA(0, 1), a2, 1, last);
            PG8_WAIT_V(8); PG8_WAIT_L(0); PG8_BAR; PG8_MMA(0, 0, At, B0); PG8_MMA(0, 1, At, B1); PG8_BAR; PG8_SCHED;
            PG8_LDA(At, 1, 1); PG8_STAGE(PG8_SB(1, 0), b3, voffB); PG8_STAGE(PG8_SB(1, 1), b3 + hstep, voffB); PG8_STAGE_A(PG8_SA(1, 0), a3, 0, last);
            PG8_WAIT_V(8); PG8_WAIT_L(0); PG8_BAR; PG8_MMA(1, 0, At, B0); PG8_MMA(1, 1, At, B1); PG8_BAR; PG8_SCHED;
            } else {
            PG8_LDB(B0, 0, 0); PG8_SCHED; PG8_LDA(At, 0, 0); PG8_STAGE(PG8_SA(1, 1), a1 + hstep, voffA);
            PG8_WAIT_L(8); PG8_BAR; PG8_WAIT_L(0); PG8_MMA(0, 0, At, B0); PG8_BAR; PG8_SCHED;
            PG8_LDB(B1, 0, 1); PG8_STAGE(PG8_SB(0, 0), b2, voffB);
            PG8_BAR; PG8_WAIT_L(0); PG8_MMA(0, 1, At, B1); PG8_BAR;
            PG8_LDA(At, 0, 1); PG8_STAGE(PG8_SA(0, 0), a2, voffA);
            PG8_BAR; PG8_WAIT_L(0); PG8_MMA(1, 0, At, B0); PG8_BAR; PG8_SCHED;
            PG8_STAGE(PG8_SB(0, 1), b2 + hstep, voffB);
            PG8_WAIT_V(6); PG8_BAR; PG8_MMA(1, 1, At, B1); PG8_BAR;
            PG8_LDB(B0, 1, 0); PG8_SCHED; PG8_LDA(At, 1, 0); PG8_STAGE(PG8_SA(0, 1), a2 + hstep, voffA);
            PG8_WAIT_L(8); PG8_BAR; PG8_WAIT_L(0); PG8_MMA(0, 0, At, B0); PG8_BAR; PG8_SCHED;
            PG8_LDB(B1, 1, 1); PG8_STAGE(PG8_SB(1, 0), b3, voffB);
            PG8_BAR; PG8_WAIT_L(0); PG8_MMA(0, 1, At, B1); PG8_BAR;
            PG8_LDA(At, 1, 1); PG8_STAGE(PG8_SA(1, 0), a3, voffA);
            PG8_BAR; PG8_WAIT_L(0); PG8_MMA(1, 0, At, B0); PG8_BAR; PG8_SCHED;
            PG8_STAGE(PG8_SB(1, 1), b3 + hstep, voffB);
            PG8_WAIT_V(6); PG8_BAR; PG8_MMA(1, 1, At, B1); PG8_BAR;
            }
        }
        if constexpr (ALIGN_EPI) { if (wr == 0) PG8_BAR; }
        if constexpr (!Epi::AFTER_DRAIN) { const int le_ = fresh_lane(); E(acc, cur, wr, wc, le_ & 15, le_ >> 4); S.done(cur); }
        if (!has_next) break;
        PG8_ZERO();
        cur = nxt; cA = nA; cB = nB; ++ui;
        E.prefetch(cur, wr, fr, rslot);
        if constexpr (ALIGN_EPI) { if (wr == 1) PG8_BAR; }
    }
    PG8_WAIT_V(0);
    if constexpr (!ALIGN_EPI) { if (wr == 0) PG8_BAR; }
    PG8_BAR;
    if constexpr (Epi::AFTER_DRAIN) { E.fused(acc, cur, wr, wc, fr, fq, lds, wid, lane); S.done(cur); }
#undef PG8_ZERO
#undef PG8_SA
#undef PG8_SB
#undef PG8_STAGE
#undef PG8_GLDS
#undef PG8_STAGE_A
#undef PG8_TFRESH
#undef PG8_GFIRST
#undef PG8_GISSUE
#undef PG8_GTAKE
#undef PG8_LDA
#undef PG8_LDB
#undef PG8_MMA
#undef PG8_WAIT_V
#undef PG8_WAIT_L
#undef PG8_BAR
#undef PG8_SCHED
}
}
constexpr int BATCH = 8, SEQ = 8192, DM = 1024, T = BATCH * SEQ;
constexpr int INW = 2832, INW_G = 2816;
constexpr int NEXP = 16, CAP = 1024, FF = 1024, MEMT = 256;
constexpr int XROWS = BATCH * NEXP * CAP;
constexpr float EPS = 1e-6f;
constexpr float LOG2E = 1.4426950408889634f;

#define GAS __attribute__((address_space(1)))
#define LAS __attribute__((address_space(3)))
typedef unsigned short bf16;
typedef unsigned u32x4 __attribute__((ext_vector_type(4)));
typedef unsigned u32x2 __attribute__((ext_vector_type(2)));
typedef float f32x4 __attribute__((ext_vector_type(4)));
typedef float f32x2 __attribute__((ext_vector_type(2)));
typedef float f32x16 __attribute__((ext_vector_type(16)));
typedef short bf16x8 __attribute__((ext_vector_type(8)));
typedef short bf16x4 __attribute__((ext_vector_type(4)));

constexpr size_t MiB = 1u << 20;
constexpr size_t WS_CTL = 0;
constexpr size_t WS_GATES = 1 * MiB;
constexpr size_t WS_SSQAQ = 5 * MiB;
constexpr size_t WS_SSQAK = 9 * MiB;
constexpr size_t WS_SSQ1 = 10 * MiB;
constexpr size_t WS_SSQQ = 14 * MiB;
constexpr size_t WS_SSQ2 = 18 * MiB;
constexpr size_t WS_AFF = 22 * MiB;
constexpr size_t WS_SLOT = 26 * MiB;
constexpr size_t WS_N0 = 30 * MiB;
constexpr size_t WS_MEMN = 32 * MiB;
constexpr size_t WS_KVM = 36 * MiB;
constexpr size_t WS_SSQMK = 40 * MiB;
constexpr size_t WS_RINV2 = 40 * MiB + 256 * 1024;
constexpr size_t WS_IDX = 40 * MiB + 512 * 1024;
constexpr size_t WS_GVAL = 41 * MiB;
constexpr size_t WS_RINVE = 41 * MiB + 512 * 1024;
constexpr size_t WS_WST = 43 * MiB;
constexpr size_t WS_FTA = 45 * MiB;
constexpr size_t WS_RINVX = 47 * MiB + 64 * 1024;
constexpr size_t WS_DEC = 47 * MiB;
constexpr size_t WS_ESA = 60 * MiB;
constexpr size_t WS_WG16 = 42 * MiB;
constexpr size_t WS_WRHI = 42 * MiB + 64 * 1024;
constexpr size_t WS_WRLO = 42 * MiB + 128 * 1024;
constexpr size_t WS_WIN = 48 * MiB;
constexpr size_t WS_WOUT = 54 * MiB;
constexpr size_t WS_WMQ = 56 * MiB;
constexpr size_t WS_WKV = 57 * MiB;
constexpr size_t WS_WMO = 59 * MiB;
constexpr size_t WS_WGU = 64 * MiB;
constexpr size_t WS_WD = 128 * MiB;
constexpr size_t WS_A = 160 * MiB;
constexpr size_t WS_AQ = WS_A, WS_AK = WS_A + 64 * MiB, WS_AV = WS_A + 80 * MiB, WS_MQ = WS_A + 96 * MiB, WS_MK = WS_A + 160 * MiB, WS_MV = WS_A + 224 * MiB, WS_MO = WS_A + 288 * MiB;
constexpr size_t WS_XE = WS_A, WS_Y = WS_A;
constexpr size_t WS_B = 512 * MiB;
constexpr size_t WS_XN = WS_B, WS_MIX = WS_B, WS_QM = WS_B, WS_OM = WS_B + 64 * MiB;
constexpr size_t WS_C = 640 * MiB;
constexpr size_t WS_C0 = WS_C, WS_X1B = WS_C;
constexpr size_t WS_X2B = 768 * MiB;
constexpr size_t WS_HID = WS_B;
constexpr size_t WS_QC = 768 * MiB, WS_KC = 832 * MiB;
constexpr size_t WS_XB = 896 * MiB;
constexpr size_t WS_X2F8 = WS_A;
constexpr size_t WS_END = 1024 * MiB;
constexpr int F8_YSHIFT = 3;
constexpr int F8_WSHIFT = 5;

constexpr int LDS_BYTES = 155648;

__device__ __forceinline__ unsigned f2bf(float f) { unsigned u = __builtin_bit_cast(unsigned, f); return (u + 0x7fffu + ((u >> 16) & 1u)) >> 16; }
typedef __bf16 hwbf16x2 __attribute__((ext_vector_type(2)));
__device__ __forceinline__ unsigned pk2(float lo, float hi) { const f32x2 v = {lo, hi}; return __builtin_bit_cast(unsigned, __builtin_convertvector(v, hwbf16x2)); }
__device__ __forceinline__ float bf2f(unsigned short h) { return __builtin_bit_cast(float, (unsigned)h << 16); }
__device__ __forceinline__ float bflo(unsigned w) { return __builtin_bit_cast(float, w << 16); }
__device__ __forceinline__ float bfhi(unsigned w) { return __builtin_bit_cast(float, w & 0xffff0000u); }
__device__ __forceinline__ float wave_sum(float v) {
#pragma unroll
    for (int o = 1; o < 64; o <<= 1) v += __shfl_xor(v, o);
    return v;
}
__device__ __forceinline__ f32x16 mfma32(bf16x8 a, bf16x8 b, f32x16 c) { return __builtin_amdgcn_mfma_f32_32x32x16_bf16(a, b, c, 0, 0, 0); }
__device__ __forceinline__ f32x4 mfma16(bf16x8 a, bf16x8 b, f32x4 c) { return __builtin_amdgcn_mfma_f32_16x16x32_bf16(a, b, c, 0, 0, 0); }
#define LDS_WAIT() asm volatile("s_waitcnt lgkmcnt(0)" ::: "memory")

enum { I_X = 0, I_MEM, I_NORM_MIX_G, I_W_IN, I_ATT_Q_G, I_ATT_K_G, I_ATT_SINK, I_CONV_W, I_CONV_B, I_GATE_B, I_ML_OUT_G, I_W_OUT, I_NORM_MEM_G, I_MEM_KV_G,
       I_W_MEM_Q, I_W_MEM_KV, I_MEM_Q_G, I_MEM_K_G, I_W_MEM_O, I_NORM_FFN_G, I_W_ROUTER, I_B_ROUTER, I_W_GATE, I_W_UP, I_W_DOWN };
#define CAS __attribute__((address_space(4)))
struct Frame {
    LAS unsigned char* lds;
    int tid, lane, wave, bid, G;
    float* out; unsigned char* ws;
};
__device__ __forceinline__ const float* inp(int i) { const volatile CAS unsigned long long* ka = (const volatile CAS unsigned long long*)__builtin_amdgcn_kernarg_segment_ptr(); return (const float*)(const GAS float*)ka[i]; }
template <class Tp> __device__ __forceinline__ Tp* wsp(const Frame& F, size_t off) { return (Tp*)(GAS Tp*)(F.ws + off); }

namespace pg8 {
struct EpiInProj {
    static constexpr bool PERM = true, AFTER_DRAIN = false;
    unsigned char* ws; mutable float rpre[8];
    __device__ __forceinline__ void prefetch(const Unit& u, int wr, int fr, unsigned rslot) const { const float* rx = (const float*)(ws + WS_RINVX) + u.pm * BM + wr * 64 + fr;
#pragma unroll
        for (int i = 0; i < 8; ++i) rpre[i] = rx[(i >> 2) * HALF + (i & 3) * 16]; }
    __device__ __forceinline__ void operator()(const f32x4 (&acc)[2][2][4][2], const Unit& u, int wr, int wc, int fr, int fq) const {
        const int pn = u.pn;
        bf16_t* base[2]; int ld[2];
        if (pn < 2) { base[0] = (bf16_t*)(ws + WS_AQ) + 256 * pn; base[1] = base[0] + 128; ld[0] = ld[1] = 512; }
        else if (pn == 2) { base[0] = (bf16_t*)(ws + WS_AK); base[1] = (bf16_t*)(ws + WS_AV); ld[0] = ld[1] = 128; }
        else { const int s = (pn - 3) >> 1; base[0] = (bf16_t*)(ws + WS_MQ + (size_t)s * (64u << 20)) + 256 * ((pn - 3) & 1); base[1] = base[0] + 128; ld[0] = ld[1] = 512; }
        const int row0 = u.pm * BM + wr * 64 + fr, cw = wc * 32 + 8 * fq;
        float* sq = (float*)(ws + WS_SSQAQ); float* sk = (float*)(ws + WS_SSQAK);
#pragma unroll
        for (int ai = 0; ai < 2; ++ai)
#pragma unroll
            for (int m = 0; m < 4; ++m) {
                const int row = row0 + ai * HALF + m * 16; const float rs = rpre[ai * 4 + m];
#pragma unroll
                for (int bj = 0; bj < 2; ++bj) {
                    const f32x4 v0 = acc[ai][bj][m][0] * rs, v1 = acc[ai][bj][m][1] * rs;
                    u32x4 w; w.x = cvt_pk_bf16(v0[0], v0[1]); w.y = cvt_pk_bf16(v0[2], v0[3]); w.z = cvt_pk_bf16(v1[0], v1[1]); w.w = cvt_pk_bf16(v1[2], v1[3]);
                    *(GAS u32x4*)(base[bj] + (size_t)row * ld[bj] + cw) = w;
                    if (pn < 2 || (pn == 2 && bj == 0)) {
                        float s = (v0[0] * v0[0] + v0[1] * v0[1]) + (v0[2] * v0[2] + v0[3] * v0[3]) + (v1[0] * v1[0] + v1[1] * v1[1]) + (v1[2] * v1[2] + v1[3] * v1[3]);
                        s += __shfl_xor(s, 16); s += __shfl_xor(s, 32);
                        if (fq == 0) { if (pn < 2) sq[(size_t)((pn * 4 + bj * 2 + (wc >> 1)) * 2 + (wc & 1)) * T + row] = s; else sk[(size_t)wc * T + row] = s; }
                    }
                }
            }
    }
};
template <bool ROWSCALE> struct EpiHead128 {
    static constexpr bool PERM = true, AFTER_DRAIN = false;
    bf16_t* O; int ldc; const float* ssq_in; float* ssq_out; int nssq_tiles; int nrows;
    mutable float rpre[8];
    __device__ __forceinline__ void prefetch(const Unit& u, int wr, int fr, unsigned rslot) const {
        if (ROWSCALE) {
#pragma unroll
            for (int i = 0; i < 8; ++i) { const int row = u.pm * BM + wr * 64 + fr + (i >> 2) * HALF + (i & 3) * 16;
                float t = 0.f;
#pragma unroll
                for (int q = 0; q < 16; ++q) t += ssq_in[(size_t)q * nrows + row];
                rpre[i] = 1.0f / sqrtf(t * (1.0f / 1024.0f) + 1e-6f); }
        }
    }
    __device__ __forceinline__ void operator()(const f32x4 (&acc)[2][2][4][2], const Unit& u, int wr, int wc, int fr, int fq) const {
        const int row0 = u.pm * BM + wr * 64 + fr, col0 = u.pn * BM + wc * 32 + 8 * fq;
#pragma unroll
        for (int ai = 0; ai < 2; ++ai)
#pragma unroll
            for (int m = 0; m < 4; ++m) {
                const int row = row0 + ai * HALF + m * 16;
                const float rs = ROWSCALE ? rpre[ai * 4 + m] : 1.f;
#pragma unroll
                for (int bj = 0; bj < 2; ++bj) {
                    const f32x4 v0 = acc[ai][bj][m][0] * rs, v1 = acc[ai][bj][m][1] * rs;
                    u32x4 w; w.x = cvt_pk_bf16(v0[0], v0[1]); w.y = cvt_pk_bf16(v0[2], v0[3]); w.z = cvt_pk_bf16(v1[0], v1[1]); w.w = cvt_pk_bf16(v1[2], v1[3]);
                    *(u32x4*)(O + (size_t)row * ldc + col0 + bj * HALF) = w;
                    if (u.pn < nssq_tiles) {
                        float s = (v0[0] * v0[0] + v0[1] * v0[1]) + (v0[2] * v0[2] + v0[3] * v0[3]) + (v1[0] * v1[0] + v1[1] * v1[1]) + (v1[2] * v1[2] + v1[3] * v1[3]);
                        s += __shfl_xor(s, 16); s += __shfl_xor(s, 32);
                        if (fq == 0) ssq_out[(size_t)((2 * u.pn + bj) * 4 + wc) * nrows + row] = s;
                    }
                }
            }
    }
};
template <bool BASE_BF16, bool F8COPY = false> struct EpiResid {
    static constexpr bool PERM = true, AFTER_DRAIN = false;
    const void* base; bf16_t* outb; float* ssq; unsigned char* out8;
    __device__ __forceinline__ void prefetch(const Unit&, int, int, unsigned) const {}
    __device__ __forceinline__ void operator()(const f32x4 (&acc)[2][2][4][2], const Unit& u, int wr, int wc, int fr, int fq) const {
        const int row0 = u.pm * BM + wr * 64 + fr, col0 = u.pn * BM + wc * 32 + 8 * fq;
#pragma unroll
        for (int ai = 0; ai < 2; ++ai)
#pragma unroll
            for (int m = 0; m < 4; ++m) {
                const int row = row0 + ai * HALF + m * 16; const size_t off = (size_t)row * 1024 + col0;
                float s = 0.f;
#pragma unroll
                for (int bj = 0; bj < 2; ++bj) {
                    f32x4 b0, b1;
                    if (BASE_BF16) { const u32x4 bw = *(const u32x4*)((const bf16_t*)base + off + bj * HALF);
                        b0[0] = __builtin_bit_cast(float, bw.x << 16); b0[1] = __builtin_bit_cast(float, bw.x & 0xffff0000u); b0[2] = __builtin_bit_cast(float, bw.y << 16); b0[3] = __builtin_bit_cast(float, bw.y & 0xffff0000u);
                        b1[0] = __builtin_bit_cast(float, bw.z << 16); b1[1] = __builtin_bit_cast(float, bw.z & 0xffff0000u); b1[2] = __builtin_bit_cast(float, bw.w << 16); b1[3] = __builtin_bit_cast(float, bw.w & 0xffff0000u); }
                    else { b0 = *(const f32x4*)((const float*)base + off + bj * HALF); b1 = *(const f32x4*)((const float*)base + off + bj * HALF + 4); }
                    const f32x4 v0 = acc[ai][bj][m][0] + b0, v1 = acc[ai][bj][m][1] + b1;
                    u32x4 w; w.x = cvt_pk_bf16(v0[0], v0[1]); w.y = cvt_pk_bf16(v0[2], v0[3]); w.z = cvt_pk_bf16(v1[0], v1[1]); w.w = cvt_pk_bf16(v1[2], v1[3]);
                    *(u32x4*)(outb + off + bj * HALF) = w;
                    if constexpr (F8COPY) { u32x2 w8; w8.x = cvt_pk4_fp8(v0[0], v0[1], v0[2], v0[3]); w8.y = cvt_pk4_fp8(v1[0], v1[1], v1[2], v1[3]); *(u32x2*)(out8 + off + bj * HALF) = w8; }
                    s += (v0[0] * v0[0] + v0[1] * v0[1]) + (v0[2] * v0[2] + v0[3] * v0[3]) + (v1[0] * v1[0] + v1[1] * v1[1]) + (v1[2] * v1[2] + v1[3] * v1[3]);
                }
                s += __shfl_xor(s, 16); s += __shfl_xor(s, 32);
                if (ssq != nullptr && fq == 0) ssq[(size_t)(u.pn * 4 + wc) * T + row] = s;
            }
    }
};
__device__ __forceinline__ void rows_to_lds(const float* src, unsigned slot) {
    const unsigned vo = (unsigned)fresh_lane() * 4u;
#pragma unroll
    for (int j = 0; j < 4; ++j) asm volatile("s_mov_b32 m0, %2\n\ts_nop 0\n\tglobal_load_lds_dword %0, %1" :: "v"(vo), "s"(src + 64 * j), "s"(slot + 256u * j) : "memory", "m0");
}
template <bool F8OUT, int PREF = 1> struct EpiGateUpT {
    static constexpr bool PERM = true, AFTER_DRAIN = false;
    bf16_t* H; const float* rinv; float oscale; mutable float rpre[8]; mutable unsigned rs;
    __device__ __forceinline__ void prefetch(const Unit& u, int wr, int fr, unsigned rslot) const { if constexpr (PREF == 0) return; if constexpr (PREF == 2) { rs = rslot; rows_to_lds(rinv + u.pm * BM, rslot); return; } const float* p = rinv + u.pm * BM + wr * 64 + fr;
#pragma unroll
        for (int i = 0; i < 8; ++i) rpre[i] = p[(i >> 2) * HALF + (i & 3) * 16]; }
    __device__ __forceinline__ void operator()(const f32x4 (&acc)[2][2][4][2], const Unit& u, int wr, int wc, int fr, int fq) const {
        const int row0 = u.pm * BM + wr * 64 + fr, col0 = (u.pn & 7) * 128 + wc * 32 + 8 * fq;
#pragma unroll
        for (int ai = 0; ai < 2; ++ai)
#pragma unroll
            for (int m = 0; m < 4; ++m) {
                const int row = row0 + ai * HALF + m * 16; const float r = (PREF == 1 ? rpre[ai * 4 + m] : PREF == 2 ? ((const LAS float*)(size_t)rs)[ai * HALF + wr * 64 + m * 16 + fr] : rinv[row]) * oscale;
                const f32x2 rr2 = {r * r, r * r}, rl2 = {r * -1.4426950408889634f, r * -1.4426950408889634f}, one2 = {1.0f, 1.0f};
                float h[8];
#pragma unroll
                for (int n = 0; n < 2; ++n)
#pragma unroll
                    for (int e = 0; e < 4; e += 2) { const f32x2 g2 = {acc[ai][0][m][n][e], acc[ai][0][m][n][e + 1]}, u2 = {acc[ai][1][m][n][e], acc[ai][1][m][n][e + 1]};
                        const f32x2 p2 = (g2 * u2) * rr2, t2 = g2 * rl2; f32x2 d2 = {__builtin_amdgcn_exp2f(t2[0]), __builtin_amdgcn_exp2f(t2[1])}; d2 = d2 + one2;
                        const f32x2 q2 = {__builtin_amdgcn_rcpf(d2[0]), __builtin_amdgcn_rcpf(d2[1])}, h2 = p2 * q2; h[n * 4 + e] = h2[0]; h[n * 4 + e + 1] = h2[1]; }
                if constexpr (F8OUT) {
                    u32x2 w; w.x = cvt_pk4_fp8(h[0], h[1], h[2], h[3]); w.y = cvt_pk4_fp8(h[4], h[5], h[6], h[7]);
                    *(u32x2*)((unsigned char*)H + (size_t)row * 1024 + col0) = w;
                } else {
                    u32x4 w; w.x = cvt_pk_bf16(h[0], h[1]); w.y = cvt_pk_bf16(h[2], h[3]); w.z = cvt_pk_bf16(h[4], h[5]); w.w = cvt_pk_bf16(h[6], h[7]);
                    *(u32x4*)(H + (size_t)row * 1024 + col0) = w;
                }
            }
    }
};
using EpiGateUp = EpiGateUpT<false>;
template <int PREF, bool F8Y = false> struct EpiDownT {
    static constexpr bool PERM = true, AFTER_DRAIN = false;
    bf16_t* Y; const float* gval; float oscale; mutable float rpre[8]; mutable unsigned rs;
    __device__ __forceinline__ void prefetch(const Unit& u, int wr, int fr, unsigned rslot) const { if constexpr (PREF == 0) return; if constexpr (PREF == 2) { rs = rslot; rows_to_lds(gval + u.pm * BM, rslot); return; } const float* p = gval + u.pm * BM + wr * 64 + fr;
#pragma unroll
        for (int i = 0; i < 8; ++i) rpre[i] = p[(i >> 2) * HALF + (i & 3) * 16]; }
    __device__ __forceinline__ void operator()(const f32x4 (&acc)[2][2][4][2], const Unit& u, int wr, int wc, int fr, int fq) const {
        int row0 = u.pm * BM + wr * 64 + fr, col0 = (u.pn & 3) * BM + wc * 32 + 8 * fq;
        asm volatile("" : "+v"(row0), "+v"(col0));
#pragma unroll
        for (int ai = 0; ai < 2; ++ai)
#pragma unroll
            for (int m = 0; m < 4; ++m) {
                const int row = row0 + ai * HALF + m * 16; const float r = (PREF == 1 ? rpre[ai * 4 + m] : PREF == 2 ? ((const LAS float*)(size_t)rs)[ai * HALF + wr * 64 + m * 16 + fr] : gval[row]) * oscale;
#pragma unroll
                for (int bj = 0; bj < 2; ++bj) {
                    const f32x4 v0 = acc[ai][bj][m][0] * r, v1 = acc[ai][bj][m][1] * r;
                    if constexpr (F8Y) { u32x2 w8; w8.x = cvt_pk4_fp8(v0[0], v0[1], v0[2], v0[3]); w8.y = cvt_pk4_fp8(v1[0], v1[1], v1[2], v1[3]); *(u32x2*)((unsigned char*)Y + (size_t)row * 1024 + col0 + bj * HALF) = w8; }
                    else { u32x4 w; w.x = cvt_pk_bf16(v0[0], v0[1]); w.y = cvt_pk_bf16(v0[2], v0[3]); w.z = cvt_pk_bf16(v1[0], v1[1]); w.w = cvt_pk_bf16(v1[2], v1[3]);
                        *(u32x4*)(Y + (size_t)row * 1024 + col0 + bj * HALF) = w; }
                }
            }
    }
};
using EpiDown = EpiDownT<1>;
template <int NT> struct ExpertOrder {
    int G, c;
    __device__ bool next(int i, Unit& u) const {
        constexpr int UPG = 4 * NT, NU = 128 * UPG;
        const int L = i * G + c; if (L >= NU) return false;
        const int xcd = L & 7, off = L >> 3, idx = xcd * (NU / 8) + off;
        const int g = idx / UPG, w = idx % UPG, e = g >> 3, b = g & 7;
        u.pm = (b * 16 + e) * 4 + (w & 3); u.pn = e * NT + (w >> 2); return true;
    }
    __device__ __forceinline__ void a_ready(const Unit&) const {}
    __device__ __forceinline__ void done(const Unit&) const {}
};
}
#define XB_TMO      128
#define XB_XCNT(j)  (256  + 64 * (j))
#define XB_XSUB(j)  (1280 + 64 * (j))
#define XB_XGEN(j)  (2304 + 64 * (j))
#define XB_TOP      3328
#define XB_TOPGEN   3392
#define XCD_BAR_WORDS 3456
#define XB_SPIN_CAP (1u << 18)

__device__ __forceinline__ unsigned xb_ld(unsigned* p)              { return __hip_atomic_load(p, __ATOMIC_RELAXED, __HIP_MEMORY_SCOPE_AGENT); }
__device__ __forceinline__ unsigned xb_add(unsigned* p, unsigned v) { return __hip_atomic_fetch_add(p, v, __ATOMIC_RELAXED, __HIP_MEMORY_SCOPE_AGENT); }
__device__ __forceinline__ unsigned xb_xcc_id() { return (unsigned)__builtin_amdgcn_s_getreg((3 << 11) | 20) & 0xFu; }
#define XB_SPIN(cond, bar) do { unsigned _sp = 0; while (cond) { __builtin_amdgcn_s_sleep(1); \
    if ((++_sp & 255u) == 0u) { if (xb_ld(&(bar)[XB_TMO])) break; if (_sp > XB_SPIN_CAP) { atomicAdd(&(bar)[XB_TMO], 1u); break; } } } } while (0)

struct XcdBarrier {
    unsigned* bar; unsigned x;
    volatile LAS unsigned* st;
};

__device__ __forceinline__ XcdBarrier xcd_barrier_post(unsigned* bar, volatile LAS unsigned* st, bool leader) {
    XcdBarrier b; b.bar = bar; b.x = xb_xcc_id(); b.st = st;
    if (leader) (void)xb_add(&bar[XB_XCNT(b.x)], 1u);
    return b;
}
__device__ __forceinline__ void xcd_barrier_complete(unsigned* bar, unsigned x, unsigned& nloc, unsigned& nx) {
    const unsigned G = gridDim.x * gridDim.y * gridDim.z;
    unsigned sum, cnt, mine, sp = 0u;
    for (;;) {
        sum = 0u; cnt = 0u; mine = 0u;
#pragma unroll
        for (unsigned j = 0; j < 16; ++j) { const unsigned c = xb_ld(&bar[XB_XCNT(j)]); sum += c; cnt += (c > 0u) ? 1u : 0u; mine = (j == x) ? c : mine; }
        if (sum == G) break;
        __builtin_amdgcn_s_sleep(1);
        if ((++sp & 255u) == 0u) { if (xb_ld(&bar[XB_TMO])) break; if (sp > XB_SPIN_CAP) { atomicAdd(&bar[XB_TMO], 1u); break; } }
    }
    nloc = mine > 0u ? mine : 1u; nx = cnt > 0u ? cnt : 1u;
}

__device__ __forceinline__ void xcd_barrier(const XcdBarrier& b, bool leader) {
    asm volatile("s_waitcnt vmcnt(0)" ::: "memory");
    __syncthreads();
    if (leader) {
        unsigned* bar = b.bar;
        __builtin_amdgcn_s_waitcnt(0);
        unsigned nloc = b.st[0], nx = b.st[1];
        if (nloc == 0u) { xcd_barrier_complete(bar, b.x, nloc, nx); b.st[0] = nloc; b.st[1] = nx; }
        const unsigned old = xb_add(&bar[XB_XSUB(b.x)], 1u);
        const unsigned gen = old / nloc;
        if (old + 1u == (gen + 1u) * nloc) {
            __builtin_amdgcn_fence(__ATOMIC_RELEASE, "agent");
            asm volatile("s_waitcnt vmcnt(0)" ::: "memory");
            const unsigned og = xb_add(&bar[XB_TOP], 1u);
            const unsigned tg = og / nx;
            if (og + 1u == (tg + 1u) * nx) xb_add(&bar[XB_TOPGEN], 1u);
            else XB_SPIN(xb_ld(&bar[XB_TOPGEN]) == tg, bar);
            __builtin_amdgcn_fence(__ATOMIC_ACQUIRE, "agent");
            xb_add(&bar[XB_XGEN(b.x)], 1u);
            asm volatile("s_waitcnt vmcnt(0)" ::: "memory");
        } else {
            XB_SPIN(xb_ld(&bar[XB_XGEN(b.x)]) == gen, bar);
            __builtin_amdgcn_fence(__ATOMIC_ACQUIRE, "agent");
            asm volatile("s_waitcnt vmcnt(0)" ::: "memory");
        }
    }
    __syncthreads();
}

template <class RowMap> __device__ __forceinline__ void tr_tile(const float* W, int N, int k0, int n0, bf16* WT, int K, const float* kscale, LAS unsigned char* tile, int lane, RowMap rowmap) {
    const int ksub = lane >> 4, n4 = (lane & 15) * 4;
    const float* src = W + (size_t)(k0 + ksub) * N + n0 + n4;
    f32x4 v[16];
#pragma unroll
    for (int i = 0; i < 16; ++i) v[i] = *(const f32x4*)(src + (size_t)(4 * i) * N);
    if (kscale) {
#pragma unroll
        for (int i = 0; i < 16; ++i) v[i] = v[i] * kscale[k0 + 4 * i + ksub];
    }
    LAS unsigned short* t = (LAS unsigned short*)tile;
#pragma unroll
    for (int i = 0; i < 16; ++i) { const unsigned p0 = pk2(v[i][0], v[i][1]), p1 = pk2(v[i][2], v[i][3]); const int k = 4 * i + ksub;
        t[(n4 + 0) * 72 + k] = (unsigned short)(p0 & 0xffffu); t[(n4 + 1) * 72 + k] = (unsigned short)(p0 >> 16);
        t[(n4 + 2) * 72 + k] = (unsigned short)(p1 & 0xffffu); t[(n4 + 3) * 72 + k] = (unsigned short)(p1 >> 16); }
    LDS_WAIT(); asm volatile("" ::: "memory");
    const int ch = lane & 7;
#pragma unroll
    for (int j = 0; j < 8; ++j) { const int n = (lane >> 3) + 8 * j;
        const u32x4 o = *(const LAS u32x4*)(tile + n * 144 + ch * 16);
        *(u32x4*)(WT + (size_t)rowmap(n0 + n) * K + k0 + 8 * ch) = o; }
    LDS_WAIT(); asm volatile("" ::: "memory");
}
template <class RowMap> __device__ __forceinline__ void tr_tile8(const float* W, int N, int k0, int n0, unsigned char* WT, int K, const float* kscale, float wscale, LAS unsigned char* tile, int lane, RowMap rowmap) {
    const int ksub = lane >> 4, n4 = (lane & 15) * 4;
#pragma unroll 1
    for (int half = 0; half < 2; ++half) {
        const float* src = W + (size_t)(k0 + 64 * half + ksub) * N + n0 + n4;
        f32x4 v[16];
#pragma unroll
        for (int i = 0; i < 16; ++i) v[i] = *(const f32x4*)(src + (size_t)(4 * i) * N);
#pragma unroll
        for (int i = 0; i < 16; ++i) v[i] = v[i] * (kscale ? kscale[k0 + 64 * half + 4 * i + ksub] * wscale : wscale);
#pragma unroll
        for (int i = 0; i < 16; ++i) { const unsigned p = pg8::cvt_pk4_fp8(v[i][0], v[i][1], v[i][2], v[i][3]); const int k = 64 * half + 4 * i + ksub;
            tile[(n4 + 0) * 144 + k] = (unsigned char)(p & 0xffu); tile[(n4 + 1) * 144 + k] = (unsigned char)((p >> 8) & 0xffu);
            tile[(n4 + 2) * 144 + k] = (unsigned char)((p >> 16) & 0xffu); tile[(n4 + 3) * 144 + k] = (unsigned char)(p >> 24); }
    }
    LDS_WAIT(); asm volatile("" ::: "memory");
    const int ch = lane & 7;
#pragma unroll
    for (int j = 0; j < 8; ++j) { const int n = (lane >> 3) + 8 * j;
        const u32x4 o = *(const LAS u32x4*)(tile + n * 144 + ch * 16);
        *(u32x4*)(WT + (size_t)rowmap(n0 + n) * K + k0 + 16 * ch) = o; }
    LDS_WAIT(); asm volatile("" ::: "memory");
}
struct RowId { __device__ __forceinline__ int operator()(int n) const { return n; } };
struct RowOff { int off; __device__ __forceinline__ int operator()(int n) const { return off + n; } };
struct RowGateUp { int e, which; __device__ __forceinline__ int operator()(int n) const { return e * 2048 + 256 * (n >> 7) + 128 * which + (n & 127); } };
__device__ __forceinline__ void rms_row_to_bf16(const float* xrow, const float* g, bf16* orow, int lane) {
    const f32x4* xr = (const f32x4*)xrow + lane; const f32x4* gr = (const f32x4*)g + lane;
    f32x4 v[4]; float s = 0.f;
#pragma unroll
    for (int j = 0; j < 4; ++j) { v[j] = xr[64 * j]; s += (v[j][0] * v[j][0] + v[j][1] * v[j][1]) + (v[j][2] * v[j][2] + v[j][3] * v[j][3]); }
    const float r = 1.0f / sqrtf(wave_sum(s) * (1.0f / 1024.0f) + EPS);
    u32x2* o8 = (u32x2*)orow + lane;
#pragma unroll
    for (int j = 0; j < 4; ++j) { const f32x4 gg = gr[64 * j]; u32x2 w; w.x = pk2(v[j][0] * r * gg[0], v[j][1] * r * gg[1]); w.y = pk2(v[j][2] * r * gg[2], v[j][3] * r * gg[3]); o8[64 * j] = w; }
}
__device__ __forceinline__ void x_row2_to_bf16(const float* xrow, bf16* orow, float* rinv, int lane) {
    const f32x4* xr = (const f32x4*)xrow + lane;
    f32x4 v[8]; float s0 = 0.f, s1 = 0.f;
#pragma unroll
    for (int j = 0; j < 8; ++j) v[j] = xr[64 * j];
    u32x2* o8 = (u32x2*)orow + lane;
#pragma unroll
    for (int j = 0; j < 8; ++j) { u32x2 w; w.x = pk2(v[j][0], v[j][1]); w.y = pk2(v[j][2], v[j][3]); o8[64 * j] = w; }
#pragma unroll
    for (int j = 0; j < 4; ++j) { s0 += (v[j][0] * v[j][0] + v[j][1] * v[j][1]) + (v[j][2] * v[j][2] + v[j][3] * v[j][3]);
                                  s1 += (v[j + 4][0] * v[j + 4][0] + v[j + 4][1] * v[j + 4][1]) + (v[j + 4][2] * v[j + 4][2] + v[j + 4][3] * v[j + 4][3]); }
#pragma unroll
    for (int o = 1; o < 64; o <<= 1) { s0 += __shfl_xor(s0, o); s1 += __shfl_xor(s1, o); }
    if (lane == 0) { rinv[0] = 1.0f / sqrtf(s0 * (1.0f / 1024.0f) + EPS); rinv[1] = 1.0f / sqrtf(s1 * (1.0f / 1024.0f) + EPS); }
}
__device__ __forceinline__ void prep_weights(Frame& F) {
    const float* w_in = inp(I_W_IN); const float* norm_ffn_g = inp(I_NORM_FFN_G);
    const int gw = F.bid * 8 + F.wave, NGW = F.G * 8, lane = F.lane;
    LAS unsigned char* tile = F.lds + F.wave * 9216;
    constexpr int I_IN = 16 * 44, I_OUT = 16 * 16, I_MQ = 16 * 8, I_KV = 16 * 16, I_MO = 8 * 16, I_EX = 16 * 16 * 16;
    constexpr int I_EX8 = I_EX / 2;
    constexpr int NITEMS = I_IN + I_OUT + I_MQ + I_KV + I_MO + 3 * I_EX8;
    for (int it = gw; it < NITEMS; it += NGW) {
        int r = it;
        if (r < I_IN) { const int kb = r / 44, nb = r % 44; tr_tile(w_in, INW, 64 * kb, 64 * nb, wsp<bf16>(F, WS_WIN), 1024, inp(I_NORM_MIX_G), tile, lane, RowId{}); continue; } r -= I_IN;
        if (r < I_OUT) { const int kb = r / 16, nb = r % 16; tr_tile(inp(I_W_OUT), 1024, 64 * kb, 64 * nb, wsp<bf16>(F, WS_WOUT), 1024, nullptr, tile, lane, RowId{}); continue; } r -= I_OUT;
        if (r < I_MQ) { const int kb = r / 8, nb = r % 8; tr_tile(inp(I_W_MEM_Q), 512, 64 * kb, 64 * nb, wsp<bf16>(F, WS_WMQ), 1024, inp(I_NORM_MEM_G), tile, lane, RowId{}); continue; } r -= I_MQ;
        if (r < I_KV) { const int kb = r / 16, nb = r % 16; tr_tile(inp(I_W_MEM_KV), 1024, 64 * kb, 64 * nb, wsp<bf16>(F, WS_WKV), 1024, nullptr, tile, lane, RowId{}); continue; } r -= I_KV;
        if (r < I_MO) { const int kb = r / 16, nb = r % 16; tr_tile(inp(I_W_MEM_O), 1024, 64 * kb, 64 * nb, wsp<bf16>(F, WS_WMO), 512, nullptr, tile, lane, RowId{}); continue; } r -= I_MO;
        if (r < 2 * I_EX8) {
            const int which = r / I_EX8; const int q = r % I_EX8; const int e = q / 128, kb = (q % 128) / 16, nb = q % 16;
            const float* W = (which ? inp(I_W_UP) : inp(I_W_GATE)) + (size_t)e * 1024 * 1024;
            tr_tile8(W, 1024, 128 * kb, 64 * nb, wsp<unsigned char>(F, WS_WGU), 1024, norm_ffn_g, (float)(1 << F8_WSHIFT), tile, lane, RowGateUp{e, which}); continue; }
        r -= 2 * I_EX8;
        { const int e = r / 128, kb = (r % 128) / 16, nb = r % 16;
          tr_tile8(inp(I_W_DOWN) + (size_t)e * 1024 * 1024, 1024, 128 * kb, 64 * nb, wsp<unsigned char>(F, WS_WD), 1024, nullptr, (float)(1 << F8_WSHIFT), tile, lane, RowOff{e * 1024}); }
    }
}
__device__ __forceinline__ void prep_small(Frame& F) {
    const float* w_in = inp(I_W_IN); const float* norm_ffn_g = inp(I_NORM_FFN_G); const float* norm_mix_g = inp(I_NORM_MIX_G);
    {
        const int gt = F.bid * 512 + F.tid, NGT = F.G * 512; const float* w_router = inp(I_W_ROUTER);
        for (int it = gt; it < 2 * 16 * 128; it += NGT) {
            const int which = it >> 11, q = it & 2047, n = q >> 7, c = q & 127;
            float v[8];
#pragma unroll
            for (int j = 0; j < 8; ++j) { const int k = 8 * c + j; v[j] = which ? w_router[(size_t)k * 16 + n] * norm_ffn_g[k] : w_in[(size_t)k * INW + INW_G + n] * norm_mix_g[k]; }
            u32x4 hi; hi.x = pk2(v[0], v[1]); hi.y = pk2(v[2], v[3]); hi.z = pk2(v[4], v[5]); hi.w = pk2(v[6], v[7]);
            if (!which) *(u32x4*)(wsp<bf16>(F, WS_WG16) + n * 1024 + 8 * c) = hi;
            else {
                *(u32x4*)(wsp<bf16>(F, WS_WRHI) + n * 1024 + 8 * c) = hi;
                float l[8]; const unsigned hw[4] = {hi.x, hi.y, hi.z, hi.w};
#pragma unroll
                for (int j = 0; j < 8; ++j) l[j] = v[j] - ((j & 1) ? bfhi(hw[j >> 1]) : bflo(hw[j >> 1]));
                u32x4 lo; lo.x = pk2(l[0], l[1]); lo.y = pk2(l[2], l[3]); lo.z = pk2(l[4], l[5]); lo.w = pk2(l[6], l[7]);
                *(u32x4*)(wsp<bf16>(F, WS_WRLO) + n * 1024 + 8 * c) = lo;
            }
        }
    }
}
__device__ __forceinline__ void prep_rows(Frame& F) {
    const int gw = F.bid * 8 + F.wave, NGW = F.G * 8, lane = F.lane;
    { const float* x = inp(I_X); bf16* XB = wsp<bf16>(F, WS_XB); float* RX = wsp<float>(F, WS_RINVX);
    for (int m = 2 * gw; m < T; m += 2 * NGW) x_row2_to_bf16(x + (size_t)m * 1024, XB + (size_t)m * 1024, RX + m, lane); }
    { const float* mem = inp(I_MEM); const float* g = inp(I_MEM_KV_G);
    for (int m = gw; m < BATCH * MEMT; m += NGW) rms_row_to_bf16(mem + (size_t)m * 1024, g, wsp<bf16>(F, WS_MEMN) + (size_t)m * 1024, lane); }
}

__device__ __forceinline__ void phase_gates(Frame& F, int first_block) {
    const int gw = (F.bid - first_block) * 8 + F.wave, NGW = (F.G - first_block) * 8, lane = F.lane, r16 = lane & 15, kg = lane >> 4;
    if (F.bid < first_block) return;
    const bf16* XN = wsp<bf16>(F, WS_XB); const float* RX = wsp<float>(F, WS_RINVX); const bf16* WG = wsp<bf16>(F, WS_WG16) + r16 * 1024 + 8 * kg; float* GA = wsp<float>(F, WS_GATES);
    const float gb = inp(I_GATE_B)[r16];
    for (int task = gw; task < T / 16; task += NGW) {
        const bf16* a = XN + (size_t)(task * 16 + r16) * 1024 + 8 * kg;
        f32x4 acc = {0.f, 0.f, 0.f, 0.f};
#pragma unroll 8
        for (int s = 0; s < 32; ++s) { const bf16x8 av = *(const bf16x8*)(a + 32 * s), bv = *(const bf16x8*)(WG + 32 * s); acc = mfma16(av, bv, acc); }
#pragma unroll
        for (int r = 0; r < 4; ++r) GA[(size_t)(task * 16 + 4 * kg + r) * 16 + r16] = acc[r] * RX[task * 16 + 4 * kg + r] + gb;
    }
}
__device__ __forceinline__ void phase_router(Frame& F) {
    const int gw = F.bid * 8 + F.wave, NGW = F.G * 8, lane = F.lane, r16 = lane & 15, kg = lane >> 4;
    const bf16* WH = wsp<bf16>(F, WS_WRHI) + r16 * 1024 + 8 * kg; const bf16* WL = wsp<bf16>(F, WS_WRLO) + r16 * 1024 + 8 * kg;
    float* AFF = wsp<float>(F, WS_AFF); float* RINV2 = wsp<float>(F, WS_RINV2); const bf16* X2B = wsp<bf16>(F, WS_X2B);
    const float br = inp(I_B_ROUTER)[r16];
    for (int task = gw; task < T / 16; task += NGW) {
        const bf16* a = X2B + (size_t)(task * 16 + r16) * 1024 + 8 * kg;
        f32x4 acc = {0.f, 0.f, 0.f, 0.f}; float ss = 0.f;
#pragma unroll 8
        for (int s = 0; s < 32; ++s) {
            const u32x4 xw = *(const u32x4*)(a + 32 * s);
            const float x0 = bflo(xw.x), x1 = bfhi(xw.x), x2 = bflo(xw.y), x3 = bfhi(xw.y), x4 = bflo(xw.z), x5 = bfhi(xw.z), x6 = bflo(xw.w), x7 = bfhi(xw.w);
            ss += (x0 * x0 + x1 * x1) + (x2 * x2 + x3 * x3) + (x4 * x4 + x5 * x5) + (x6 * x6 + x7 * x7);
            const bf16x8 av = __builtin_bit_cast(bf16x8, xw);
            const bf16x8 bh = *(const bf16x8*)(WH + 32 * s), bl = *(const bf16x8*)(WL + 32 * s);
            acc = mfma16(av, bh, acc); acc = mfma16(av, bl, acc);
        }
        ss += __shfl_xor(ss, 16); ss += __shfl_xor(ss, 32);
        const float rinv = 1.0f / sqrtf(ss * (1.0f / 1024.0f) + EPS);
        if (kg == 0) RINV2[task * 16 + r16] = rinv;
        f32x4 p;
#pragma unroll
        for (int r = 0; r < 4; ++r) {
            const float rr = __shfl(rinv, 4 * kg + r);
            const float lg = acc[r] * rr + br;
            float mx = lg;
#pragma unroll
            for (int o = 1; o < 16; o <<= 1) mx = fmaxf(mx, __shfl_xor(mx, o));
            const float ex = __expf(lg - mx); float sm = ex;
#pragma unroll
            for (int o = 1; o < 16; o <<= 1) sm += __shfl_xor(sm, o);
            p[r] = ex / sm;
        }
        const int t0 = task * 16 + 4 * kg, b = t0 >> 13, s0 = t0 & 8191;
        *(f32x4*)(AFF + ((size_t)(b * 16 + r16) << 13) + s0) = p;
    }
}
template <int D> __device__ __forceinline__ f32x16 st_tile(const LAS unsigned char* kp, const bf16x8* qf) {
    f32x16 acc;
#pragma unroll
    for (int i = 0; i < 16; ++i) acc[i] = 0.f;
#pragma unroll
    for (int ks = 0; ks < D / 16; ++ks) acc = mfma32(*(const LAS bf16x8*)(kp + ks * 32), qf[ks], acc);
    return acc;
}
__device__ __forceinline__ bf16x8 pack8(const f32x16& p, int s) {
    u32x4 w; w.x = pk2(p[8 * s + 0], p[8 * s + 1]); w.y = pk2(p[8 * s + 2], p[8 * s + 3]); w.z = pk2(p[8 * s + 4], p[8 * s + 5]); w.w = pk2(p[8 * s + 6], p[8 * s + 7]);
    return __builtin_bit_cast(bf16x8, w);
}
__device__ __forceinline__ bf16x8 vt_frag(const LAS unsigned char* vp) {
    const u32x2 a = *(const LAS u32x2*)vp, b = *(const LAS u32x2*)(vp + 16);
    const u32x4 w = {a.x, a.y, b.x, b.y};
    return __builtin_bit_cast(bf16x8, w);
}

typedef short v4i16 __attribute__((ext_vector_type(4)));
__device__ __forceinline__ bf16x8 tr_pair(const LAS unsigned char* p, int second) {
    const v4i16 a = __builtin_amdgcn_ds_read_tr16_b64_v4i16((LAS v4i16*)p), b = __builtin_amdgcn_ds_read_tr16_b64_v4i16((LAS v4i16*)(p + second));
    return (bf16x8){a[0], a[1], a[2], a[3], b[0], b[1], b[2], b[3]};
}
__device__ __forceinline__ int vfrag_base(int lane, int rs) { const int i = lane & 15, g = lane >> 4; return (4 * (g >> 1) + (i >> 2)) * rs + (16 * (g & 1) + 4 * (i & 3)) * 2; }

constexpr int OST_BYTES = 32 * 72;
__device__ __forceinline__ void stage_store_32x32(LAS unsigned char* stg, const u32x2 (&w)[4], bf16* gbase, int ld, int lane) {
    const int r = lane & 31, h = lane >> 5;
#pragma unroll
    for (int rg = 0; rg < 4; ++rg) *(LAS u32x2*)(stg + r * 72 + (8 * rg + 4 * h) * 2) = w[rg];
    LDS_WAIT();
#pragma unroll
    for (int ps = 0; ps < 2; ++ps) { const int row = (lane >> 2) + 16 * ps, ch = lane & 3;
        const u32x2 a = *(const LAS u32x2*)(stg + row * 72 + ch * 16), b = *(const LAS u32x2*)(stg + row * 72 + ch * 16 + 8);
        const u32x4 v = {a.x, a.y, b.x, b.y};
        *(u32x4*)(gbase + (size_t)row * ld + ch * 8) = v; }
    LDS_WAIT();
}

constexpr int WA_KS = 144, WA_VS = 192;
constexpr int WA_K_OFF = 0, WA_V_OFF = 384 * WA_KS;
__host__ __device__ constexpr int wa_kind(int rel) { return rel == 0 ? 0 : rel < 4 ? 1 : rel == 4 ? 2 : rel < 8 ? 3 : 4; }
template <int KIND> __device__ __forceinline__ void wa_softmax(f32x16& s, float rq, float nslope2, int dist0, float kill, float& m, float& l, f32x16 (&o)[2]) {
    const float b0 = nslope2 * (float)dist0 + kill, nb0 = -(nslope2 * (float)dist0) + kill;
    float tmax = -INFINITY;
#pragma unroll
    for (int reg = 0; reg < 16; ++reg) {
        const int off = (reg & 3) + 8 * (reg >> 2);
        float v;
        if (KIND == 0 || KIND == 1) v = __builtin_fmaf(s[reg], rq, __builtin_fmaf(nslope2, -(float)off, b0));
        else if (KIND == 3 || KIND == 4) v = __builtin_fmaf(s[reg], rq, __builtin_fmaf(nslope2, (float)off, nb0));
        else { const int dist = dist0 - off; v = __builtin_fmaf(s[reg], rq, nslope2 * (float)(dist < 0 ? -dist : dist)) + kill; }
        if (KIND == 0) v = (dist0 - off <= 128) ? v : -INFINITY;
        if (KIND == 4) v = (dist0 - off >= -128) ? v : -INFINITY;
        s[reg] = v; tmax = fmaxf(tmax, v);
    }
    tmax = fmaxf(tmax, __shfl_xor(tmax, 32));
    if (__any(tmax > m + 8.0f)) {
        const float mn = fmaxf(m, tmax), f = __builtin_amdgcn_exp2f(m - mn);
        o[0] = o[0] * f; o[1] = o[1] * f; l *= f; m = mn;
    }
#pragma unroll
    for (int reg = 0; reg < 16; ++reg) { const float p = __builtin_amdgcn_exp2f(s[reg] - m); l += p; s[reg] = p; }
}
template <int KA, int KB> __device__ __forceinline__ void wa_step(const LAS unsigned char* kp, const LAS unsigned char* vtile, const bf16x8 (&qfA)[4], const bf16x8 (&qfB)[4], float rqA, float rqB,
                                                                  float nslope2, int dist0A, float killA, float killB,
                                                                  float& mA, float& lA, f32x16 (&oA)[2], float& mB, float& lB, f32x16 (&oB)[2]) {
    bf16x8 kf[4];
#pragma unroll
    for (int ks = 0; ks < 4; ++ks) kf[ks] = *(const LAS bf16x8*)(kp + ks * 32);
    f32x16 sA, sB;
#pragma unroll
    for (int i = 0; i < 16; ++i) { sA[i] = 0.f; sB[i] = 0.f; }
#pragma unroll
    for (int ks = 0; ks < 4; ++ks) { if (KA >= 0) sA = mfma32(kf[ks], qfA[ks], sA); if (KB >= 0) sB = mfma32(kf[ks], qfB[ks], sB); }
    if (KA >= 0) wa_softmax<(KA >= 0 ? KA : 1)>(sA, rqA, nslope2, dist0A, killA, mA, lA, oA);
    if (KB >= 0) wa_softmax<(KB >= 0 ? KB : 1)>(sB, rqB, nslope2, dist0A + 32, killB, mB, lB, oB);
#pragma unroll
    for (int s2 = 0; s2 < 2; ++s2) {
        bf16x8 vf[2];
#pragma unroll
        for (int dt = 0; dt < 2; ++dt) vf[dt] = tr_pair(vtile + 16 * s2 * WA_VS + dt * 64, 8 * WA_VS);
        if (KA >= 0) { const bf16x8 pb = pack8(sA, s2);
#pragma unroll
            for (int dt = 0; dt < 2; ++dt) oA[dt] = mfma32(vf[dt], pb, oA[dt]); }
        if (KB >= 0) { const bf16x8 pb = pack8(sB, s2);
#pragma unroll
            for (int dt = 0; dt < 2; ++dt) oB[dt] = mfma32(vf[dt], pb, oB[dt]); }
    }
}
__device__ __forceinline__ void wattn_unit(Frame& F, int b, int qb, int kvh) {
    const int tid = F.tid, lane = F.lane, wave = F.wave, r = lane & 31, h = lane >> 5;
    LAS unsigned char* Ks = F.lds + WA_K_OFF; LAS unsigned char* VS = F.lds + WA_V_OFF;
    const bf16* AK = wsp<bf16>(F, WS_AK); const bf16* AV = wsp<bf16>(F, WS_AV); const bf16* AQ = wsp<bf16>(F, WS_AQ);
    const float* SSK = wsp<float>(F, WS_SSQAK); const float* SSQ = wsp<float>(F, WS_SSQAQ); bf16* MIX = wsp<bf16>(F, WS_MIX);
    const int kpos0 = qb * 128 - 128; const float* sinkp = inp(I_ATT_SINK);
    __syncthreads();
    {
        const int ch = tid & 7; float gs[8]; const float* akg = inp(I_ATT_K_G); const float* aqg = inp(I_ATT_Q_G);
#pragma unroll
        for (int j = 0; j < 8; ++j) gs[j] = akg[ch * 8 + j] * aqg[ch * 8 + j] * (0.125f * LOG2E);
        u32x4 kraw[6], vraw[6]; float s0[6], s1[6];
#pragma unroll
        for (int i = 0; i < 6; ++i) {
            const int key = (tid >> 3) + 64 * i, kp = kpos0 + key, kpc = kp < 0 ? 0 : (kp >= SEQ ? SEQ - 1 : kp); const size_t tok = (size_t)b * SEQ + kpc;
            kraw[i] = *(const u32x4*)(AK + tok * 128 + kvh * 64 + ch * 8); vraw[i] = *(const u32x4*)(AV + tok * 128 + kvh * 64 + ch * 8);
            s0[i] = SSK[(size_t)(2 * kvh) * T + tok]; s1[i] = SSK[(size_t)(2 * kvh + 1) * T + tok];
        }
#pragma unroll
        for (int i = 0; i < 6; ++i) {
            const int key = (tid >> 3) + 64 * i, kp = kpos0 + key; const bool ok = kp >= 0 && kp < SEQ;
            const float rk = ok ? 1.0f / sqrtf((s0[i] + s1[i]) * (1.0f / 64.0f) + EPS) : 0.f;
            const u32x4 raw = kraw[i]; u32x4 w;
            w.x = pk2(bflo(raw.x) * rk * gs[0], bfhi(raw.x) * rk * gs[1]); w.y = pk2(bflo(raw.y) * rk * gs[2], bfhi(raw.y) * rk * gs[3]);
            w.z = pk2(bflo(raw.z) * rk * gs[4], bfhi(raw.z) * rk * gs[5]); w.w = pk2(bflo(raw.w) * rk * gs[6], bfhi(raw.w) * rk * gs[7]);
            *(LAS u32x4*)(Ks + key * WA_KS + ch * 16) = w;
            u32x4 vv = vraw[i]; if (!ok) vv = (u32x4){0u, 0u, 0u, 0u};
            *(LAS u32x4*)(VS + key * WA_VS + ch * 16) = vv;
        }
    }
    __syncthreads();
    const int vb = vfrag_base(lane, WA_VS);
    {
        const int g = wave >> 1, jqA = 2 * (wave & 1), hq = kvh * 4 + g, qiA = 32 * jqA + r;
        const size_t tokA = (size_t)b * SEQ + qb * 128 + qiA, tokB = tokA + 32;
        bf16x8 qfA[4], qfB[4];
#pragma unroll
        for (int ks = 0; ks < 4; ++ks) { qfA[ks] = *(const bf16x8*)(AQ + tokA * 512 + hq * 64 + 16 * ks + 8 * h); qfB[ks] = *(const bf16x8*)(AQ + tokB * 512 + hq * 64 + 16 * ks + 8 * h); }
        const float rqA = 1.0f / sqrtf((SSQ[(size_t)(2 * hq) * T + tokA] + SSQ[(size_t)(2 * hq + 1) * T + tokA]) * (1.0f / 64.0f) + EPS);
        const float rqB = 1.0f / sqrtf((SSQ[(size_t)(2 * hq) * T + tokB] + SSQ[(size_t)(2 * hq + 1) * T + tokB]) * (1.0f / 64.0f) + EPS);
        const float nslope2 = -__builtin_amdgcn_exp2f(-(float)(hq + 1)) * LOG2E, sink2 = sinkp[hq] * LOG2E;
        float mA = sink2, lA = 0.f, mB = sink2, lB = 0.f;
        f32x16 oA[2], oB[2];
#pragma unroll
        for (int i = 0; i < 16; ++i) { oA[0][i] = 0.f; oA[1][i] = 0.f; oB[0][i] = 0.f; oB[1][i] = 0.f; }
        const int kv_lo = (qb == 0) ? 4 : 0, kv_hi = (qb == 63) ? 7 : 11;
        const LAS unsigned char* kp0 = Ks + r * WA_KS + h * 16;
#define WA_STEP(rel, KA_, KB_) do { const int kt = jqA + (rel); const float kill = (kt < kv_lo || kt > kv_hi) ? -INFINITY : 0.f; \
            wa_step<KA_, KB_>(kp0 + kt * 32 * WA_KS, VS + vb + kt * 32 * WA_VS, qfA, qfB, rqA, rqB, nslope2, qiA + 128 - 32 * kt - 4 * h, kill, kill, mA, lA, oA, mB, lB, oB); } while (0)
        WA_STEP(0, wa_kind(0), -1);
        WA_STEP(1, wa_kind(1), wa_kind(0)); WA_STEP(2, wa_kind(2), wa_kind(1)); WA_STEP(3, wa_kind(3), wa_kind(2)); WA_STEP(4, wa_kind(4), wa_kind(3));
        WA_STEP(5, wa_kind(5), wa_kind(4)); WA_STEP(6, wa_kind(6), wa_kind(5)); WA_STEP(7, wa_kind(7), wa_kind(6)); WA_STEP(8, wa_kind(8), wa_kind(7));
        WA_STEP(9, -1, wa_kind(8));
#undef WA_STEP
        lA += __shfl_xor(lA, 32); lA += __builtin_amdgcn_exp2f(sink2 - mA);
        lB += __shfl_xor(lB, 32); lB += __builtin_amdgcn_exp2f(sink2 - mB);
        const float invA = __builtin_amdgcn_rcpf(lA), invB = __builtin_amdgcn_rcpf(lB);
        bf16* obase = MIX + ((size_t)b * SEQ + qb * 128 + 32 * jqA) * 1024 + hq * 64;
        LAS unsigned char* stg = F.lds + WA_V_OFF + 384 * WA_VS + wave * OST_BYTES;
#pragma unroll
        for (int dt = 0; dt < 2; ++dt) { u32x2 w[4];
#pragma unroll
            for (int rg = 0; rg < 4; ++rg) { w[rg].x = pk2(oA[dt][4 * rg] * invA, oA[dt][4 * rg + 1] * invA); w[rg].y = pk2(oA[dt][4 * rg + 2] * invA, oA[dt][4 * rg + 3] * invA); }
            stage_store_32x32(stg, w, obase + dt * 32, 1024, lane);
#pragma unroll
            for (int rg = 0; rg < 4; ++rg) { w[rg].x = pk2(oB[dt][4 * rg] * invB, oB[dt][4 * rg + 1] * invB); w[rg].y = pk2(oB[dt][4 * rg + 2] * invB, oB[dt][4 * rg + 3] * invB); }
            stage_store_32x32(stg, w, obase + (size_t)32 * 1024 + dt * 32, 1024, lane); }
    }
}

constexpr int XA_KS = 272, XA_VS = 520;
constexpr int XA_K_OFF = 0, XA_V_OFF = 256 * XA_KS;
__device__ __forceinline__ void xattn_phase(Frame& F) {
    const int tid = F.tid, lane = F.lane, wave = F.wave, r = lane & 31, h = lane >> 5;
    LAS unsigned char* Ks = F.lds + XA_K_OFF; LAS unsigned char* VT = F.lds + XA_V_OFF;
    const bf16* KVM = wsp<bf16>(F, WS_KVM); const float* SSK = wsp<float>(F, WS_SSQMK); const bf16* QM = wsp<bf16>(F, WS_QM); const float* SSQ = wsp<float>(F, WS_SSQQ);
    bf16* OM = wsp<bf16>(F, WS_OM);
    const int nunits = BATCH * 4 * 32;
    const int per = (nunits + F.G - 1) / F.G;
    int cur_bh = -1;
#pragma unroll 1
    for (int ui = 0; ui < per; ++ui) {
        const int u = F.bid * per + ui; if (u >= nunits) break;
        const int bh = u >> 5, qblk = u & 31, b = bh >> 2, hd = bh & 3;
        if (bh != cur_bh) {
            cur_bh = bh;
            __syncthreads();
            const int ch = tid & 15; float gs[8]; const float* mkg = inp(I_MEM_K_G); const float* mqg = inp(I_MEM_Q_G);
#pragma unroll
            for (int j = 0; j < 8; ++j) gs[j] = mkg[ch * 8 + j] * mqg[ch * 8 + j] * (0.08838834764831845f * LOG2E);
#pragma unroll
            for (int i = 0; i < 8; ++i) {
                const int key = (tid >> 4) + 32 * i; const size_t row = (size_t)b * MEMT + key;
                const u32x4 raw = *(const u32x4*)(KVM + row * 1024 + hd * 128 + ch * 8);
                const float* sp = SSK + (size_t)(hd * 4) * (BATCH * MEMT) + row;
                const float rk = 1.0f / sqrtf(((sp[0] + sp[BATCH * MEMT]) + (sp[2 * BATCH * MEMT] + sp[3 * BATCH * MEMT])) * (1.0f / 128.0f) + EPS);
                u32x4 w;
                w.x = pk2(bflo(raw.x) * rk * gs[0], bfhi(raw.x) * rk * gs[1]); w.y = pk2(bflo(raw.y) * rk * gs[2], bfhi(raw.y) * rk * gs[3]);
                w.z = pk2(bflo(raw.z) * rk * gs[4], bfhi(raw.z) * rk * gs[5]); w.w = pk2(bflo(raw.w) * rk * gs[6], bfhi(raw.w) * rk * gs[7]);
                *(LAS u32x4*)(Ks + key * XA_KS + ch * 16) = w;
            }
#pragma unroll
            for (int i = 0; i < 8; ++i) {
                const int idx = tid + 512 * i, key = idx & 255, vc = idx >> 8;
                const u32x4 raw = *(const u32x4*)(KVM + ((size_t)b * MEMT + key) * 1024 + 512 + hd * 128 + vc * 8);
                LAS unsigned short* vt = (LAS unsigned short*)(VT + (vc * 8) * XA_VS + key * 2);
                const unsigned rw[4] = {raw.x, raw.y, raw.z, raw.w};
#pragma unroll
                for (int j = 0; j < 8; ++j) vt[j * (XA_VS / 2)] = (unsigned short)((j & 1) ? (rw[j >> 1] >> 16) : (rw[j >> 1] & 0xffffu));
            }
            __syncthreads();
        }
        const size_t tok = (size_t)b * SEQ + qblk * 256 + wave * 32 + r;
        bf16x8 qf[8];
#pragma unroll
        for (int ks = 0; ks < 8; ++ks) qf[ks] = *(const bf16x8*)(QM + tok * 512 + hd * 128 + 16 * ks + 8 * h);
        const float* sp = SSQ + (size_t)(hd * 4) * T + tok;
        const float rq = 1.0f / sqrtf(((sp[0] + sp[T]) + (sp[2 * (size_t)T] + sp[3 * (size_t)T])) * (1.0f / 128.0f) + EPS);
        const LAS unsigned char* kp0 = Ks + r * XA_KS + h * 16;
        float m = -INFINITY, l = 0.f;
        f32x16 o[4];
#pragma unroll
        for (int i = 0; i < 16; ++i) { o[0][i] = 0.f; o[1][i] = 0.f; o[2][i] = 0.f; o[3][i] = 0.f; }
#pragma unroll 1
        for (int kt = 0; kt < 8; ++kt) {
            bf16x8 vf[2][4];
#pragma unroll
            for (int s2 = 0; s2 < 2; ++s2)
#pragma unroll
                for (int dt = 0; dt < 4; ++dt) vf[s2][dt] = vt_frag(VT + (dt * 32 + r) * XA_VS + (kt * 32 + 16 * s2 + 4 * h) * 2);
            f32x16 s = st_tile<128>(kp0 + kt * 32 * XA_KS, qf);
            float tmax = -INFINITY;
#pragma unroll
            for (int reg = 0; reg < 16; ++reg) { s[reg] *= rq; tmax = fmaxf(tmax, s[reg]); }
            tmax = fmaxf(tmax, __shfl_xor(tmax, 32));
            if (__any(tmax > m + 8.0f)) {
                const float mn = fmaxf(m, tmax), f = __builtin_amdgcn_exp2f(m - mn);
                o[0] = o[0] * f; o[1] = o[1] * f; o[2] = o[2] * f; o[3] = o[3] * f; l *= f; m = mn;
            }
#pragma unroll
            for (int reg = 0; reg < 16; ++reg) { const float p = __builtin_amdgcn_exp2f(s[reg] - m); l += p; s[reg] = p; }
#pragma unroll
            for (int s2 = 0; s2 < 2; ++s2) {
                const bf16x8 pb = pack8(s, s2);
#pragma unroll
                for (int dt = 0; dt < 4; ++dt) o[dt] = mfma32(vf[s2][dt], pb, o[dt]);
            }
        }
        l += __shfl_xor(l, 32);
        const float inv = __builtin_amdgcn_rcpf(l);
        bf16* obase = OM + ((size_t)b * SEQ + qblk * 256 + wave * 32) * 512 + hd * 128;
        LAS unsigned char* stg = F.lds + XA_V_OFF + 128 * XA_VS + wave * OST_BYTES;
#pragma unroll
        for (int dt = 0; dt < 4; ++dt) { u32x2 w[4];
#pragma unroll
            for (int rg = 0; rg < 4; ++rg) { w[rg].x = pk2(o[dt][4 * rg] * inv, o[dt][4 * rg + 1] * inv); w[rg].y = pk2(o[dt][4 * rg + 2] * inv, o[dt][4 * rg + 3] * inv); }
            stage_store_32x32(stg, w, obase + dt * 32, 512, lane); }
    }
}
__device__ __forceinline__ float logsig2(float f) { return (fminf(f, 0.f) - log1pf(expf(-fabsf(f)))) * LOG2E; }
__device__ __forceinline__ float wave_incl_scan(float v, int lane) {
#pragma unroll
    for (int o = 1; o < 64; o <<= 1) { const float t = __shfl_up(v, o); if (lane >= o) v += t; }
    return v;
}
__device__ __forceinline__ float silu_f(float x) { return x * __builtin_amdgcn_rcpf(1.0f + __builtin_amdgcn_exp2f(-x * LOG2E)); }
__device__ __forceinline__ float sigmoid_f(float x) { return __builtin_amdgcn_rcpf(1.0f + __builtin_amdgcn_exp2f(-x * LOG2E)); }

__device__ __forceinline__ void phase_conv(Frame& F) {
    const bf16* MQ = wsp<bf16>(F, WS_MQ); const bf16* MK = wsp<bf16>(F, WS_MK); bf16* QC = wsp<bf16>(F, WS_QC); bf16* KC = wsp<bf16>(F, WS_KC);
    const float* conv_w = inp(I_CONV_W); const float* conv_b = inp(I_CONV_B);
    const int gt = F.bid * 512 + F.tid, NGT = F.G * 512;
#pragma unroll 1
    for (int it = gt; it < (T / 4) * 128; it += NGT) {
        const int cc = it & 127, rg = it >> 7, tok0 = rg * 4, pos0 = tok0 & (SEQ - 1), which = cc >> 6, col = (cc & 63) * 8, ch = which * 512 + col;
        const bf16* src = (which ? MK : MQ) + col;
        u32x4 rw[6];
#pragma unroll
        for (int d = 0; d < 6; ++d) { const int pp = pos0 + d - 1; const bool ok = pp >= 0 && pp < SEQ; rw[d] = *(const u32x4*)(src + (size_t)(ok ? tok0 + d - 1 : tok0) * 512); if (!ok) rw[d] = (u32x4){0u, 0u, 0u, 0u}; }
        const f32x4 w0a = *(const f32x4*)(conv_w + ch), w0b = *(const f32x4*)(conv_w + ch + 4), w1a = *(const f32x4*)(conv_w + 1024 + ch), w1b = *(const f32x4*)(conv_w + 1024 + ch + 4);
        const f32x4 w2a = *(const f32x4*)(conv_w + 2048 + ch), w2b = *(const f32x4*)(conv_w + 2048 + ch + 4), bba = *(const f32x4*)(conv_b + ch), bbb = *(const f32x4*)(conv_b + ch + 4);
        const float sc = which ? 0.08838834764831845f : 1.0f;
        float y[4][8];
#pragma unroll
        for (int j = 0; j < 8; ++j) {
            const float w0 = j < 4 ? w0a[j & 3] : w0b[j & 3], w1 = j < 4 ? w1a[j & 3] : w1b[j & 3], w2 = j < 4 ? w2a[j & 3] : w2b[j & 3], bb = j < 4 ? bba[j & 3] : bbb[j & 3];
            float xv[6];
#pragma unroll
            for (int d = 0; d < 6; ++d) { const unsigned wd = (j >> 1) == 0 ? rw[d].x : (j >> 1) == 1 ? rw[d].y : (j >> 1) == 2 ? rw[d].z : rw[d].w; xv[d] = (j & 1) ? bfhi(wd) : bflo(wd); }
#pragma unroll
            for (int rr = 0; rr < 4; ++rr) y[rr][j] = silu_f(bb + w0 * xv[rr] + w1 * xv[rr + 1] + w2 * xv[rr + 2]) * sc;
        }
        bf16* dst = (which ? KC : QC) + col;
#pragma unroll
        for (int rr = 0; rr < 4; ++rr) { u32x4 w; w.x = pk2(y[rr][0], y[rr][1]); w.y = pk2(y[rr][2], y[rr][3]); w.z = pk2(y[rr][4], y[rr][5]); w.w = pk2(y[rr][6], y[rr][7]);
            *(u32x4*)(dst + (size_t)(tok0 + rr) * 512) = w; }
    }
}
__device__ __forceinline__ void phase_gatescan(Frame& F) {
    const int gw = F.bid * 8 + F.wave, NGW = F.G * 8, lane = F.lane;
    const float* GA = wsp<float>(F, WS_GATES); float* WST = wsp<float>(F, WS_WST); float* FTA = wsp<float>(F, WS_FTA); float* ESA = wsp<float>(F, WS_ESA); float* DEC = wsp<float>(F, WS_DEC);
#pragma unroll 1
    for (int task = gw; task < BATCH * 64 * 4 * 2; task += NGW) {
        const int dir = task & 1, hd = (task >> 1) & 3, bc = task >> 3; const size_t tok0 = (size_t)bc * 128;
        const float* g = GA + (tok0 + 2 * lane) * 16 + dir * 8 + hd;
        const float i0 = g[0] * LOG2E, i1 = g[16] * LOG2E, l0 = logsig2(g[4]), l1 = logsig2(g[20]);
        const float incl = wave_incl_scan(l0 + l1, lane), tot = __shfl(incl, 63);
        float F0, F1;
        if (!dir) { F1 = incl; F0 = incl - l1; } else { F0 = tot - incl + l0 + l1; F1 = tot - incl + l1; }
        const size_t o = (size_t)(dir * 4 + hd) * T + tok0 + 2 * lane;
        *(f32x2*)(FTA + o) = (f32x2){F0, F1}; *(f32x2*)(ESA + o) = (f32x2){i0 - F0, i1 - F1};
        *(f32x2*)(WST + o) = (f32x2){__builtin_amdgcn_exp2f(tot - F0 + i0), __builtin_amdgcn_exp2f(tot - F1 + i1)};
        if (lane == 0) DEC[task] = __builtin_amdgcn_exp2f(tot);
    }
}

constexpr int MS_KW_STRIDE = 96, MS_VT_STRIDE = 288;
constexpr int MS_KW_BYTES = 128 * MS_KW_STRIDE, MS_VT_BYTES = 128 * MS_VT_STRIDE, MS_BUF = MS_KW_BYTES + MS_VT_BYTES;
__device__ __forceinline__ void mlstm_state_unit(Frame& F, int u) {
    const int tid = F.tid, lane = F.lane, wave = F.wave;
    const int ksl = u & 3, dir = (u >> 2) & 1, hd = (u >> 3) & 3, b = u >> 5;
    const bf16* KC = wsp<bf16>(F, WS_KC); const bf16* MV = wsp<bf16>(F, WS_MV); const float* WST = wsp<float>(F, WS_WST); const float* DEC = wsp<float>(F, WS_DEC);
    bf16* C0 = wsp<bf16>(F, WS_C0); float* N0 = wsp<float>(F, WS_N0);
    const int krow = tid >> 2, kch = tid & 3, kcol = hd * 128 + ksl * 32 + kch * 8;
    f32x4 acc[2], nacc[2];
#pragma unroll
    for (int i = 0; i < 2; ++i) { acc[i] = (f32x4){0.f, 0.f, 0.f, 0.f}; nacc[i] = (f32x4){0.f, 0.f, 0.f, 0.f}; }
    const bf16x8 ones = {0x3F80, 0x3F80, 0x3F80, 0x3F80, 0x3F80, 0x3F80, 0x3F80, 0x3F80};
    const int tg = lane >> 4, ti = lane & 15, tq = ti >> 2, tp = ti & 3;
    const int aoff = (8 * tg + tq) * MS_KW_STRIDE + (4 * tp) * 2, boff = (8 * tg + tq) * MS_VT_STRIDE + (16 * wave + 4 * tp) * 2;
    u32x4 krA, vrA[4], krB, vrB[4]; float wA, wB, dA, dB;
#define MS_LOAD(kr, vr, wv, dv, c) do { const size_t tok0_ = (size_t)b * SEQ + (c) * 128; \
        kr = *(const u32x4*)(KC + (tok0_ + krow) * 512 + kcol); wv = WST[(size_t)(dir * 4 + hd) * T + tok0_ + krow]; dv = DEC[((((size_t)b * 64 + (c)) * 4 + hd) * 2) + dir]; \
        _Pragma("unroll") for (int i_ = 0; i_ < 4; ++i_) { const int idx_ = tid + 512 * i_; vr[i_] = *(const u32x4*)(MV + (tok0_ + (idx_ >> 4)) * 512 + hd * 128 + (idx_ & 15) * 8); } } while (0)
#define MS_STEP(kr, vr, wv, dv, ci) do { \
        const int c = dir ? 63 - (ci) : (ci), buf = (ci) & 1; \
        LAS unsigned char* KW = F.lds + buf * MS_BUF; LAS unsigned char* VT = KW + MS_KW_BYTES; \
        const float dec = dv; \
        { u32x4 w_; w_.x = pk2(bflo(kr.x) * wv, bfhi(kr.x) * wv); w_.y = pk2(bflo(kr.y) * wv, bfhi(kr.y) * wv); w_.z = pk2(bflo(kr.z) * wv, bfhi(kr.z) * wv); w_.w = pk2(bflo(kr.w) * wv, bfhi(kr.w) * wv); \
          *(LAS u32x4*)(KW + krow * MS_KW_STRIDE + kch * 16) = w_; \
          _Pragma("unroll") for (int i = 0; i < 4; ++i) { const int idx = tid + 512 * i; *(LAS u32x4*)(VT + (idx >> 4) * MS_VT_STRIDE + (idx & 15) * 16) = vr[i]; } } \
        if ((ci) + 2 < 64) MS_LOAD(kr, vr, wv, dv, dir ? 61 - (ci) : (ci) + 2);     \
        __syncthreads(); \
        {   \
            const size_t unit4 = (((size_t)b * 64 + c) * 4 + hd) * 2 + dir; \
            bf16* cdst = C0 + unit4 * 16384 + ksl * 4096 + (16 * wave + (lane & 15)) * 32 + 4 * (lane >> 4); \
            _Pragma("unroll") for (int kt = 0; kt < 2; ++kt) { u32x2 w; w.x = pk2(acc[kt][0], acc[kt][1]); w.y = pk2(acc[kt][2], acc[kt][3]); *(u32x2*)(cdst + 16 * kt) = w; } \
            if (wave == 0 && (lane & 15) == 0) { \
                _Pragma("unroll") for (int kt = 0; kt < 2; ++kt) *(f32x4*)(N0 + unit4 * 128 + ksl * 32 + 16 * kt + 4 * (lane >> 4)) = nacc[kt]; } \
        } \
        _Pragma("unroll") for (int kt = 0; kt < 2; ++kt) { acc[kt] = acc[kt] * dec; nacc[kt] = nacc[kt] * dec; } \
        _Pragma("unroll") for (int ks = 0; ks < 4; ++ks) { \
            const bf16x8 bv = tr_pair(VT + boff + 32 * ks * MS_VT_STRIDE, 4 * MS_VT_STRIDE); \
            _Pragma("unroll") for (int kt = 0; kt < 2; ++kt) { \
                const bf16x8 av = tr_pair(KW + aoff + 32 * ks * MS_KW_STRIDE + 32 * kt, 4 * MS_KW_STRIDE); \
                acc[kt] = mfma16(av, bv, acc[kt]); nacc[kt] = mfma16(av, ones, nacc[kt]); } } \
    } while (0)
    MS_LOAD(krA, vrA, wA, dA, dir ? 63 : 0);
    MS_LOAD(krB, vrB, wB, dB, dir ? 62 : 1);
    __syncthreads();
#pragma unroll 1
    for (int ci = 0; ci < 64; ci += 2) {
        MS_STEP(krA, vrA, wA, dA, ci);
        MS_STEP(krB, vrB, wB, dB, ci + 1);
    }
#undef MS_STEP
#undef MS_LOAD
}

constexpr int MO_KS = 0, MO_VS = 34816, MO_C0 = 71680, MO_FT = 141312, MO_ES = 142336, MO_N0 = 143360, MO_XS = 144384, MO_OG = 145408;
__device__ __forceinline__ void mlstm_out_unit(Frame& F, int u) {
    const int tid = F.tid, lane = F.lane, wave = F.wave, r = lane & 31, hh = lane >> 5;
    const int hd = u & 3, c = (u >> 2) & 63, b = u >> 8;
    const size_t tok0 = (size_t)b * SEQ + c * 128;
    const bf16* MV = wsp<bf16>(F, WS_MV); const bf16* MOg = wsp<bf16>(F, WS_MO);
    const bf16* C0 = wsp<bf16>(F, WS_C0); const float* N0 = wsp<float>(F, WS_N0); bf16* MIX = wsp<bf16>(F, WS_MIX);
    LAS unsigned char* L = F.lds;
    LAS float* FT = (LAS float*)(L + MO_FT); LAS float* ES = (LAS float*)(L + MO_ES); LAS float* N0s = (LAS float*)(L + MO_N0); LAS float* XS = (LAS float*)(L + MO_XS); LAS float* OG = (LAS float*)(L + MO_OG);
    const size_t unit4 = (((size_t)b * 64 + c) * 4 + hd) * 2;
    const int tt = wave & 3, vh = wave >> 2, t = 32 * tt + r;
    bf16x8 qf[8];
    {
    __syncthreads();
    u32x4 kst[4], vst[4], cst[8];
    {
        const bf16* KC = wsp<bf16>(F, WS_KC);
#pragma unroll
        for (int i = 0; i < 4; ++i) { const int idx = tid + 512 * i, row = idx >> 4, ch = idx & 15;
            kst[i] = *(const u32x4*)(KC + (tok0 + row) * 512 + hd * 128 + ch * 8); vst[i] = *(const u32x4*)(MV + (tok0 + row) * 512 + hd * 128 + ch * 8); }
#pragma unroll
        for (int i = 0; i < 8; ++i) cst[i] = *(const u32x4*)(C0 + unit4 * 16384 + (size_t)(tid + 512 * i) * 8);
    }
    float ftv = 0.f, esv = 0.f, n0v = 0.f;
    if (tid < 256) { const int dir = tid >> 7, pos = tid & 127; const size_t o = (size_t)(dir * 4 + hd) * T + tok0 + pos;
        ftv = wsp<float>(F, WS_FTA)[o]; esv = wsp<float>(F, WS_ESA)[o]; n0v = N0[(unit4 + dir) * 128 + pos]; }
#pragma unroll
    for (int ks = 0; ks < 8; ++ks) qf[ks] = *(const bf16x8*)(wsp<bf16>(F, WS_QC) + (tok0 + t) * 512 + hd * 128 + 16 * ks + 8 * hh);
#pragma unroll
    for (int i = 0; i < 4; ++i) { const int idx = tid + 512 * i, row = idx >> 4, ch = idx & 15;
        *(LAS u32x4*)(L + MO_KS + row * 272 + ch * 16) = kst[i]; *(LAS u32x4*)(L + MO_VS + row * 288 + ch * 16) = vst[i]; }
#pragma unroll
    for (int i = 0; i < 8; ++i) { const int cidx = tid + 512 * i, dir = cidx >> 11, ksl = (cidx >> 9) & 3, v = (cidx >> 2) & 127, kq = cidx & 3;
        *(LAS u32x4*)(L + MO_C0 + dir * 34816 + v * 272 + (ksl * 32 + kq * 8) * 2) = cst[i]; }
    if (tid >= 384) OG[tid - 384] = inp(I_ML_OUT_G)[hd * 128 + tid - 384];
    if (tid < 256) { FT[tid] = ftv; ES[tid] = esv; ((LAS unsigned short*)N0s)[tid] = (unsigned short)pk2(n0v, 0.f); }
    __syncthreads();
    }
    const int vb = vfrag_base(lane, 288);
    f32x16 hs[2];
    {
#pragma unroll
    for (int i = 0; i < 16; ++i) { hs[0][i] = 0.f; hs[1][i] = 0.f; }
#pragma unroll 1
    for (int dir = 0; dir < 2; ++dir) {
        const float Ft = FT[dir * 128 + t], at = __builtin_amdgcn_exp2f(Ft);
        float qn;
        { f32x16 qa;
#pragma unroll
          for (int i = 0; i < 16; ++i) qa[i] = 0.f;
#pragma unroll
          for (int ks = 0; ks < 8; ++ks) qa = mfma32(*(const LAS bf16x8*)((const LAS unsigned char*)N0s + dir * 256 + (16 * ks + 8 * hh) * 2), qf[ks], qa);
          qn = qa[0]; }
        f32x16 num[2];
        const LAS unsigned char* c0 = L + MO_C0 + dir * 34816 + (64 * vh + r) * 272 + 16 * hh;
#pragma unroll
        for (int vt = 0; vt < 2; ++vt) {
#pragma unroll
            for (int i = 0; i < 16; ++i) num[vt][i] = 0.f;
#pragma unroll
            for (int ks = 0; ks < 8; ++ks) num[vt] = mfma32(*(const LAS bf16x8*)(c0 + vt * 32 * 272 + 32 * ks), qf[ks], num[vt]);
            num[vt] = num[vt] * at;
        }
        float rowsum = 0.f;
        const int st_lo = dir ? tt : 0, st_hi = dir ? 3 : tt;
#pragma unroll 1
        for (int st = st_lo; st <= st_hi; ++st) {
            f32x16 pm = st_tile<128>(L + MO_KS + (32 * st + r) * 272 + hh * 16, qf);
            if (st == tt) {
#pragma unroll
                for (int rg = 0; rg < 4; ++rg) {
                    const int s0 = 32 * st + 8 * rg + 4 * hh;
                    const f32x4 es = *(const LAS f32x4*)(ES + dir * 128 + s0);
#pragma unroll
                    for (int e = 0; e < 4; ++e) {
                        const int s = s0 + e; const bool ok = dir ? (s >= t) : (s <= t);
                        const float pv = ok ? pm[4 * rg + e] * __builtin_amdgcn_exp2f(Ft + es[e]) : 0.f;
                        pm[4 * rg + e] = pv; rowsum += pv;
                    }
                }
            } else {
#pragma unroll
                for (int rg = 0; rg < 4; ++rg) {
                    const f32x4 es = *(const LAS f32x4*)(ES + dir * 128 + 32 * st + 8 * rg + 4 * hh);
#pragma unroll
                    for (int e = 0; e < 4; ++e) { const float pv = pm[4 * rg + e] * __builtin_amdgcn_exp2f(Ft + es[e]); pm[4 * rg + e] = pv; rowsum += pv; }
                }
            }
#pragma unroll
            for (int s2 = 0; s2 < 2; ++s2) {
                const bf16x8 pb = pack8(pm, s2);
#pragma unroll
                for (int vt = 0; vt < 2; ++vt) num[vt] = mfma32(tr_pair(L + MO_VS + vb + (32 * st + 16 * s2) * 288 + (64 * vh + 32 * vt) * 2, 8 * 288), pb, num[vt]);
            }
        }
        rowsum += __shfl_xor(rowsum, 32);
        const float den = at * qn + rowsum, dinv = 1.0f / fmaxf(fabsf(den), 1.0f);
        hs[0] = hs[0] + num[0] * dinv; hs[1] = hs[1] + num[1] * dinv;
    }
    }
    {
    const size_t tok = tok0 + t;
    u32x2 mw[8];
#pragma unroll
    for (int i = 0; i < 8; ++i) mw[i] = *(const u32x2*)(MOg + tok * 512 + hd * 128 + 64 * vh + 32 * (i >> 2) + 8 * (i & 3) + 4 * hh);
    float ss = 0.f;
#pragma unroll
    for (int i = 0; i < 16; ++i) ss += hs[0][i] * hs[0][i] + hs[1][i] * hs[1][i];
    ss += __shfl_xor(ss, 32);
    if (hh == 0) XS[wave * 32 + r] = ss;
    __syncthreads();
    const float rinv = 1.0f / sqrtf((ss + XS[(wave ^ 4) * 32 + r]) * (1.0f / 128.0f) + EPS);
    LAS unsigned char* stg = L + MO_KS + wave * OST_BYTES;
    bf16* obase = MIX + (tok0 + 32 * tt) * 1024 + 512 + hd * 128 + 64 * vh;
#pragma unroll
    for (int vt = 0; vt < 2; ++vt) { u32x2 ow[4];
#pragma unroll
        for (int rg = 0; rg < 4; ++rg) {
            const int v = 64 * vh + 32 * vt + 8 * rg + 4 * hh;
            const f32x4 og = *(const LAS f32x4*)(OG + v);
            const u32x2 m_ = mw[vt * 4 + rg];
            const float m0 = bflo(m_.x), m1 = bfhi(m_.x), m2 = bflo(m_.y), m3 = bfhi(m_.y);
            const float o0 = hs[vt][4 * rg] * rinv * og[0] * sigmoid_f(m0), o1 = hs[vt][4 * rg + 1] * rinv * og[1] * sigmoid_f(m1);
            const float o2 = hs[vt][4 * rg + 2] * rinv * og[2] * sigmoid_f(m2), o3 = hs[vt][4 * rg + 3] * rinv * og[3] * sigmoid_f(m3);
            ow[rg].x = pk2(o0, o1); ow[rg].y = pk2(o2, o3);
        }
        stage_store_32x32(stg, ow, obase + 32 * vt, 1024, lane); }
    }
}
constexpr int SEL_VALS = 0, SEL_HIST = 32768, SEL_MISC = 32768 + 1024, SEL_WSUM = SEL_MISC + 64;
__device__ __forceinline__ void select_unit(Frame& F, int u) {
    const int tid = F.tid, lane = F.lane, wave = F.wave;
    LAS unsigned* vals = (LAS unsigned*)(F.lds + SEL_VALS); LAS unsigned* hist = (LAS unsigned*)(F.lds + SEL_HIST); LAS unsigned* misc = (LAS unsigned*)(F.lds + SEL_MISC); LAS unsigned* wsum = (LAS unsigned*)(F.lds + SEL_WSUM);
    const float* AFF = wsp<float>(F, WS_AFF) + (size_t)u * SEQ;
    int* IDX = wsp<int>(F, WS_IDX) + (size_t)u * CAP; float* GV = wsp<float>(F, WS_GVAL) + (size_t)u * CAP; int* SLOT = wsp<int>(F, WS_SLOT);
    float* RE = wsp<float>(F, WS_RINVE) + (size_t)u * CAP; const float* RINV2 = wsp<float>(F, WS_RINV2) + (size_t)(u >> 4) * SEQ;
    const int b = u >> 4, e = u & 15;
    __syncthreads();
    unsigned mine[16];
#pragma unroll
    for (int i = 0; i < 4; ++i) { const u32x4 v = *(const u32x4*)(AFF + 16 * tid + 4 * i); mine[4 * i] = v.x; mine[4 * i + 1] = v.y; mine[4 * i + 2] = v.z; mine[4 * i + 3] = v.w; }
    unsigned prefix = 0u, mask = 0u, kk = CAP;
#pragma unroll 1
    for (int pass = 0; pass < 4; ++pass) {
        const int shift = 24 - 8 * pass;
        if (tid < 256) hist[tid] = 0u;
        __syncthreads();
#pragma unroll
        for (int i = 0; i < 16; ++i) if ((mine[i] & mask) == prefix) __hip_atomic_fetch_add(&hist[(mine[i] >> shift) & 255u], 1u, __ATOMIC_RELAXED, __HIP_MEMORY_SCOPE_WORKGROUP);
        __syncthreads();
        if (wave == 0) {
            const unsigned h0 = hist[4 * lane], h1 = hist[4 * lane + 1], h2 = hist[4 * lane + 2], h3 = hist[4 * lane + 3];
            const unsigned ls = h0 + h1 + h2 + h3;
            unsigned incl = ls;
#pragma unroll
            for (int o = 1; o < 64; o <<= 1) { const unsigned t = __shfl_down(incl, o); if (lane + o < 64) incl += t; }
            const unsigned above = incl - ls;
            const unsigned a3 = above, a2 = above + h3, a1 = a2 + h2, a0 = a1 + h1;
            int d = -1; unsigned ab = 0u;
            if (a3 < kk && kk <= a3 + h3) { d = 4 * lane + 3; ab = a3; }
            else if (a2 < kk && kk <= a2 + h2) { d = 4 * lane + 2; ab = a2; }
            else if (a1 < kk && kk <= a1 + h1) { d = 4 * lane + 1; ab = a1; }
            else if (a0 < kk && kk <= a0 + h0) { d = 4 * lane; ab = a0; }
            if (d >= 0) { misc[0] = (unsigned)d; misc[1] = ab; }
        }
        __syncthreads();
        prefix |= misc[0] << shift; mask |= 255u << shift; kk -= misc[1];
    }
    unsigned cg = 0u, ce = 0u;
#pragma unroll
    for (int i = 0; i < 16; ++i) { cg += mine[i] > prefix ? 1u : 0u; ce += mine[i] == prefix ? 1u : 0u; }
    unsigned pk = cg | (ce << 16), incl = pk;
#pragma unroll
    for (int o = 1; o < 64; o <<= 1) { const unsigned t = __shfl_up(incl, o); if (lane >= o) incl += t; }
    if (lane == 63) wsum[wave] = incl;
    __syncthreads();
    unsigned base = 0u;
#pragma unroll
    for (int w = 0; w < 8; ++w) if (w < wave) base += wsum[w];
    unsigned excl = base + incl - pk;
    unsigned ng = excl & 0xffffu, ne = excl >> 16;
    const unsigned ngt_total = CAP - kk;
#pragma unroll
    for (int i = 0; i < 16; ++i) {
        const int s = 16 * tid + i; int slot = -1;
        if (mine[i] > prefix) { slot = (int)ng; ++ng; }
        else if (mine[i] == prefix) { if (ne < kk) slot = (int)(ngt_total + ne); ++ne; }
        if (slot >= 0) { IDX[slot] = s; GV[slot] = __builtin_bit_cast(float, mine[i]); RE[slot] = RINV2[s]; }
        SLOT[(size_t)u * SEQ + s] = slot;
    }
}
__device__ __forceinline__ void phase_gather(Frame& F) {
    const int gw = F.bid * 8 + F.wave, NGW = F.G * 8, lane = F.lane;
    const int* IDX = wsp<int>(F, WS_IDX); const bf16* X2B = wsp<bf16>(F, WS_X2B); bf16* XE = wsp<bf16>(F, WS_XE); const float* RINV2 = wsp<float>(F, WS_RINV2); float* RE = wsp<float>(F, WS_RINVE);
    for (int row = gw; row < XROWS; row += NGW) {
        const int b = row >> 14; const size_t tok = (size_t)b * SEQ + IDX[row];
        const u32x4* src = (const u32x4*)(X2B + tok * 1024) + lane; u32x4* dst = (u32x4*)(XE + (size_t)row * 1024) + lane;
        const u32x4 v0 = src[0], v1 = src[64];
        dst[0] = v0; dst[64] = v1;
        if (lane == 0) RE[row] = RINV2[tok];
    }
}
__device__ __forceinline__ void phase_combine(Frame& F) {
    const int gw = F.bid * 8 + F.wave, NGW = F.G * 8, lane = F.lane;
    const int* SLOT = wsp<int>(F, WS_SLOT); const unsigned char* Y8 = wsp<unsigned char>(F, WS_Y); const bf16* X2B = wsp<bf16>(F, WS_X2B);
    constexpr float YS = 1.0f / (float)(1 << F8_YSHIFT);
    for (int grp = gw; grp < T / 8; grp += NGW) {
        const int tok0 = grp * 8, b = tok0 >> 13, s0 = tok0 & (SEQ - 1);
        const u32x2 sl = *(const u32x2*)(SLOT + ((size_t)(b * 16 + (lane & 15)) * SEQ + s0 + 2 * (lane >> 4)));
#pragma unroll
        for (int jj = 0; jj < 8; ++jj) {
            const int tok = tok0 + jj;
            const int mys = (jj & 1) ? (int)sl.y : (int)sl.x;
            const u32x4* xr = (const u32x4*)(X2B + (size_t)tok * 1024) + 2 * lane;
            const u32x4 x0 = xr[0], x1 = xr[1];
            f32x4 a0 = {bflo(x0.x), bfhi(x0.x), bflo(x0.y), bfhi(x0.y)}, a1 = {bflo(x0.z), bfhi(x0.z), bflo(x0.w), bfhi(x0.w)};
            f32x4 a2 = {bflo(x1.x), bfhi(x1.x), bflo(x1.y), bfhi(x1.y)}, a3 = {bflo(x1.z), bfhi(x1.z), bflo(x1.w), bfhi(x1.w)};
#pragma unroll 1
            for (int e = 0; e < 16; ++e) {
                const int slot = __shfl(mys, e + 16 * (jj >> 1));
                if (slot >= 0) {
                    const u32x4 yv = *((const u32x4*)(Y8 + ((size_t)(b * 16 + e) * CAP + slot) * 1024) + lane);
                    f32x2 p;
                    p = __builtin_amdgcn_cvt_pk_f32_fp8((int)yv.x, false); a0[0] += p[0] * YS; a0[1] += p[1] * YS; p = __builtin_amdgcn_cvt_pk_f32_fp8((int)yv.x, true); a0[2] += p[0] * YS; a0[3] += p[1] * YS;
                    p = __builtin_amdgcn_cvt_pk_f32_fp8((int)yv.y, false); a1[0] += p[0] * YS; a1[1] += p[1] * YS; p = __builtin_amdgcn_cvt_pk_f32_fp8((int)yv.y, true); a1[2] += p[0] * YS; a1[3] += p[1] * YS;
                    p = __builtin_amdgcn_cvt_pk_f32_fp8((int)yv.z, false); a2[0] += p[0] * YS; a2[1] += p[1] * YS; p = __builtin_amdgcn_cvt_pk_f32_fp8((int)yv.z, true); a2[2] += p[0] * YS; a2[3] += p[1] * YS;
                    p = __builtin_amdgcn_cvt_pk_f32_fp8((int)yv.w, false); a3[0] += p[0] * YS; a3[1] += p[1] * YS; p = __builtin_amdgcn_cvt_pk_f32_fp8((int)yv.w, true); a3[2] += p[0] * YS; a3[3] += p[1] * YS;
                }
            }
            f32x4* o = (f32x4*)(F.out + (size_t)tok * 1024) + 4 * lane;
            o[0] = a0; o[1] = a1; o[2] = a2; o[3] = a3;
        }
    }
}
struct Args { const float* in[25]; float* out; unsigned char* ws; };
constexpr int MISC_OFF = LDS_BYTES - 64;
constexpr int CW_BAR = 4096;
__global__ void __launch_bounds__(512, 2) hymba_fwd(Args args) {
    extern __shared__ __attribute__((aligned(16))) unsigned char lds_raw[];
    cg::grid_group grid = cg::this_grid();
    Frame F;
    F.lds = (LAS unsigned char*)lds_raw;
    F.tid = threadIdx.x; F.lane = F.tid & 63; F.wave = __builtin_amdgcn_readfirstlane(F.tid >> 6); F.bid = blockIdx.x; F.G = gridDim.x;
    F.out = args.out; F.ws = args.ws;
    const int G = F.G, bid = F.bid;
    if (F.tid < 16) ((LAS unsigned*)(F.lds + MISC_OFF))[F.tid] = 0u;
    __syncthreads();
    if (bid == 0) for (int i = F.tid; i < XCD_BAR_WORDS; i += 512) ((unsigned*)(F.ws + WS_CTL) + CW_BAR)[i] = 0u;
#define GSYNC() xcd_barrier(xbar, F.wave == 0 && pg8::fresh_lane() == 0)
#define LAUNDER() do { F.tid = F.wave * 64 + pg8::fresh_lane(); asm volatile("" : "+v"(F.tid)); F.lane = F.tid & 63; } while (0)

    LAUNDER(); prep_weights(F);
    LAUNDER(); prep_small(F);
    LAUNDER(); prep_rows(F);
    grid.sync();
    const XcdBarrier xbar = xcd_barrier_post((unsigned*)(F.ws + WS_CTL) + CW_BAR, (volatile LAS unsigned*)(F.lds + MISC_OFF), F.wave == 0 && pg8::fresh_lane() == 0);
    LAUNDER(); phase_gates(F, G > 64 ? 32 : 0);
    LAUNDER(); {
        pg8::Gemm g{wsp<bf16>(F, WS_MEMN), wsp<bf16>(F, WS_WKV), BATCH * MEMT, 1024, 1024, F.wave}; pg8::StaticOrder S; S.init(BATCH * MEMT, 1024, G, bid);
        pg8::EpiHead128<false> E{wsp<bf16>(F, WS_KVM), 1024, nullptr, wsp<float>(F, WS_SSQMK), 2, BATCH * MEMT};
        pg8::gemm_phase<pg8::EpiHead128<false>, pg8::StaticOrder, true, true>(F.lds, g, S, E);
    }
    LAUNDER(); {
        pg8::Gemm g{wsp<bf16>(F, WS_XB), wsp<bf16>(F, WS_WIN), T, INW_G, 1024, F.wave}; pg8::StaticOrder S; S.init(T, INW_G, G, bid);
        pg8::EpiInProj E{F.ws};
        pg8::gemm_phase<pg8::EpiInProj, pg8::StaticOrder, true, true>(F.lds, g, S, E);
    }
    GSYNC();
    LAUNDER(); phase_conv(F);
    LAUNDER(); phase_gatescan(F);
    LAUNDER(); for (int u = bid; u < BATCH * 64 * 2; u += G) { const int kvh = u & 1, qb = (u >> 1) & 63, b = u >> 7; wattn_unit(F, b, qb, kvh); }
    GSYNC();
    LAUNDER(); for (int v = bid; v < BATCH * 4 * 2 * 4; v += G) { const int u = (((v >> 5) << 3 | (v & 7)) << 2) | ((v >> 3) & 3); mlstm_state_unit(F, u); }
    GSYNC();
    LAUNDER(); for (int u = bid; u < BATCH * 64 * 4; u += G) mlstm_out_unit(F, u);
    GSYNC();
    LAUNDER(); {
        pg8::Gemm g{wsp<bf16>(F, WS_MIX), wsp<bf16>(F, WS_WOUT), T, 1024, 1024, F.wave}; pg8::StaticOrder S; S.init(T, 1024, G, bid);
        pg8::EpiResid<true> E{wsp<bf16>(F, WS_XB), wsp<bf16>(F, WS_X1B), wsp<float>(F, WS_SSQ1)};
        pg8::gemm_phase<pg8::EpiResid<true>, pg8::StaticOrder, true, true>(F.lds, g, S, E);
    }
    GSYNC();
    LAUNDER(); {
        pg8::Gemm g{wsp<bf16>(F, WS_X1B), wsp<bf16>(F, WS_WMQ), T, 512, 1024, F.wave}; pg8::StaticOrder S; S.init(T, 512, G, bid);
        pg8::EpiHead128<true> E{wsp<bf16>(F, WS_QM), 512, wsp<float>(F, WS_SSQ1), wsp<float>(F, WS_SSQQ), 2, T};
        pg8::gemm_phase<pg8::EpiHead128<true>, pg8::StaticOrder, true, true>(F.lds, g, S, E);
    }
    GSYNC();
    LAUNDER(); xattn_phase(F);
    GSYNC();
    {
        pg8::Gemm g{wsp<bf16>(F, WS_OM), wsp<bf16>(F, WS_WMO), T, 1024, 512, F.wave}; pg8::StaticOrder S; S.init(T, 1024, G, bid);
        pg8::EpiResid<true, true> E{wsp<bf16>(F, WS_X1B), wsp<bf16>(F, WS_X2B), nullptr, wsp<unsigned char>(F, WS_X2F8)};
        pg8::gemm_phase<pg8::EpiResid<true, true>, pg8::StaticOrder, true, true>(F.lds, g, S, E);
    }
    GSYNC();
    LAUNDER(); phase_router(F);
    GSYNC();
    LAUNDER(); for (int u = bid; u < BATCH * NEXP; u += G) select_unit(F, u);
    GSYNC();
    LAUNDER(); {
        pg8::Gemm g{wsp<bf16>(F, WS_X2F8), wsp<bf16>(F, WS_WGU), XROWS, NEXP * 2048, 512, F.wave}; pg8::ExpertOrder<8> S{G, bid};
        pg8::EpiGateUpT<true, 2> E{wsp<bf16>(F, WS_HID), wsp<float>(F, WS_RINVE), 1.0f / (float)(1 << F8_WSHIFT)};
        pg8::gemm_phase<pg8::EpiGateUpT<true, 2>, pg8::ExpertOrder<8>, true, true, true, 1>(F.lds, g, S, E, wsp<int>(F, WS_IDX));
    }
    GSYNC();
    LAUNDER(); {
        pg8::Gemm g{wsp<bf16>(F, WS_HID), wsp<bf16>(F, WS_WD), XROWS, NEXP * 1024, 512, F.wave}; pg8::ExpertOrder<4> S{G, bid};
        pg8::EpiDownT<2, true> E{wsp<bf16>(F, WS_Y), wsp<float>(F, WS_GVAL), (float)(1 << F8_YSHIFT) / (float)(1 << F8_WSHIFT)};
        pg8::gemm_phase<pg8::EpiDownT<2, true>, pg8::ExpertOrder<4>, true, true, false, 1>(F.lds, g, S, E);
    }
    GSYNC();
    LAUNDER(); phase_combine(F);
}

extern "C" void kernel_launch(void* const* d_in, const int* in_sizes, int n_in, void* d_out, int out_size, void* d_ws, size_t ws_size, hipStream_t stream) {
    static int grid = 0;
    if (grid == 0) {
        if (n_in != 25 || in_sizes[0] != T * DM || out_size != T * DM || ws_size < WS_END) { fprintf(stderr, "kernel_launch: unexpected shapes (n_in %d, in0 %d, out %d, ws %zu); nothing launched\n", n_in, n_in > 0 ? in_sizes[0] : -1, out_size, ws_size); grid = -1; return; }
        int dev = 0, cus = 0, per_cu = 0;
        if (hipGetDevice(&dev) != hipSuccess || hipDeviceGetAttribute(&cus, hipDeviceAttributeMultiprocessorCount, dev) != hipSuccess) { grid = -1; return; }
        if (hipFuncSetAttribute((const void*)hymba_fwd, hipFuncAttributeMaxDynamicSharedMemorySize, LDS_BYTES) != hipSuccess) { fprintf(stderr, "kernel_launch: hipFuncSetAttribute failed\n"); grid = -1; return; }
        if (hipOccupancyMaxActiveBlocksPerMultiprocessor(&per_cu, (const void*)hymba_fwd, 512, LDS_BYTES) != hipSuccess || per_cu < 1) { fprintf(stderr, "kernel_launch: occupancy query says %d blocks per CU\n", per_cu); (void)hipGetLastError(); per_cu = 1; }
        grid = cus;
        fprintf(stderr, "kernel_launch: %d CUs, %d blocks/CU by the occupancy query, grid %d, ws %zu\n", cus, per_cu, grid, ws_size);
    }
    if (grid < 0) return;
    Args a{};
    for (int i = 0; i < 25; ++i) a.in[i] = (const float*)d_in[i];
    a.out = (float*)d_out; a.ws = (unsigned char*)d_ws;
    void* kargs[] = {&a};
    const hipError_t e = hipLaunchCooperativeKernel((const void*)hymba_fwd, dim3(grid), dim3(512), kargs, LDS_BYTES, stream);
    if (e != hipSuccess) fprintf(stderr, "kernel_launch: cooperative launch failed: %s (grid %d)\n", hipGetErrorString(e), grid);
}
```

```cpp
#include <hip/hip_runtime.h>
#include <hip/hip_cooperative_groups.h>
#include <cstdio>
#include <cstdint>
namespace cg = cooperative_groups;
namespace pg8 {
#define PG8_LAS __attribute__((address_space(3)))
typedef unsigned short bf16_t;
typedef short bf16x8 __attribute__((ext_vector_type(8)));
typedef float f32x4 __attribute__((ext_vector_type(4)));
typedef unsigned u32x4 __attribute__((ext_vector_type(4)));
typedef float f32x8 __attribute__((ext_vector_type(8)));
typedef int i32x4 __attribute__((ext_vector_type(4)));
typedef int i32x8 __attribute__((ext_vector_type(8)));
template <bool F8> struct Frag;
template <> struct Frag<false> { bf16x8 v[2]; __device__ __forceinline__ void set(int k, bf16x8 x) { v[k] = x; } };
template <> struct Frag<true> { i32x8 v; __device__ __forceinline__ void set(int k, bf16x8 x) { if (k == 0) v.lo = __builtin_bit_cast(i32x4, x); else v.hi = __builtin_bit_cast(i32x4, x); } };
constexpr int BM = 256, BK = 64, HALF = 128, HTB = HALF * BK * 2  , STAGE_BYTES = 8 * HTB, NXCD = 8, WGM = 8;

__host__ __device__ __forceinline__ int lds_byte(int r, int c) { const int st = (r >> 4) * 2 + (c >> 5), rr = r & 15, cc = c & 31, ob = rr * 64 + cc * 2; return st * 1024 + (ob ^ (((ob >> 9) & 1) << 5)); }
__host__ __device__ __forceinline__ void stage_rc(int b, int& R, int& C) { const int st = b / 1024, sb = b % 1024, swz = sb ^ (((sb >> 9) & 1) << 5); R = (st >> 1) * 16 + swz / 64; C = (st & 1) * 32 + (swz % 64) / 2; }
__host__ __device__ __forceinline__ int perm32(int rho) { const int n = rho >> 4, i = rho & 15; return 8 * (i >> 2) + 4 * n + (i & 3); }

struct Unit { int pm, pn; };
struct Gemm { const bf16_t* A; const bf16_t* Bt; int M, N, K; int wave; };
__device__ __forceinline__ int fresh_lane() { unsigned ones = ~0u; asm volatile("" : "+s"(ones)); return (int)__builtin_amdgcn_mbcnt_hi(ones, __builtin_amdgcn_mbcnt_lo(ones, 0u)); }

struct StaticOrder {
    int nM, nN, nwg, G, c;
    __host__ __device__ void init(int M, int N, int G_, int c_) { nM = M / BM; nN = N / BM; nwg = nM * nN; G = G_; c = c_; }
    __host__ __device__ __forceinline__ bool next(int i, Unit& u) const {
        const long L = (long)i * G + c; if (L >= nwg) return false;
        int wgid = (int)L; { const int q = nwg / NXCD, r = nwg % NXCD, xcd = wgid % NXCD, off = wgid / NXCD; wgid = (xcd < r ? xcd * (q + 1) : r * (q + 1) + (xcd - r) * q) + off; }
        const int nig = WGM * nN, gid = wgid / nig, fm = gid * WGM, gsz = (nM - fm) < WGM ? (nM - fm) : WGM;
        u.pm = fm + ((wgid % nig) % gsz); u.pn = (wgid % nig) / gsz; return true;
    }
    __device__ __forceinline__ void a_ready(const Unit&) const {}
    __device__ __forceinline__ void done(const Unit&) const {}
};

__device__ __forceinline__ unsigned cvt_pk_bf16(float lo, float hi) { unsigned r; asm volatile("v_cvt_pk_bf16_f32 %0, %1, %2" : "=v"(r) : "v"(lo), "v"(hi)); return r; }
__device__ __forceinline__ unsigned cvt_pk4_fp8(float a, float b, float c, float d) {
    a = __builtin_amdgcn_fmed3f(a, -448.f, 448.f); b = __builtin_amdgcn_fmed3f(b, -448.f, 448.f); c = __builtin_amdgcn_fmed3f(c, -448.f, 448.f); d = __builtin_amdgcn_fmed3f(d, -448.f, 448.f);
    const int r = __builtin_amdgcn_cvt_pk_fp8_f32(a, b, 0, false); return (unsigned)__builtin_amdgcn_cvt_pk_fp8_f32(c, d, r, true); }
typedef float f32x2 __attribute__((ext_vector_type(2)));
__device__ __forceinline__ f32x2 gelu_pk(f32x2 v) {
    const f32x2 av = __builtin_elementwise_abs(v), d = av * 0.2316418882f + 1.0f;
    f32x2 t; t.x = __builtin_amdgcn_rcpf(d.x); t.y = __builtin_amdgcn_rcpf(d.y);
    f32x2 q = t * 0.5307027145f + (-0.7265760135f); q = q * t + 0.7107068705f; q = q * t + (-0.142248368f); q = q * t + 0.127414796f; q = q * t;
    const f32x2 s = (v * v) * (-0.72134752044f);
    f32x2 e; e.x = __builtin_amdgcn_exp2f(s.x); e.y = __builtin_amdgcn_exp2f(s.y);
    const f32x2 m = v * (q * e), r = v - m;
    f32x2 o; o.x = v.x < 0.f ? m.x : r.x; o.y = v.y < 0.f ? m.y : r.y; return o;
}

template <int ACT  > struct EpiBf16 {
    static constexpr bool PERM = true, AFTER_DRAIN = false; static_assert(ACT == 0 || ACT == 1, "EpiBf16: ACT is 0 (none) or 1 (gelu_pk)");
    bf16_t* O; int ldc; const float* bias; int split_cols; size_t split_stride; float scale0;
    __device__ __forceinline__ void operator()(const f32x4 (&acc)[2][2][4][2], const Unit& u, int wr, int wc, int fr, int fq) const {
        const int row0 = u.pm * BM + wr * 64 + fr; int colt = u.pn * BM; bf16_t* base = O;
        float sc = 1.f; if (split_cols) { const int t = colt / split_cols; base += (size_t)t * split_stride; colt -= t * split_cols; if (t == 0) sc = scale0; }
        const int col0 = colt + wc * 32 + 8 * fq, bcol0 = u.pn * BM + wc * 32 + 8 * fq;
        f32x4 bv[2][2];
#pragma unroll
        for (int bj = 0; bj < 2; ++bj)
#pragma unroll
            for (int n = 0; n < 2; ++n) bv[bj][n] = bias ? *(const f32x4*)(bias + bcol0 + bj * HALF + 4 * n) : (f32x4){0.f, 0.f, 0.f, 0.f};
#pragma unroll
        for (int ai = 0; ai < 2; ++ai)
#pragma unroll
            for (int m = 0; m < 4; ++m) { bf16_t* rowp = base + (size_t)(row0 + ai * HALF + m * 16) * ldc + col0;
#pragma unroll
                for (int bj = 0; bj < 2; ++bj) { f32x4 v0 = acc[ai][bj][m][0] + bv[bj][0], v1 = acc[ai][bj][m][1] + bv[bj][1];
                    if (ACT == 1) { f32x2 a = gelu_pk((f32x2){v0[0], v0[1]}), b = gelu_pk((f32x2){v0[2], v0[3]}), c = gelu_pk((f32x2){v1[0], v1[1]}), d = gelu_pk((f32x2){v1[2], v1[3]});
                        v0 = (f32x4){a.x, a.y, b.x, b.y}; v1 = (f32x4){c.x, c.y, d.x, d.y}; }
                    v0 = v0 * sc; v1 = v1 * sc; u32x4 w; w.x = cvt_pk_bf16(v0[0], v0[1]); w.y = cvt_pk_bf16(v0[2], v0[3]); w.z = cvt_pk_bf16(v1[0], v1[1]); w.w = cvt_pk_bf16(v1[2], v1[3]);
                    *(u32x4*)(rowp + bj * HALF) = w; } }
    }
};
template <class Epi, class Sched, bool ALIGN_EPI = false, bool SP2 = false, bool GATHER = false, int F8W = 0>
__device__ __forceinline__ void gemm_phase(PG8_LAS unsigned char* lds, const Gemm g, const Sched& S, const Epi& E, const int* gidx = nullptr) {
    static_assert(!GATHER || SP2, "GATHER is wired into the SP2 loop only");
    int wid_ = g.wave; asm volatile("" : "+s"(wid_));
    int tid_ = wid_ * 64 + fresh_lane(); asm volatile("" : "+v"(tid_));
    const int tid = tid_, wid = wid_, lane = tid & 63, wr = wid >> 2, wc = wid & 3, fr = lane & 15, fq = lane >> 4;
    const int K = g.K, nt = K / BK;
    unsigned voffA[2], voffB[2];
#pragma unroll
    for (int i = 0; i < 2; ++i) { int R, C; stage_rc(tid * 16 + i * 8192, R, C); const int Rb = Epi::PERM ? ((R & ~31) + perm32(R & 31)) : R;
        voffA[i] = (unsigned)(R * K + C) * 2u; voffB[i] = (unsigned)(Rb * K + C) * 2u; }
    const unsigned rslot = (unsigned)(size_t)(lds + STAGE_BYTES + 8192) + (unsigned)wid * 1024u;
    unsigned gC[2][2];
    const unsigned gslot = (unsigned)(size_t)(lds + STAGE_BYTES) + (unsigned)wid * 1024u;
#define PG8_TFRESH() int t_ = wid * 64 + fresh_lane(); asm volatile("" : "+v"(t_))
#define PG8_GFIRST(pm_) do { PG8_TFRESH(); _Pragma("unroll") for (int h_ = 0; h_ < 2; ++h_) _Pragma("unroll") for (int i_ = 0; i_ < 2; ++i_) { int R_, C_; stage_rc(t_ * 16 + i_ * 8192, R_, C_); \
        const int row_ = (pm_) * BM + h_ * HALF + R_; gC[h_][i_] = ((unsigned)((row_ >> 14) * 8192 + gidx[row_]) * (unsigned)K + (unsigned)C_) * 2u; } } while (0)
#define PG8_GISSUE(pm_) do { PG8_TFRESH(); _Pragma("unroll") for (int h_ = 0; h_ < 2; ++h_) _Pragma("unroll") for (int i_ = 0; i_ < 2; ++i_) { int R_, C_; stage_rc(t_ * 16 + i_ * 8192, R_, C_); \
        const unsigned vo_ = (unsigned)((pm_) * BM + h_ * HALF + R_) * 4u; \
        asm volatile("s_mov_b32 m0, %2\n\ts_nop 0\n\tglobal_load_lds_dword %0, %1" :: "v"(vo_), "s"(gidx), "s"(gslot + (unsigned)((h_ * 2 + i_) * 256)) : "memory", "m0"); } } while (0)
#define PG8_GTAKE(pm_) do { PG8_TFRESH(); _Pragma("unroll") for (int h_ = 0; h_ < 2; ++h_) _Pragma("unroll") for (int i_ = 0; i_ < 2; ++i_) { int R_, C_; stage_rc(t_ * 16 + i_ * 8192, R_, C_); \
        const int row_ = (pm_) * BM + h_ * HALF + R_; const unsigned raw_ = *(const PG8_LAS unsigned*)(lds + STAGE_BYTES + wid * 1024 + (h_ * 2 + i_) * 256 + (t_ & 63) * 4); \
        gC[h_][i_] = ((unsigned)((row_ >> 14) * 8192 + (int)raw_) * (unsigned)K + (unsigned)C_) * 2u; } } while (0)
    const size_t kstep = (size_t)(BK * 2);
    const size_t hstep = (size_t)HALF * K * 2;
    const size_t tstep = 2 * hstep;
    const unsigned ldsw = (unsigned)wid * 1024u;
    const int aoff = lds_byte(wr * 64 + fr, fq * 8), boff = lds_byte(wc * 32 + fr, fq * 8);
#define PG8_SA(b, h) (((b) * 2 + (h)) * HTB)
#define PG8_SB(b, h) ((4 + (b) * 2 + (h)) * HTB)
#define PG8_GLDS(voff32, gbase, ldsaddr) asm volatile("s_mov_b32 m0, %2\n\ts_nop 0\n\tglobal_load_lds_dwordx4 %0, %1" :: "v"(voff32), "s"(gbase), "s"(ldsaddr) : "memory", "m0")
#define PG8_STAGE(bufoff, gbase, voff) do { const char* gb_ = (const char*)(gbase); const unsigned la_ = (unsigned)(size_t)(lds + (bufoff)) + ldsw; \
        PG8_GLDS((voff)[0], gb_, la_); PG8_GLDS((voff)[1], gb_, la_ + 8192u); } while (0)
#define PG8_STAGE_A(bufoff, aptr, h, nx) do { if constexpr (GATHER) { const char* gb_ = (const char*)(aptr); const unsigned la_ = (unsigned)(size_t)(lds + (bufoff)) + ldsw; \
        PG8_GLDS(gC[h][0], gb_, la_); PG8_GLDS(gC[h][1], gb_, la_ + 8192u); } \
    else { PG8_STAGE(bufoff, (aptr) + (h) * hstep, voffA); } } while (0)
#define PG8_LDA(dst, b, h) do { _Pragma("unroll") for (int m = 0; m < 4; ++m) _Pragma("unroll") for (int k = 0; k < 2; ++k) dst[m].set(k, *(const PG8_LAS bf16x8*)(lds + PG8_SA(b, h) + aoff + m * 2048 + k * 1024)); } while (0)
#define PG8_LDB(dst, b, h) do { _Pragma("unroll") for (int n = 0; n < 2; ++n) _Pragma("unroll") for (int k = 0; k < 2; ++k) dst[n].set(k, *(const PG8_LAS bf16x8*)(lds + PG8_SB(b, h) + boff + n * 2048 + k * 1024)); } while (0)
#define PG8_MMA(ai, bj, At, Bt) do { __builtin_amdgcn_s_setprio(1); _Pragma("unroll") for (int m = 0; m < 4; ++m) _Pragma("unroll") for (int n = 0; n < 2; ++n) { \
        if constexpr (F8W != 0) acc[ai][bj][m][n] = __builtin_amdgcn_mfma_scale_f32_16x16x128_f8f6f4(Bt[n].v, At[m].v, acc[ai][bj][m][n], 0, 0, 0, 0, 0, 0);   \
        else { _Pragma("unroll") for (int k = 0; k < 2; ++k) acc[ai][bj][m][n] = __builtin_amdgcn_mfma_f32_16x16x32_bf16(Bt[n].v[k], At[m].v[k], acc[ai][bj][m][n], 0, 0, 0); } } __builtin_amdgcn_s_setprio(0); } while (0)
#define PG8_WAIT_V(n) asm volatile("s_waitcnt vmcnt(" #n ")" ::: "memory")
#define PG8_WAIT_L(n) asm volatile("s_waitcnt lgkmcnt(" #n ")" ::: "memory")
#define PG8_BAR __builtin_amdgcn_s_barrier()
#define PG8_SCHED __builtin_amdgcn_sched_barrier(0)
    Unit cur, nxt; int ui = 0;
    if (!S.next(0, cur)) return;
    f32x4 acc[2][2][4][2];
#define PG8_ZERO() do { _Pragma("unroll") for (int a = 0; a < 2; ++a) _Pragma("unroll") for (int b = 0; b < 2; ++b) _Pragma("unroll") for (int m = 0; m < 4; ++m) _Pragma("unroll") for (int n = 0; n < 2; ++n) \
        acc[a][b][m][n] = (f32x4){0.f, 0.f, 0.f, 0.f}; } while (0)
    PG8_ZERO();
    Frag<(F8W != 0)> At[4], B0[2], B1[2];
    const char* cA = GATHER ? (const char*)g.A : (const char*)g.A + (size_t)cur.pm * tstep; const char* cB = (const char*)g.Bt + (size_t)cur.pn * tstep;
    if constexpr (GATHER) { PG8_GFIRST(cur.pm); }
    S.a_ready(cur);
    E.prefetch(cur, wr, fr, rslot);
    if constexpr (SP2) {
        PG8_STAGE(PG8_SB(0, 0), cB, voffB); PG8_STAGE(PG8_SB(0, 1), cB + hstep, voffB); PG8_STAGE_A(PG8_SA(0, 0), cA, 0, false); PG8_STAGE_A(PG8_SA(0, 1), cA, 1, false);
        if (wr == 1) PG8_BAR;
        PG8_WAIT_V(2); PG8_BAR;
        PG8_STAGE(PG8_SB(1, 0), cB + kstep, voffB); PG8_STAGE_A(PG8_SA(1, 0), cA + kstep, 0, false); PG8_STAGE(PG8_SB(1, 1), cB + hstep + kstep, voffB);
        PG8_WAIT_V(6); PG8_BAR;
    } else {
        PG8_STAGE(PG8_SB(0, 0), cB, voffB); PG8_STAGE(PG8_SA(0, 0), cA, voffA); PG8_STAGE(PG8_SB(0, 1), cB + hstep, voffB); PG8_STAGE(PG8_SA(0, 1), cA + hstep, voffA);
        if (wr == 1) PG8_BAR;
        PG8_WAIT_V(4); PG8_BAR;
        PG8_STAGE(PG8_SB(1, 0), cB + kstep, voffB); PG8_STAGE(PG8_SA(1, 0), cA + kstep, voffA); PG8_STAGE(PG8_SB(1, 1), cB + hstep + kstep, voffB);
        PG8_WAIT_V(6); PG8_BAR;
    }
    for (;;) {
        const bool has_next = S.next(ui + 1, nxt);
        if constexpr (GATHER) { if (has_next) PG8_GISSUE(nxt.pm); }
        const char* nA = (has_next && !GATHER) ? (const char*)g.A + (size_t)nxt.pm * tstep : cA; const char* nB = has_next ? (const char*)g.Bt + (size_t)nxt.pn * tstep : cB;
#pragma unroll 1
        for (int t = 0; t < nt; t += 2) {
            const bool last = (t == nt - 2);
            const char* a1 = cA + (size_t)(t + 1) * kstep;
            const char* a2 = last ? nA : cA + (size_t)(t + 2) * kstep; const char* b2 = last ? nB : cB + (size_t)(t + 2) * kstep;
            const char* a3 = a2 + kstep; const char* b3 = b2 + kstep;
            if (last && has_next) S.a_ready(nxt);
            if constexpr (SP2) {
            PG8_LDB(B0, 0, 0); PG8_LDB(B1, 0, 1); PG8_SCHED; PG8_LDA(At, 0, 0); PG8_STAGE_A(PG8_SA(1, 1), a1, 1, false);
            if constexpr (GATHER) { if (last && has_next) PG8_GTAKE(nxt.pm); }
            PG8_WAIT_V(8); PG8_WAIT_L(0); PG8_BAR; PG8_MMA(0, 0, At, B0); PG8_MMA(0, 1, At, B1); PG8_BAR; PG8_SCHED;
            PG8_LDA(At, 0, 1); PG8_STAGE(PG8_SB(0, 0), b2, voffB); PG8_STAGE(PG8_SB(0, 1), b2 + hstep, voffB); PG8_STAGE_A(PG8_SA(0, 0), a2, 0, last);
            PG8_WAIT_V(8); PG8_WAIT_L(0); PG8_BAR; PG8_MMA(1, 0, At, B0); PG8_MMA(1, 1, At, B1); PG8_BAR; PG8_SCHED;
            PG8_LDB(B0, 1, 0); PG8_LDB(B1, 1, 1); PG8_SCHED; PG8_LDA(At, 1, 0); PG8_STAGE_A(PG8_SA(0, 1), a2, 1, last);
            PG8_WAIT_V(8); PG8_WAIT_L(0); PG8_BAR; PG8_MMA(0, 0, At, B0); PG8_MMA(0, 1, At, B1); PG8_BAR; PG8_SCHED;
            PG8_LDA(At, 1, 1); PG8_STAGE(PG8_SB(1, 0), b3, voffB); PG8_STAGE(PG8_SB(1, 1), b3 + hstep, voffB); PG8_STAGE_A(PG8_SA(1, 0), a3, 0, last);
            PG8_WAIT_V(8); PG8_WAIT_L(0); PG8_BAR; PG8_MMA(1, 0, At, B0); PG8_MMA(1, 1, At, B1); PG8_BAR; PG8_SCHED;
            } else {
            PG8_LDB(B0, 0, 0); PG8_SCHED; PG8_LDA(At, 0, 0); PG8_STAGE(PG8_SA(1, 1), a1 + hstep, voffA);
            PG8_WAIT_L(8); PG8_BAR; PG8_WAIT_L(0); PG8_MMA(0, 0, At, B0); PG8_BAR; PG8_SCHED;
            PG8_LDB(B1, 0, 1); PG8_STAGE(PG8_SB(0, 0), b2, voffB);
            PG8_BAR; PG8_WAIT_L(0); PG8_MMA(0, 1, At, B1); PG8_BAR;
            PG8_LDA(At, 0, 1); PG8_STAGE(PG8_SA(0, 0), a2, voffA);
            PG8_BAR; PG8_WAIT_L(0); PG8_MMA(1, 0, At, B0); PG8_BAR; PG8_SCHED;
            PG8_STAGE(PG8_SB(0, 1), b2 + hstep, voffB);
            PG8_WAIT_V(6); PG8_BAR; PG8_MMA(1, 1, At, B1); PG8_BAR;
            PG8_LDB(B0, 1, 0); PG8_SCHED; PG8_LDA(At, 1, 0); PG8_STAGE(PG8_SA(0, 1), a2 + hstep, voffA);
            PG8_WAIT_L(8); PG8_BAR; PG8_WAIT_L(0); PG8_MMA(0, 0, At, B0); PG8_BAR; PG8_SCHED;
            PG8_LDB(B1, 1, 1); PG8_STAGE(PG8_SB(1, 0), b3, voffB);
            PG8_BAR; PG8_WAIT_L(0); PG8_MMA(0, 1, At, B1); PG8_BAR;
            PG8_LDA(At, 1, 1); PG8_STAGE(PG8_SA(1, 0), a3, voffA);
            PG8_BAR; PG8_WAIT_L(0); PG8_MMA(1, 0, At, B0); PG8_BAR; PG8_SCHED;
            PG8_STAGE(PG8_SB(1, 1), b3 + hstep, voffB);
            PG8_WAIT_V(6); PG8_BAR; PG8_MMA(1, 1, At, B1); PG8_BAR;
            }
        }
        if constexpr (ALIGN_EPI) { if (wr == 0) PG8_BAR; }
        if constexpr (!Epi::AFTER_DRAIN) { const int le_ = fresh_lane(); E(acc, cur, wr, wc, le_ & 15, le_ >> 4); S.done(cur); }
        if (!has_next) break;
        PG8_ZERO();
        cur = nxt; cA = nA; cB = nB; ++ui;
        E.prefetch(cur, wr, fr, rslot);
        if constexpr (ALIGN_EPI) { if (wr == 1) PG8_BAR; }
    }
    PG8_WAIT_V(0);
    if constexpr (!ALIGN_EPI) { if (wr == 0) PG8_BAR; }
    PG8_BAR;
    if constexpr (Epi::AFTER_DRAIN) { E.fused(acc, cur, wr, wc, fr, fq, lds, wid, lane); S.done(cur); }
#undef PG8_ZERO
#undef PG8_SA
#undef PG8_SB
#undef PG8_STAGE
#undef PG8_GLDS
#undef PG8_STAGE_A
#undef PG8_TFRESH
#undef PG8_GFIRST
#undef PG8_GISSUE
#undef PG8_GTAKE
#undef PG8_LDA
#undef PG8_LDB
#undef PG8_MMA
#undef PG8_WAIT_V
#undef PG8_WAIT_L
#undef PG8_BAR
#undef PG8_SCHED
}
}
constexpr int BATCH = 8, SEQ = 8192, DM = 1024, T = BATCH * SEQ;
constexpr int INW = 2832, INW_G = 2816;
constexpr int NEXP = 16, CAP = 1024, FF = 1024, MEMT = 256;
constexpr int XROWS = BATCH * NEXP * CAP;
constexpr float EPS = 1e-6f;
constexpr float LOG2E = 1.4426950408889634f;

#define GAS __attribute__((address_space(1)))
#define LAS __attribute__((address_space(3)))
typedef unsigned short bf16;
typedef unsigned u32x4 __attribute__((ext_vector_type(4)));
typedef unsigned u32x2 __attribute__((ext_vector_type(2)));
typedef float f32x4 __attribute__((ext_vector_type(4)));
typedef float f32x2 __attribute__((ext_vector_type(2)));
typedef float f32x16 __attribute__((ext_vector_type(16)));
typedef short bf16x8 __attribute__((ext_vector_type(8)));
typedef short bf16x4 __attribute__((ext_vector_type(4)));

constexpr size_t MiB = 1u << 20;
constexpr size_t WS_CTL = 0;
constexpr size_t WS_GATES = 1 * MiB;
constexpr size_t WS_SSQAQ = 5 * MiB;
constexpr size_t WS_SSQAK = 9 * MiB;
constexpr size_t WS_SSQ1 = 10 * MiB;
constexpr size_t WS_SSQQ = 14 * MiB;
constexpr size_t WS_SSQ2 = 18 * MiB;
constexpr size_t WS_AFF = 22 * MiB;
constexpr size_t WS_SLOT = 26 * MiB;
constexpr size_t WS_N0 = 30 * MiB;
constexpr size_t WS_MEMN = 32 * MiB;
constexpr size_t WS_KVM = 36 * MiB;
constexpr size_t WS_SSQMK = 40 * MiB;
constexpr size_t WS_RINV2 = 40 * MiB + 256 * 1024;
constexpr size_t WS_IDX = 40 * MiB + 512 * 1024;
constexpr size_t WS_GVAL = 41 * MiB;
constexpr size_t WS_RINVE = 41 * MiB + 512 * 1024;
constexpr size_t WS_WST = 43 * MiB;
constexpr size_t WS_FTA = 45 * MiB;
constexpr size_t WS_RINVX = 47 * MiB + 64 * 1024;
constexpr size_t WS_DEC = 47 * MiB;
constexpr size_t WS_ESA = 60 * MiB;
constexpr size_t WS_WG16 = 42 * MiB;
constexpr size_t WS_WRHI = 42 * MiB + 64 * 1024;
constexpr size_t WS_WRLO = 42 * MiB + 128 * 1024;
constexpr size_t WS_WIN = 48 * MiB;
constexpr size_t WS_WOUT = 54 * MiB;
constexpr size_t WS_WMQ = 56 * MiB;
constexpr size_t WS_WKV = 57 * MiB;
constexpr size_t WS_WMO = 59 * MiB;
constexpr size_t WS_WGU = 64 * MiB;
constexpr size_t WS_WD = 128 * MiB;
constexpr size_t WS_A = 160 * MiB;
constexpr size_t WS_AQ = WS_A, WS_AK = WS_A + 64 * MiB, WS_AV = WS_A + 80 * MiB, WS_MQ = WS_A + 96 * MiB, WS_MK = WS_A + 160 * MiB, WS_MV = WS_A + 224 * MiB, WS_MO = WS_A + 288 * MiB;
constexpr size_t WS_XE = WS_A, WS_Y = WS_A;
constexpr size_t WS_B = 512 * MiB;
constexpr size_t WS_XN = WS_B, WS_MIX = WS_B, WS_QM = WS_B, WS_OM = WS_B + 64 * MiB;
constexpr size_t WS_C = 640 * MiB;
constexpr size_t WS_C0 = WS_C, WS_X1B = WS_C;
constexpr size_t WS_X2B = 768 * MiB;
constexpr size_t WS_HID = WS_B;
constexpr size_t WS_QC = 768 * MiB, WS_KC = 832 * MiB;
constexpr size_t WS_XB = 896 * MiB;
constexpr size_t WS_X2F8 = WS_A;
constexpr size_t WS_END = 1024 * MiB;
constexpr int F8_YSHIFT = 3;
constexpr int F8_WSHIFT = 5;

constexpr int LDS_BYTES = 155648;

__device__ __forceinline__ unsigned f2bf(float f) { unsigned u = __builtin_bit_cast(unsigned, f); return (u + 0x7fffu + ((u >> 16) & 1u)) >> 16; }
typedef __bf16 hwbf16x2 __attribute__((ext_vector_type(2)));
__device__ __forceinline__ unsigned pk2(float lo, float hi) { const f32x2 v = {lo, hi}; return __builtin_bit_cast(unsigned, __builtin_convertvector(v, hwbf16x2)); }
__device__ __forceinline__ float bf2f(unsigned short h) { return __builtin_bit_cast(float, (unsigned)h << 16); }
__device__ __forceinline__ float bflo(unsigned w) { return __builtin_bit_cast(float, w << 16); }
__device__ __forceinline__ float bfhi(unsigned w) { return __builtin_bit_cast(float, w & 0xffff0000u); }
__device__ __forceinline__ float wave_sum(float v) {
#pragma unroll
    for (int o = 1; o < 64; o <<= 1) v += __shfl_xor(v, o);
    return v;
}
__device__ __forceinline__ f32x16 mfma32(bf16x8 a, bf16x8 b, f32x16 c) { return __builtin_amdgcn_mfma_f32_32x32x16_bf16(a, b, c, 0, 0, 0); }
__device__ __forceinline__ f32x4 mfma16(bf16x8 a, bf16x8 b, f32x4 c) { return __builtin_amdgcn_mfma_f32_16x16x32_bf16(a, b, c, 0, 0, 0); }
#define LDS_WAIT() asm volatile("s_waitcnt lgkmcnt(0)" ::: "memory")

enum { I_X = 0, I_MEM, I_NORM_MIX_G, I_W_IN, I_ATT_Q_G, I_ATT_K_G, I_ATT_SINK, I_CONV_W, I_CONV_B, I_GATE_B, I_ML_OUT_G, I_W_OUT, I_NORM_MEM_G, I_MEM_KV_G,
       I_W_MEM_Q, I_W_MEM_KV, I_MEM_Q_G, I_MEM_K_G, I_W_MEM_O, I_NORM_FFN_G, I_W_ROUTER, I_B_ROUTER, I_W_GATE, I_W_UP, I_W_DOWN };
#define CAS __attribute__((address_space(4)))
struct Frame {
    LAS unsigned char* lds;
    int tid, lane, wave, bid, G;
    float* out; unsigned char* ws;
};
__device__ __forceinline__ const float* inp(int i) { const volatile CAS unsigned long long* ka = (const volatile CAS unsigned long long*)__builtin_amdgcn_kernarg_segment_ptr(); return (const float*)(const GAS float*)ka[i]; }
template <class Tp> __device__ __forceinline__ Tp* wsp(const Frame& F, size_t off) { return (Tp*)(GAS Tp*)(F.ws + off); }

namespace pg8 {
struct EpiInProj {
    static constexpr bool PERM = true, AFTER_DRAIN = false;
    unsigned char* ws; mutable float rpre[8];
    __device__ __forceinline__ void prefetch(const Unit& u, int wr, int fr, unsigned rslot) const { const float* rx = (const float*)(ws + WS_RINVX) + u.pm * BM + wr * 64 + fr;
#pragma unroll
        for (int i = 0; i < 8; ++i) rpre[i] = rx[(i >> 2) * HALF + (i & 3) * 16]; }
    __device__ __forceinline__ void operator()(const f32x4 (&acc)[2][2][4][2], const Unit& u, int wr, int wc, int fr, int fq) const {
        const int pn = u.pn;
        bf16_t* base[2]; int ld[2];
        if (pn < 2) { base[0] = (bf16_t*)(ws + WS_AQ) + 256 * pn; base[1] = base[0] + 128; ld[0] = ld[1] = 512; }
        else if (pn == 2) { base[0] = (bf16_t*)(ws + WS_AK); base[1] = (bf16_t*)(ws + WS_AV); ld[0] = ld[1] = 128; }
        else { const int s = (pn - 3) >> 1; base[0] = (bf16_t*)(ws + WS_MQ + (size_t)s * (64u << 20)) + 256 * ((pn - 3) & 1); base[1] = base[0] + 128; ld[0] = ld[1] = 512; }
        const int row0 = u.pm * BM + wr * 64 + fr, cw = wc * 32 + 8 * fq;
        float* sq = (float*)(ws + WS_SSQAQ); float* sk = (float*)(ws + WS_SSQAK);
#pragma unroll
        for (int ai = 0; ai < 2; ++ai)
#pragma unroll
            for (int m = 0; m < 4; ++m) {
                const int row = row0 + ai * HALF + m * 16; const float rs = rpre[ai * 4 + m];
#pragma unroll
                for (int bj = 0; bj < 2; ++bj) {
                    const f32x4 v0 = acc[ai][bj][m][0] * rs, v1 = acc[ai][bj][m][1] * rs;
                    u32x4 w; w.x = cvt_pk_bf16(v0[0], v0[1]); w.y = cvt_pk_bf16(v0[2], v0[3]); w.z = cvt_pk_bf16(v1[0], v1[1]); w.w = cvt_pk_bf16(v1[2], v1[3]);
                    *(GAS u32x4*)(base[bj] + (size_t)row * ld[bj] + cw) = w;
                    if (pn < 2 || (pn == 2 && bj == 0)) {
                        float s = (v0[0] * v0[0] + v0[1] * v0[1]) + (v0[2] * v0[2] + v0[3] * v0[3]) + (v1[0] * v1[0] + v1[1] * v1[1]) + (v1[2] * v1[2] + v1[3] * v1[3]);
                        s += __shfl_xor(s, 16); s += __shfl_xor(s, 32);
                        if (fq == 0) { if (pn < 2) sq[(size_t)((pn * 4 + bj * 2 + (wc >> 1)) * 2 + (wc & 1)) * T + row] = s; else sk[(size_t)wc * T + row] = s; }
                    }
                }
            }
    }
};
template <bool ROWSCALE> struct EpiHead128 {
    static constexpr bool PERM = true, AFTER_DRAIN = false;
    bf16_t* O; int ldc; const float* ssq_in; float* ssq_out; int nssq_tiles; int nrows;
    mutable float rpre[8];
    __device__ __forceinline__ void prefetch(const Unit& u, int wr, int fr, unsigned rslot) const {
        if (ROWSCALE) {
#pragma unroll
            for (int i = 0; i < 8; ++i) { const int row = u.pm * BM + wr * 64 + fr + (i >> 2) * HALF + (i & 3) * 16;
                rpre[i] = ssq_in[row]; }
        }
    }
    __device__ __forceinline__ void operator()(const f32x4 (&acc)[2][2][4][2], const Unit& u, int wr, int wc, int fr, int fq) const {
        const int row0 = u.pm * BM + wr * 64 + fr, col0 = u.pn * BM + wc * 32 + 8 * fq;
#pragma unroll
        for (int ai = 0; ai < 2; ++ai)
#pragma unroll
            for (int m = 0; m < 4; ++m) {
                const int row = row0 + ai * HALF + m * 16;
                const float rs = ROWSCALE ? rpre[ai * 4 + m] : 1.f;
#pragma unroll
                for (int bj = 0; bj < 2; ++bj) {
                    const f32x4 v0 = acc[ai][bj][m][0] * rs, v1 = acc[ai][bj][m][1] * rs;
                    u32x4 w; w.x = cvt_pk_bf16(v0[0], v0[1]); w.y = cvt_pk_bf16(v0[2], v0[3]); w.z = cvt_pk_bf16(v1[0], v1[1]); w.w = cvt_pk_bf16(v1[2], v1[3]);
                    *(u32x4*)(O + (size_t)row * ldc + col0 + bj * HALF) = w;
                    if (u.pn < nssq_tiles) {
                        float s = (v0[0] * v0[0] + v0[1] * v0[1]) + (v0[2] * v0[2] + v0[3] * v0[3]) + (v1[0] * v1[0] + v1[1] * v1[1]) + (v1[2] * v1[2] + v1[3] * v1[3]);
                        s += __shfl_xor(s, 16); s += __shfl_xor(s, 32);
                        if (fq == 0) ssq_out[(size_t)((2 * u.pn + bj) * 4 + wc) * nrows + row] = s;
                    }
                }
            }
    }
};
template <bool BASE_BF16, bool F8COPY = false> struct EpiResid {
    static constexpr bool PERM = true, AFTER_DRAIN = false;
    const void* base; bf16_t* outb; float* ssq; unsigned char* out8;
    __device__ __forceinline__ void prefetch(const Unit&, int, int, unsigned) const {}
    __device__ __forceinline__ void operator()(const f32x4 (&acc)[2][2][4][2], const Unit& u, int wr, int wc, int fr, int fq) const {
        const int row0 = u.pm * BM + wr * 64 + fr, col0 = u.pn * BM + wc * 32 + 8 * fq;
        u32x4 bw[2][4][2]; f32x4 bf[2][4][2][2];
#pragma unroll
        for (int ai = 0; ai < 2; ++ai)
#pragma unroll
            for (int m = 0; m < 4; ++m)
#pragma unroll
                for (int bj = 0; bj < 2; ++bj) { const size_t off = (size_t)(row0 + ai * HALF + m * 16) * 1024 + col0 + bj * HALF;
                    if (BASE_BF16) bw[ai][m][bj] = *(const u32x4*)((const bf16_t*)base + off);
                    else { bf[ai][m][bj][0] = *(const f32x4*)((const float*)base + off); bf[ai][m][bj][1] = *(const f32x4*)((const float*)base + off + 4); } }
        __builtin_amdgcn_sched_barrier(0);
#pragma unroll
        for (int ai = 0; ai < 2; ++ai)
#pragma unroll
            for (int m = 0; m < 4; ++m) {
                const int row = row0 + ai * HALF + m * 16; const size_t off = (size_t)row * 1024 + col0;
                float s = 0.f;
#pragma unroll
                for (int bj = 0; bj < 2; ++bj) {
                    f32x4 b0, b1;
                    if (BASE_BF16) { const u32x4 w_ = bw[ai][m][bj];
                        b0[0] = __builtin_bit_cast(float, w_.x << 16); b0[1] = __builtin_bit_cast(float, w_.x & 0xffff0000u); b0[2] = __builtin_bit_cast(float, w_.y << 16); b0[3] = __builtin_bit_cast(float, w_.y & 0xffff0000u);
                        b1[0] = __builtin_bit_cast(float, w_.z << 16); b1[1] = __builtin_bit_cast(float, w_.z & 0xffff0000u); b1[2] = __builtin_bit_cast(float, w_.w << 16); b1[3] = __builtin_bit_cast(float, w_.w & 0xffff0000u); }
                    else { b0 = bf[ai][m][bj][0]; b1 = bf[ai][m][bj][1]; }
                    const f32x4 v0 = acc[ai][bj][m][0] + b0, v1 = acc[ai][bj][m][1] + b1;
                    u32x4 w; w.x = cvt_pk_bf16(v0[0], v0[1]); w.y = cvt_pk_bf16(v0[2], v0[3]); w.z = cvt_pk_bf16(v1[0], v1[1]); w.w = cvt_pk_bf16(v1[2], v1[3]);
                    *(u32x4*)(outb + off + bj * HALF) = w;
                    if constexpr (F8COPY) { u32x2 w8; w8.x = cvt_pk4_fp8(v0[0], v0[1], v0[2], v0[3]); w8.y = cvt_pk4_fp8(v1[0], v1[1], v1[2], v1[3]); *(u32x2*)(out8 + off + bj * HALF) = w8; }
                    s += (v0[0] * v0[0] + v0[1] * v0[1]) + (v0[2] * v0[2] + v0[3] * v0[3]) + (v1[0] * v1[0] + v1[1] * v1[1]) + (v1[2] * v1[2] + v1[3] * v1[3]);
                }
                s += __shfl_xor(s, 16); s += __shfl_xor(s, 32);
                if (ssq != nullptr && fq == 0) ssq[(size_t)(u.pn * 4 + wc) * T + row] = s;
            }
    }
};
__device__ __forceinline__ void rows_to_lds(const float* src, unsigned slot) {
    const unsigned vo = (unsigned)fresh_lane() * 4u;
#pragma unroll
    for (int j = 0; j < 4; ++j) asm volatile("s_mov_b32 m0, %2\n\ts_nop 0\n\tglobal_load_lds_dword %0, %1" :: "v"(vo), "s"(src + 64 * j), "s"(slot + 256u * j) : "memory", "m0");
}
template <bool F8OUT, int PREF = 1> struct EpiGateUpT {
    static constexpr bool PERM = true, AFTER_DRAIN = false;
    bf16_t* H; const float* rinv; float oscale; mutable float rpre[8]; mutable unsigned rs;
    __device__ __forceinline__ void prefetch(const Unit& u, int wr, int fr, unsigned rslot) const { if constexpr (PREF == 0) return; if constexpr (PREF == 2) { rs = rslot; rows_to_lds(rinv + u.pm * BM, rslot); return; } const float* p = rinv + u.pm * BM + wr * 64 + fr;
#pragma unroll
        for (int i = 0; i < 8; ++i) rpre[i] = p[(i >> 2) * HALF + (i & 3) * 16]; }
    __device__ __forceinline__ void operator()(const f32x4 (&acc)[2][2][4][2], const Unit& u, int wr, int wc, int fr, int fq) const {
        const int row0 = u.pm * BM + wr * 64 + fr, col0 = (u.pn & 7) * 128 + wc * 32 + 8 * fq;
#pragma unroll
        for (int ai = 0; ai < 2; ++ai)
#pragma unroll
            for (int m = 0; m < 4; ++m) {
                const int row = row0 + ai * HALF + m * 16; const float r = (PREF == 1 ? rpre[ai * 4 + m] : PREF == 2 ? ((const LAS float*)(size_t)rs)[ai * HALF + wr * 64 + m * 16 + fr] : rinv[row]) * oscale;
                const f32x2 rr2 = {r * r, r * r}, rl2 = {r * -1.4426950408889634f, r * -1.4426950408889634f}, one2 = {1.0f, 1.0f};
                float h[8];
#pragma unroll
                for (int n = 0; n < 2; ++n)
#pragma unroll
                    for (int e = 0; e < 4; e += 2) { const f32x2 g2 = {acc[ai][0][m][n][e], acc[ai][0][m][n][e + 1]}, u2 = {acc[ai][1][m][n][e], acc[ai][1][m][n][e + 1]};
                        const f32x2 p2 = (g2 * u2) * rr2, t2 = g2 * rl2; f32x2 d2 = {__builtin_amdgcn_exp2f(t2[0]), __builtin_amdgcn_exp2f(t2[1])}; d2 = d2 + one2;
                        const f32x2 q2 = {__builtin_amdgcn_rcpf(d2[0]), __builtin_amdgcn_rcpf(d2[1])}, h2 = p2 * q2; h[n * 4 + e] = h2[0]; h[n * 4 + e + 1] = h2[1]; }
                if constexpr (F8OUT) {
                    u32x2 w; w.x = cvt_pk4_fp8(h[0], h[1], h[2], h[3]); w.y = cvt_pk4_fp8(h[4], h[5], h[6], h[7]);
                    *(u32x2*)((unsigned char*)H + (size_t)row * 1024 + col0) = w;
                } else {
                    u32x4 w; w.x = cvt_pk_bf16(h[0], h[1]); w.y = cvt_pk_bf16(h[2], h[3]); w.z = cvt_pk_bf16(h[4], h[5]); w.w = cvt_pk_bf16(h[6], h[7]);
                    *(u32x4*)(H + (size_t)row * 1024 + col0) = w;
                }
            }
    }
};
using EpiGateUp = EpiGateUpT<false>;
template <int PREF, bool F8Y = false> struct EpiDownT {
    static constexpr bool PERM = true, AFTER_DRAIN = false;
    bf16_t* Y; const float* gval; float oscale; mutable float rpre[8]; mutable unsigned rs;
    __device__ __forceinline__ void prefetch(const Unit& u, int wr, int fr, unsigned rslot) const { if constexpr (PREF == 0) return; if constexpr (PREF == 2) { rs = rslot; rows_to_lds(gval + u.pm * BM, rslot); return; } const float* p = gval + u.pm * BM + wr * 64 + fr;
#pragma unroll
        for (int i = 0; i < 8; ++i) rpre[i] = p[(i >> 2) * HALF + (i & 3) * 16]; }
    __device__ __forceinline__ void operator()(const f32x4 (&acc)[2][2][4][2], const Unit& u, int wr, int wc, int fr, int fq) const {
        int row0 = u.pm * BM + wr * 64 + fr, col0 = (u.pn & 3) * BM + wc * 32 + 8 * fq;
        asm volatile("" : "+v"(row0), "+v"(col0));
#pragma unroll
        for (int ai = 0; ai < 2; ++ai)
#pragma unroll
            for (int m = 0; m < 4; ++m) {
                const int row = row0 + ai * HALF + m * 16; const float r = (PREF == 1 ? rpre[ai * 4 + m] : PREF == 2 ? ((const LAS float*)(size_t)rs)[ai * HALF + wr * 64 + m * 16 + fr] : gval[row]) * oscale;
#pragma unroll
                for (int bj = 0; bj < 2; ++bj) {
                    const f32x4 v0 = acc[ai][bj][m][0] * r, v1 = acc[ai][bj][m][1] * r;
                    if constexpr (F8Y) { u32x2 w8; w8.x = cvt_pk4_fp8(v0[0], v0[1], v0[2], v0[3]); w8.y = cvt_pk4_fp8(v1[0], v1[1], v1[2], v1[3]); *(u32x2*)((unsigned char*)Y + (size_t)row * 1024 + col0 + bj * HALF) = w8; }
                    else { u32x4 w; w.x = cvt_pk_bf16(v0[0], v0[1]); w.y = cvt_pk_bf16(v0[2], v0[3]); w.z = cvt_pk_bf16(v1[0], v1[1]); w.w = cvt_pk_bf16(v1[2], v1[3]);
                        *(u32x4*)(Y + (size_t)row * 1024 + col0 + bj * HALF) = w; }
                }
            }
    }
};
using EpiDown = EpiDownT<1>;
template <int NT> struct ExpertOrder {
    int G, c;
    __device__ bool next(int i, Unit& u) const {
        constexpr int UPG = 4 * NT, NU = 128 * UPG;
        const int L = i * G + c; if (L >= NU) return false;
        const int xcd = L & 7, off = L >> 3, idx = xcd * (NU / 8) + off;
        const int g = idx / UPG, w = idx % UPG, e = g >> 3, b = g & 7;
        u.pm = (b * 16 + e) * 4 + (w & 3); u.pn = e * NT + (w >> 2); return true;
    }
    __device__ __forceinline__ void a_ready(const Unit&) const {}
    __device__ __forceinline__ void done(const Unit&) const {}
};
}
#define XB_TMO      128
#define XB_XCNT(j)  (256  + 64 * (j))
#define XB_XSUB(j)  (1280 + 64 * (j))
#define XB_XGEN(j)  (2304 + 64 * (j))
#define XB_TOP      3328
#define XB_TOPGEN   3392
#define XCD_BAR_WORDS 3456
#define XB_SPIN_CAP (1u << 18)

__device__ __forceinline__ unsigned xb_ld(unsigned* p)              { return __hip_atomic_load(p, __ATOMIC_RELAXED, __HIP_MEMORY_SCOPE_AGENT); }
__device__ __forceinline__ unsigned xb_add(unsigned* p, unsigned v) { return __hip_atomic_fetch_add(p, v, __ATOMIC_RELAXED, __HIP_MEMORY_SCOPE_AGENT); }
__device__ __forceinline__ unsigned xb_xcc_id() { return (unsigned)__builtin_amdgcn_s_getreg((3 << 11) | 20) & 0xFu; }
#define XB_SPIN(cond, bar) do { unsigned _sp = 0; while (cond) { __builtin_amdgcn_s_sleep(1); \
    if ((++_sp & 255u) == 0u) { if (xb_ld(&(bar)[XB_TMO])) break; if (_sp > XB_SPIN_CAP) { atomicAdd(&(bar)[XB_TMO], 1u); break; } } } } while (0)

struct XcdBarrier {
    unsigned* bar; unsigned x;
    volatile LAS unsigned* st;
};

__device__ __forceinline__ XcdBarrier xcd_barrier_post(unsigned* bar, volatile LAS unsigned* st, bool leader) {
    XcdBarrier b; b.bar = bar; b.x = xb_xcc_id(); b.st = st;
    if (leader) (void)xb_add(&bar[XB_XCNT(b.x)], 1u);
    return b;
}
__device__ __forceinline__ void xcd_barrier_complete(unsigned* bar, unsigned x, unsigned& nloc, unsigned& nx) {
    const unsigned G = gridDim.x * gridDim.y * gridDim.z;
    unsigned sum, cnt, mine, sp = 0u;
    for (;;) {
        sum = 0u; cnt = 0u; mine = 0u;
#pragma unroll
        for (unsigned j = 0; j < 16; ++j) { const unsigned c = xb_ld(&bar[XB_XCNT(j)]); sum += c; cnt += (c > 0u) ? 1u : 0u; mine = (j == x) ? c : mine; }
        if (sum == G) break;
        __builtin_amdgcn_s_sleep(1);
        if ((++sp & 255u) == 0u) { if (xb_ld(&bar[XB_TMO])) break; if (sp > XB_SPIN_CAP) { atomicAdd(&bar[XB_TMO], 1u); break; } }
    }
    nloc = mine > 0u ? mine : 1u; nx = cnt > 0u ? cnt : 1u;
}

__device__ __forceinline__ void xcd_barrier(const XcdBarrier& b, bool leader) {
    asm volatile("s_waitcnt vmcnt(0)" ::: "memory");
    __syncthreads();
    if (leader) {
        unsigned* bar = b.bar;
        __builtin_amdgcn_s_waitcnt(0);
        unsigned nloc = b.st[0], nx = b.st[1];
        if (nloc == 0u) { xcd_barrier_complete(bar, b.x, nloc, nx); b.st[0] = nloc; b.st[1] = nx; }
        const unsigned old = xb_add(&bar[XB_XSUB(b.x)], 1u);
        const unsigned gen = old / nloc;
        if (old + 1u == (gen + 1u) * nloc) {
            __builtin_amdgcn_fence(__ATOMIC_RELEASE, "agent");
            asm volatile("s_waitcnt vmcnt(0)" ::: "memory");
            const unsigned og = xb_add(&bar[XB_TOP], 1u);
            const unsigned tg = og / nx;
            if (og + 1u == (tg + 1u) * nx) xb_add(&bar[XB_TOPGEN], 1u);
            else XB_SPIN(xb_ld(&bar[XB_TOPGEN]) == tg, bar);
            __builtin_amdgcn_fence(__ATOMIC_ACQUIRE, "agent");
            xb_add(&bar[XB_XGEN(b.x)], 1u);
            asm volatile("s_waitcnt vmcnt(0)" ::: "memory");
        } else {
            XB_SPIN(xb_ld(&bar[XB_XGEN(b.x)]) == gen, bar);
            __builtin_amdgcn_fence(__ATOMIC_ACQUIRE, "agent");
            asm volatile("s_waitcnt vmcnt(0)" ::: "memory");
        }
    }
    __syncthreads();
}

template <class RowMap> __device__ __forceinline__ void tr_tile(const float* W, int N, int k0, int n0, bf16* WT, int K, const float* kscale, LAS unsigned char* tile, int lane, RowMap rowmap) {
    const int ksub = lane >> 4, n4 = (lane & 15) * 4;
    const float* src = W + (size_t)(k0 + ksub) * N + n0 + n4;
    f32x4 v[16];
#pragma unroll
    for (int i = 0; i < 16; ++i) v[i] = *(const f32x4*)(src + (size_t)(4 * i) * N);
    if (kscale) {
#pragma unroll
        for (int i = 0; i < 16; ++i) v[i] = v[i] * kscale[k0 + 4 * i + ksub];
    }
    LAS unsigned short* t = (LAS unsigned short*)tile;
#pragma unroll
    for (int i = 0; i < 16; ++i) { const unsigned p0 = pk2(v[i][0], v[i][1]), p1 = pk2(v[i][2], v[i][3]); const int k = 4 * i + ksub;
        t[(n4 + 0) * 72 + k] = (unsigned short)(p0 & 0xffffu); t[(n4 + 1) * 72 + k] = (unsigned short)(p0 >> 16);
        t[(n4 + 2) * 72 + k] = (unsigned short)(p1 & 0xffffu); t[(n4 + 3) * 72 + k] = (unsigned short)(p1 >> 16); }
    LDS_WAIT(); asm volatile("" ::: "memory");
    const int ch = lane & 7;
#pragma unroll
    for (int j = 0; j < 8; ++j) { const int n = (lane >> 3) + 8 * j;
        const u32x4 o = *(const LAS u32x4*)(tile + n * 144 + ch * 16);
        *(u32x4*)(WT + (size_t)rowmap(n0 + n) * K + k0 + 8 * ch) = o; }
    LDS_WAIT(); asm volatile("" ::: "memory");
}
template <class RowMap> __device__ __forceinline__ void tr_tile8(const float* W, int N, int k0, int n0, unsigned char* WT, int K, const float* kscale, float wscale, LAS unsigned char* tile, int lane, RowMap rowmap) {
    const int ksub = lane >> 4, n4 = (lane & 15) * 4;
#pragma unroll 1
    for (int half = 0; half < 2; ++half) {
        const float* src = W + (size_t)(k0 + 64 * half + ksub) * N + n0 + n4;
        f32x4 v[16];
#pragma unroll
        for (int i = 0; i < 16; ++i) v[i] = *(const f32x4*)(src + (size_t)(4 * i) * N);
#pragma unroll
        for (int i = 0; i < 16; ++i) v[i] = v[i] * (kscale ? kscale[k0 + 64 * half + 4 * i + ksub] * wscale : wscale);
#pragma unroll
        for (int i = 0; i < 16; ++i) { const unsigned p = pg8::cvt_pk4_fp8(v[i][0], v[i][1], v[i][2], v[i][3]); const int k = 64 * half + 4 * i + ksub;
            tile[(n4 + 0) * 144 + k] = (unsigned char)(p & 0xffu); tile[(n4 + 1) * 144 + k] = (unsigned char)((p >> 8) & 0xffu);
            tile[(n4 + 2) * 144 + k] = (unsigned char)((p >> 16) & 0xffu); tile[(n4 + 3) * 144 + k] = (unsigned char)(p >> 24); }
    }
    LDS_WAIT(); asm volatile("" ::: "memory");
    const int ch = lane & 7;
#pragma unroll
    for (int j = 0; j < 8; ++j) { const int n = (lane >> 3) + 8 * j;
        const u32x4 o = *(const LAS u32x4*)(tile + n * 144 + ch * 16);
        *(u32x4*)(WT + (size_t)rowmap(n0 + n) * K + k0 + 16 * ch) = o; }
    LDS_WAIT(); asm volatile("" ::: "memory");
}
struct RowId { __device__ __forceinline__ int operator()(int n) const { return n; } };
struct RowOff { int off; __device__ __forceinline__ int operator()(int n) const { return off + n; } };
struct RowGateUp { int e, which; __device__ __forceinline__ int operator()(int n) const { return e * 2048 + 256 * (n >> 7) + 128 * which + (n & 127); } };
__device__ __forceinline__ void rms_row_to_bf16(const float* xrow, const float* g, bf16* orow, int lane) {
    const f32x4* xr = (const f32x4*)xrow + lane; const f32x4* gr = (const f32x4*)g + lane;
    f32x4 v[4]; float s = 0.f;
#pragma unroll
    for (int j = 0; j < 4; ++j) { v[j] = xr[64 * j]; s += (v[j][0] * v[j][0] + v[j][1] * v[j][1]) + (v[j][2] * v[j][2] + v[j][3] * v[j][3]); }
    const float r = 1.0f / sqrtf(wave_sum(s) * (1.0f / 1024.0f) + EPS);
    u32x2* o8 = (u32x2*)orow + lane;
#pragma unroll
    for (int j = 0; j < 4; ++j) { const f32x4 gg = gr[64 * j]; u32x2 w; w.x = pk2(v[j][0] * r * gg[0], v[j][1] * r * gg[1]); w.y = pk2(v[j][2] * r * gg[2], v[j][3] * r * gg[3]); o8[64 * j] = w; }
}
__device__ __forceinline__ void x_row2_to_bf16(const float* xrow, bf16* orow, float* rinv, int lane) {
    const f32x4* xr = (const f32x4*)xrow + lane;
    f32x4 v[8]; float s0 = 0.f, s1 = 0.f;
#pragma unroll
    for (int j = 0; j < 8; ++j) v[j] = xr[64 * j];
    u32x2* o8 = (u32x2*)orow + lane;
#pragma unroll
    for (int j = 0; j < 8; ++j) { u32x2 w; w.x = pk2(v[j][0], v[j][1]); w.y = pk2(v[j][2], v[j][3]); o8[64 * j] = w; }
#pragma unroll
    for (int j = 0; j < 4; ++j) { s0 += (v[j][0] * v[j][0] + v[j][1] * v[j][1]) + (v[j][2] * v[j][2] + v[j][3] * v[j][3]);
                                  s1 += (v[j + 4][0] * v[j + 4][0] + v[j + 4][1] * v[j + 4][1]) + (v[j + 4][2] * v[j + 4][2] + v[j + 4][3] * v[j + 4][3]); }
#pragma unroll
    for (int o = 1; o < 64; o <<= 1) { s0 += __shfl_xor(s0, o); s1 += __shfl_xor(s1, o); }
    if (lane == 0) { rinv[0] = 1.0f / sqrtf(s0 * (1.0f / 1024.0f) + EPS); rinv[1] = 1.0f / sqrtf(s1 * (1.0f / 1024.0f) + EPS); }
}
__device__ __forceinline__ void prep_weights(Frame& F) {
    const float* w_in = inp(I_W_IN); const float* norm_ffn_g = inp(I_NORM_FFN_G);
    const int gw = F.bid * 8 + F.wave, NGW = F.G * 8, lane = F.lane;
    LAS unsigned char* tile = F.lds + F.wave * 9216;
    constexpr int I_IN = 16 * 44, I_OUT = 16 * 16, I_MQ = 16 * 8, I_KV = 16 * 16, I_MO = 8 * 16, I_EX = 16 * 16 * 16;
    constexpr int I_EX8 = I_EX / 2;
    constexpr int NITEMS = I_IN + I_OUT + I_MQ + I_KV + I_MO + 3 * I_EX8;
    for (int it = gw; it < NITEMS; it += NGW) {
        int r = it;
        if (r < I_IN) { const int kb = r / 44, nb = r % 44; tr_tile(w_in, INW, 64 * kb, 64 * nb, wsp<bf16>(F, WS_WIN), 1024, inp(I_NORM_MIX_G), tile, lane, RowId{}); continue; } r -= I_IN;
        if (r < I_OUT) { const int kb = r / 16, nb = r % 16; tr_tile(inp(I_W_OUT), 1024, 64 * kb, 64 * nb, wsp<bf16>(F, WS_WOUT), 1024, nullptr, tile, lane, RowId{}); continue; } r -= I_OUT;
        if (r < I_MQ) { const int kb = r / 8, nb = r % 8; tr_tile(inp(I_W_MEM_Q), 512, 64 * kb, 64 * nb, wsp<bf16>(F, WS_WMQ), 1024, inp(I_NORM_MEM_G), tile, lane, RowId{}); continue; } r -= I_MQ;
        if (r < I_KV) { const int kb = r / 16, nb = r % 16; tr_tile(inp(I_W_MEM_KV), 1024, 64 * kb, 64 * nb, wsp<bf16>(F, WS_WKV), 1024, nullptr, tile, lane, RowId{}); continue; } r -= I_KV;
        if (r < I_MO) { const int kb = r / 16, nb = r % 16; tr_tile(inp(I_W_MEM_O), 1024, 64 * kb, 64 * nb, wsp<bf16>(F, WS_WMO), 512, nullptr, tile, lane, RowId{}); continue; } r -= I_MO;
        if (r < 2 * I_EX8) {
            const int which = r / I_EX8; const int q = r % I_EX8; const int e = q / 128, kb = (q % 128) / 16, nb = q % 16;
            const float* W = (which ? inp(I_W_UP) : inp(I_W_GATE)) + (size_t)e * 1024 * 1024;
            tr_tile8(W, 1024, 128 * kb, 64 * nb, wsp<unsigned char>(F, WS_WGU), 1024, norm_ffn_g, (float)(1 << F8_WSHIFT), tile, lane, RowGateUp{e, which}); continue; }
        r -= 2 * I_EX8;
        { const int e = r / 128, kb = (r % 128) / 16, nb = r % 16;
          tr_tile8(inp(I_W_DOWN) + (size_t)e * 1024 * 1024, 1024, 128 * kb, 64 * nb, wsp<unsigned char>(F, WS_WD), 1024, nullptr, (float)(1 << F8_WSHIFT), tile, lane, RowOff{e * 1024}); }
    }
}
__device__ __forceinline__ void prep_small(Frame& F) {
    const float* w_in = inp(I_W_IN); const float* norm_ffn_g = inp(I_NORM_FFN_G); const float* norm_mix_g = inp(I_NORM_MIX_G);
    {
        const int gt = F.bid * 512 + F.tid, NGT = F.G * 512; const float* w_router = inp(I_W_ROUTER);
        for (int it = gt; it < 2 * 16 * 128; it += NGT) {
            const int which = it >> 11, q = it & 2047, n = q >> 7, c = q & 127;
            float v[8];
#pragma unroll
            for (int j = 0; j < 8; ++j) { const int k = 8 * c + j; v[j] = which ? w_router[(size_t)k * 16 + n] * norm_ffn_g[k] : w_in[(size_t)k * INW + INW_G + n] * norm_mix_g[k]; }
            u32x4 hi; hi.x = pk2(v[0], v[1]); hi.y = pk2(v[2], v[3]); hi.z = pk2(v[4], v[5]); hi.w = pk2(v[6], v[7]);
            if (!which) *(u32x4*)(wsp<bf16>(F, WS_WG16) + n * 1024 + 8 * c) = hi;
            else {
                *(u32x4*)(wsp<bf16>(F, WS_WRHI) + n * 1024 + 8 * c) = hi;
                float l[8]; const unsigned hw[4] = {hi.x, hi.y, hi.z, hi.w};
#pragma unroll
                for (int j = 0; j < 8; ++j) l[j] = v[j] - ((j & 1) ? bfhi(hw[j >> 1]) : bflo(hw[j >> 1]));
                u32x4 lo; lo.x = pk2(l[0], l[1]); lo.y = pk2(l[2], l[3]); lo.z = pk2(l[4], l[5]); lo.w = pk2(l[6], l[7]);
                *(u32x4*)(wsp<bf16>(F, WS_WRLO) + n * 1024 + 8 * c) = lo;
            }
        }
    }
}
__device__ __forceinline__ void prep_rows(Frame& F) {
    const int gw = F.bid * 8 + F.wave, NGW = F.G * 8, lane = F.lane;
    { const float* x = inp(I_X); bf16* XB = wsp<bf16>(F, WS_XB); float* RX = wsp<float>(F, WS_RINVX);
    for (int m = 2 * gw; m < T; m += 2 * NGW) x_row2_to_bf16(x + (size_t)m * 1024, XB + (size_t)m * 1024, RX + m, lane); }
    { const float* mem = inp(I_MEM); const float* g = inp(I_MEM_KV_G);
    for (int m = gw; m < BATCH * MEMT; m += NGW) rms_row_to_bf16(mem + (size_t)m * 1024, g, wsp<bf16>(F, WS_MEMN) + (size_t)m * 1024, lane); }
}

constexpr int W16_STRIDE = 2064;
__device__ __forceinline__ void stage_w16(LAS unsigned char* dst, const bf16* W, int tid) {
#pragma unroll
    for (int i = 0; i < 4; ++i) { const int idx = tid + 512 * i, n = idx >> 7, c = idx & 127; *(LAS u32x4*)(dst + n * W16_STRIDE + c * 16) = *(const u32x4*)(W + n * 1024 + c * 8); }
}
__device__ __forceinline__ void phase_gates(Frame& F, int first_block) {
    const int gw = (F.bid - first_block) * 8 + F.wave, NGW = (F.G - first_block) * 8, lane = F.lane, r16 = lane & 15, kg = lane >> 4;
    if (F.bid < first_block) return;
    stage_w16(F.lds, wsp<bf16>(F, WS_WG16), F.tid);
    __syncthreads();
    const bf16* XN = wsp<bf16>(F, WS_XB); const float* RX = wsp<float>(F, WS_RINVX); float* GA = wsp<float>(F, WS_GATES);
    const LAS unsigned char* wl = F.lds + r16 * W16_STRIDE + kg * 16;
    const float gb = inp(I_GATE_B)[r16];
#pragma unroll 1
    for (int task = gw; task < T / 16; task += NGW) {
        const bf16* a = XN + (size_t)(task * 16 + r16) * 1024 + 8 * kg;
        bf16x8 xa[16], xb[16]; float rx[4];
#pragma unroll
        for (int s = 0; s < 16; ++s) xa[s] = *(const bf16x8*)(a + 32 * s);
#pragma unroll
        for (int s = 0; s < 16; ++s) xb[s] = *(const bf16x8*)(a + 32 * (s + 16));
#pragma unroll
        for (int r = 0; r < 4; ++r) rx[r] = RX[task * 16 + 4 * kg + r];
        __builtin_amdgcn_sched_barrier(0);
        f32x4 acc0 = {0.f, 0.f, 0.f, 0.f}, acc1 = {0.f, 0.f, 0.f, 0.f};
#pragma unroll
        for (int s = 0; s < 16; s += 2) { acc0 = mfma16(xa[s], *(const LAS bf16x8*)(wl + 64 * s), acc0); acc1 = mfma16(xa[s + 1], *(const LAS bf16x8*)(wl + 64 * (s + 1)), acc1); }
#pragma unroll
        for (int s = 0; s < 16; s += 2) { acc0 = mfma16(xb[s], *(const LAS bf16x8*)(wl + 64 * (s + 16)), acc0); acc1 = mfma16(xb[s + 1], *(const LAS bf16x8*)(wl + 64 * (s + 17)), acc1); }
        const f32x4 acc = acc0 + acc1;
#pragma unroll
        for (int r = 0; r < 4; ++r) GA[(size_t)(task * 16 + 4 * kg + r) * 16 + r16] = acc[r] * rx[r] + gb;
    }
    __syncthreads();
}
__device__ __forceinline__ void phase_router(Frame& F) {
    const int gw = F.bid * 8 + F.wave, NGW = F.G * 8, lane = F.lane, r16 = lane & 15, kg = lane >> 4;
    stage_w16(F.lds, wsp<bf16>(F, WS_WRHI), F.tid); stage_w16(F.lds + 16 * W16_STRIDE, wsp<bf16>(F, WS_WRLO), F.tid);
    __syncthreads();
    const LAS unsigned char* wh = F.lds + r16 * W16_STRIDE + kg * 16; const LAS unsigned char* wlo = wh + 16 * W16_STRIDE;
    float* AFF = wsp<float>(F, WS_AFF); float* RINV2 = wsp<float>(F, WS_RINV2); const bf16* X2B = wsp<bf16>(F, WS_X2B);
    const float br = inp(I_B_ROUTER)[r16];
#pragma unroll 1
    for (int task = gw; task < T / 16; task += NGW) {
        const bf16* a = X2B + (size_t)(task * 16 + r16) * 1024 + 8 * kg;
        u32x4 xa[16], xb[16];
#pragma unroll
        for (int s = 0; s < 16; ++s) xa[s] = *(const u32x4*)(a + 32 * s);
#pragma unroll
        for (int s = 0; s < 16; ++s) xb[s] = *(const u32x4*)(a + 32 * (s + 16));
        __builtin_amdgcn_sched_barrier(0);
        f32x4 acc = {0.f, 0.f, 0.f, 0.f}, acl = {0.f, 0.f, 0.f, 0.f}; float ss = 0.f;
#define RT_STEP(xw, s_) do { \
            const float x0 = bflo(xw.x), x1 = bfhi(xw.x), x2 = bflo(xw.y), x3 = bfhi(xw.y), x4 = bflo(xw.z), x5 = bfhi(xw.z), x6 = bflo(xw.w), x7 = bfhi(xw.w); \
            ss += (x0 * x0 + x1 * x1) + (x2 * x2 + x3 * x3) + (x4 * x4 + x5 * x5) + (x6 * x6 + x7 * x7); \
            const bf16x8 av = __builtin_bit_cast(bf16x8, xw); \
            acc = mfma16(av, *(const LAS bf16x8*)(wh + 64 * (s_)), acc); acl = mfma16(av, *(const LAS bf16x8*)(wlo + 64 * (s_)), acl); } while (0)
#pragma unroll
        for (int s = 0; s < 16; ++s) RT_STEP(xa[s], s);
#pragma unroll
        for (int s = 0; s < 16; ++s) RT_STEP(xb[s], s + 16);
#undef RT_STEP
        acc = acc + acl;
        ss += __shfl_xor(ss, 16); ss += __shfl_xor(ss, 32);
        const float rinv = 1.0f / sqrtf(ss * (1.0f / 1024.0f) + EPS);
        if (kg == 0) RINV2[task * 16 + r16] = rinv;
        f32x4 p;
#pragma unroll
        for (int r = 0; r < 4; ++r) {
            const float rr = __shfl(rinv, 4 * kg + r);
            const float lg = acc[r] * rr + br;
            float mx = lg;
#pragma unroll
            for (int o = 1; o < 16; o <<= 1) mx = fmaxf(mx, __shfl_xor(mx, o));
            const float ex = __expf(lg - mx); float sm = ex;
#pragma unroll
            for (int o = 1; o < 16; o <<= 1) sm += __shfl_xor(sm, o);
            p[r] = ex / sm;
        }
        const int t0 = task * 16 + 4 * kg, b = t0 >> 13, s0 = t0 & 8191;
        *(f32x4*)(AFF + ((size_t)(b * 16 + r16) << 13) + s0) = p;
    }
    __syncthreads();
}
template <int D> __device__ __forceinline__ f32x16 st_tile(const LAS unsigned char* kp, const bf16x8* qf) {
    f32x16 acc;
#pragma unroll
    for (int i = 0; i < 16; ++i) acc[i] = 0.f;
#pragma unroll
    for (int ks = 0; ks < D / 16; ++ks) acc = mfma32(*(const LAS bf16x8*)(kp + ks * 32), qf[ks], acc);
    return acc;
}
__device__ __forceinline__ bf16x8 pack8(const f32x16& p, int s) {
    u32x4 w; w.x = pk2(p[8 * s + 0], p[8 * s + 1]); w.y = pk2(p[8 * s + 2], p[8 * s + 3]); w.z = pk2(p[8 * s + 4], p[8 * s + 5]); w.w = pk2(p[8 * s + 6], p[8 * s + 7]);
    return __builtin_bit_cast(bf16x8, w);
}
__device__ __forceinline__ bf16x8 vt_frag(const LAS unsigned char* vp) {
    const u32x2 a = *(const LAS u32x2*)vp, b = *(const LAS u32x2*)(vp + 16);
    const u32x4 w = {a.x, a.y, b.x, b.y};
    return __builtin_bit_cast(bf16x8, w);
}

typedef short v4i16 __attribute__((ext_vector_type(4)));
__device__ __forceinline__ bf16x8 tr_pair(const LAS unsigned char* p, int second) {
    const v4i16 a = __builtin_amdgcn_ds_read_tr16_b64_v4i16((LAS v4i16*)p), b = __builtin_amdgcn_ds_read_tr16_b64_v4i16((LAS v4i16*)(p + second));
    return (bf16x8){a[0], a[1], a[2], a[3], b[0], b[1], b[2], b[3]};
}
__device__ __forceinline__ int vfrag_base(int lane, int rs) { const int i = lane & 15, g = lane >> 4; return (4 * (g >> 1) + (i >> 2)) * rs + (16 * (g & 1) + 4 * (i & 3)) * 2; }

constexpr int OST_BYTES = 32 * 72;
__device__ __forceinline__ void stage_store_32x32(LAS unsigned char* stg, const u32x2 (&w)[4], bf16* gbase, int ld, int lane) {
    const int r = lane & 31, h = lane >> 5;
#pragma unroll
    for (int rg = 0; rg < 4; ++rg) *(LAS u32x2*)(stg + r * 72 + (8 * rg + 4 * h) * 2) = w[rg];
    LDS_WAIT();
#pragma unroll
    for (int ps = 0; ps < 2; ++ps) { const int row = (lane >> 2) + 16 * ps, ch = lane & 3;
        const u32x2 a = *(const LAS u32x2*)(stg + row * 72 + ch * 16), b = *(const LAS u32x2*)(stg + row * 72 + ch * 16 + 8);
        const u32x4 v = {a.x, a.y, b.x, b.y};
        *(u32x4*)(gbase + (size_t)row * ld + ch * 8) = v; }
    LDS_WAIT();
}

constexpr int WA_KS = 144, WA_VS = 192;
constexpr int WA_K_OFF = 0, WA_V_OFF = 384 * WA_KS;
__host__ __device__ constexpr int wa_kind(int rel) { return rel == 0 ? 0 : rel < 4 ? 1 : rel == 4 ? 2 : rel < 8 ? 3 : 4; }
template <int KIND> __device__ __forceinline__ void wa_softmax(f32x16& s, float rq, float nslope2, int dist0, float kill, float& m, float& l, f32x16 (&o)[2]) {
    const float b0 = nslope2 * (float)dist0 + kill, nb0 = -(nslope2 * (float)dist0) + kill;
    float tmax = -INFINITY;
#pragma unroll
    for (int reg = 0; reg < 16; ++reg) {
        const int off = (reg & 3) + 8 * (reg >> 2);
        float v;
        if (KIND == 0 || KIND == 1) v = __builtin_fmaf(s[reg], rq, __builtin_fmaf(nslope2, -(float)off, b0));
        else if (KIND == 3 || KIND == 4) v = __builtin_fmaf(s[reg], rq, __builtin_fmaf(nslope2, (float)off, nb0));
        else { const int dist = dist0 - off; v = __builtin_fmaf(s[reg], rq, nslope2 * (float)(dist < 0 ? -dist : dist)) + kill; }
        if (KIND == 0) v = (dist0 - off <= 128) ? v : -INFINITY;
        if (KIND == 4) v = (dist0 - off >= -128) ? v : -INFINITY;
        s[reg] = v; tmax = fmaxf(tmax, v);
    }
    tmax = fmaxf(tmax, __shfl_xor(tmax, 32));
    if (__any(tmax > m + 8.0f)) {
        const float mn = fmaxf(m, tmax), f = __builtin_amdgcn_exp2f(m - mn);
        o[0] = o[0] * f; o[1] = o[1] * f; l *= f; m = mn;
    }
#pragma unroll
    for (int reg = 0; reg < 16; ++reg) { const float p = __builtin_amdgcn_exp2f(s[reg] - m); l += p; s[reg] = p; }
}
template <int KA, int KB> __device__ __forceinline__ void wa_step(const LAS unsigned char* kp, const LAS unsigned char* vtile, const bf16x8 (&qfA)[4], const bf16x8 (&qfB)[4], float rqA, float rqB,
                                                                  float nslope2, int dist0A, float killA, float killB,
                                                                  float& mA, float& lA, f32x16 (&oA)[2], float& mB, float& lB, f32x16 (&oB)[2]) {
    bf16x8 kf[4];
#pragma unroll
    for (int ks = 0; ks < 4; ++ks) kf[ks] = *(const LAS bf16x8*)(kp + ks * 32);
    f32x16 sA, sB;
#pragma unroll
    for (int i = 0; i < 16; ++i) { sA[i] = 0.f; sB[i] = 0.f; }
#pragma unroll
    for (int ks = 0; ks < 4; ++ks) { if (KA >= 0) sA = mfma32(kf[ks], qfA[ks], sA); if (KB >= 0) sB = mfma32(kf[ks], qfB[ks], sB); }
    if (KA >= 0) wa_softmax<(KA >= 0 ? KA : 1)>(sA, rqA, nslope2, dist0A, killA, mA, lA, oA);
    if (KB >= 0) wa_softmax<(KB >= 0 ? KB : 1)>(sB, rqB, nslope2, dist0A + 32, killB, mB, lB, oB);
#pragma unroll
    for (int s2 = 0; s2 < 2; ++s2) {
        bf16x8 vf[2];
#pragma unroll
        for (int dt = 0; dt < 2; ++dt) vf[dt] = tr_pair(vtile + 16 * s2 * WA_VS + dt * 64, 8 * WA_VS);
        if (KA >= 0) { const bf16x8 pb = pack8(sA, s2);
#pragma unroll
            for (int dt = 0; dt < 2; ++dt) oA[dt] = mfma32(vf[dt], pb, oA[dt]); }
        if (KB >= 0) { const bf16x8 pb = pack8(sB, s2);
#pragma unroll
            for (int dt = 0; dt < 2; ++dt) oB[dt] = mfma32(vf[dt], pb, oB[dt]); }
    }
}
__device__ __forceinline__ void wattn_unit(Frame& F, int b, int qb, int kvh) {
    const int tid = F.tid, lane = F.lane, wave = F.wave, r = lane & 31, h = lane >> 5;
    LAS unsigned char* Ks = F.lds + WA_K_OFF; LAS unsigned char* VS = F.lds + WA_V_OFF;
    const bf16* AK = wsp<bf16>(F, WS_AK); const bf16* AV = wsp<bf16>(F, WS_AV); const bf16* AQ = wsp<bf16>(F, WS_AQ);
    const float* SSK = wsp<float>(F, WS_SSQAK); const float* SSQ = wsp<float>(F, WS_SSQAQ); bf16* MIX = wsp<bf16>(F, WS_MIX);
    const int kpos0 = qb * 128 - 128; const float* sinkp = inp(I_ATT_SINK);
    __syncthreads();
    {
        const int ch = tid & 7; float gs[8]; const float* akg = inp(I_ATT_K_G); const float* aqg = inp(I_ATT_Q_G);
#pragma unroll
        for (int j = 0; j < 8; ++j) gs[j] = akg[ch * 8 + j] * aqg[ch * 8 + j] * (0.125f * LOG2E);
        u32x4 kraw[6], vraw[6]; float s0[6], s1[6];
#pragma unroll
        for (int i = 0; i < 6; ++i) {
            const int key = (tid >> 3) + 64 * i, kp = kpos0 + key, kpc = kp < 0 ? 0 : (kp >= SEQ ? SEQ - 1 : kp); const size_t tok = (size_t)b * SEQ + kpc;
            kraw[i] = *(const u32x4*)(AK + tok * 128 + kvh * 64 + ch * 8); vraw[i] = *(const u32x4*)(AV + tok * 128 + kvh * 64 + ch * 8);
            s0[i] = SSK[(size_t)(2 * kvh) * T + tok]; s1[i] = SSK[(size_t)(2 * kvh + 1) * T + tok];
        }
#pragma unroll
        for (int i = 0; i < 6; ++i) {
            const int key = (tid >> 3) + 64 * i, kp = kpos0 + key; const bool ok = kp >= 0 && kp < SEQ;
            const float rk = ok ? 1.0f / sqrtf((s0[i] + s1[i]) * (1.0f / 64.0f) + EPS) : 0.f;
            const u32x4 raw = kraw[i]; u32x4 w;
            w.x = pk2(bflo(raw.x) * rk * gs[0], bfhi(raw.x) * rk * gs[1]); w.y = pk2(bflo(raw.y) * rk * gs[2], bfhi(raw.y) * rk * gs[3]);
            w.z = pk2(bflo(raw.z) * rk * gs[4], bfhi(raw.z) * rk * gs[5]); w.w = pk2(bflo(raw.w) * rk * gs[6], bfhi(raw.w) * rk * gs[7]);
            *(LAS u32x4*)(Ks + key * WA_KS + ch * 16) = w;
            u32x4 vv = vraw[i]; if (!ok) vv = (u32x4){0u, 0u, 0u, 0u};
            *(LAS u32x4*)(VS + key * WA_VS + ch * 16) = vv;
        }
    }
    __syncthreads();
    const int vb = vfrag_base(lane, WA_VS);
    {
        const int g = wave >> 1, jqA = 2 * (wave & 1), hq = kvh * 4 + g, qiA = 32 * jqA + r;
        const size_t tokA = (size_t)b * SEQ + qb * 128 + qiA, tokB = tokA + 32;
        bf16x8 qfA[4], qfB[4];
#pragma unroll
        for (int ks = 0; ks < 4; ++ks) { qfA[ks] = *(const bf16x8*)(AQ + tokA * 512 + hq * 64 + 16 * ks + 8 * h); qfB[ks] = *(const bf16x8*)(AQ + tokB * 512 + hq * 64 + 16 * ks + 8 * h); }
        const float rqA = 1.0f / sqrtf((SSQ[(size_t)(2 * hq) * T + tokA] + SSQ[(size_t)(2 * hq + 1) * T + tokA]) * (1.0f / 64.0f) + EPS);
        const float rqB = 1.0f / sqrtf((SSQ[(size_t)(2 * hq) * T + tokB] + SSQ[(size_t)(2 * hq + 1) * T + tokB]) * (1.0f / 64.0f) + EPS);
        const float nslope2 = -__builtin_amdgcn_exp2f(-(float)(hq + 1)) * LOG2E, sink2 = sinkp[hq] * LOG2E;
        float mA = sink2, lA = 0.f, mB = sink2, lB = 0.f;
        f32x16 oA[2], oB[2];
#pragma unroll
        for (int i = 0; i < 16; ++i) { oA[0][i] = 0.f; oA[1][i] = 0.f; oB[0][i] = 0.f; oB[1][i] = 0.f; }
        const int kv_lo = (qb == 0) ? 4 : 0, kv_hi = (qb == 63) ? 7 : 11;
        const LAS unsigned char* kp0 = Ks + r * WA_KS + h * 16;
#define WA_STEP(rel, KA_, KB_) do { const int kt = jqA + (rel); const float kill = (kt < kv_lo || kt > kv_hi) ? -INFINITY : 0.f; \
            wa_step<KA_, KB_>(kp0 + kt * 32 * WA_KS, VS + vb + kt * 32 * WA_VS, qfA, qfB, rqA, rqB, nslope2, qiA + 128 - 32 * kt - 4 * h, kill, kill, mA, lA, oA, mB, lB, oB); } while (0)
        WA_STEP(0, wa_kind(0), -1);
        WA_STEP(1, wa_kind(1), wa_kind(0)); WA_STEP(2, wa_kind(2), wa_kind(1)); WA_STEP(3, wa_kind(3), wa_kind(2)); WA_STEP(4, wa_kind(4), wa_kind(3));
        WA_STEP(5, wa_kind(5), wa_kind(4)); WA_STEP(6, wa_kind(6), wa_kind(5)); WA_STEP(7, wa_kind(7), wa_kind(6)); WA_STEP(8, wa_kind(8), wa_kind(7));
        WA_STEP(9, -1, wa_kind(8));
#undef WA_STEP
        lA += __shfl_xor(lA, 32); lA += __builtin_amdgcn_exp2f(sink2 - mA);
        lB += __shfl_xor(lB, 32); lB += __builtin_amdgcn_exp2f(sink2 - mB);
        const float invA = __builtin_amdgcn_rcpf(lA), invB = __builtin_amdgcn_rcpf(lB);
        bf16* obase = MIX + ((size_t)b * SEQ + qb * 128 + 32 * jqA) * 1024 + hq * 64;
        LAS unsigned char* stg = F.lds + WA_V_OFF + 384 * WA_VS + wave * OST_BYTES;
#pragma unroll
        for (int dt = 0; dt < 2; ++dt) { u32x2 w[4];
#pragma unroll
            for (int rg = 0; rg < 4; ++rg) { w[rg].x = pk2(oA[dt][4 * rg] * invA, oA[dt][4 * rg + 1] * invA); w[rg].y = pk2(oA[dt][4 * rg + 2] * invA, oA[dt][4 * rg + 3] * invA); }
            stage_store_32x32(stg, w, obase + dt * 32, 1024, lane);
#pragma unroll
            for (int rg = 0; rg < 4; ++rg) { w[rg].x = pk2(oB[dt][4 * rg] * invB, oB[dt][4 * rg + 1] * invB); w[rg].y = pk2(oB[dt][4 * rg + 2] * invB, oB[dt][4 * rg + 3] * invB); }
            stage_store_32x32(stg, w, obase + (size_t)32 * 1024 + dt * 32, 1024, lane); }
    }
}

constexpr int XA_KS = 272, XA_VS = 520;
constexpr int XA_K_OFF = 0, XA_V_OFF = 256 * XA_KS;
__device__ __forceinline__ void xattn_phase(Frame& F) {
    const int tid = F.tid, lane = F.lane, wave = F.wave, r = lane & 31, h = lane >> 5;
    LAS unsigned char* Ks = F.lds + XA_K_OFF; LAS unsigned char* VT = F.lds + XA_V_OFF;
    const bf16* KVM = wsp<bf16>(F, WS_KVM); const float* SSK = wsp<float>(F, WS_SSQMK); const bf16* QM = wsp<bf16>(F, WS_QM); const float* SSQ = wsp<float>(F, WS_SSQQ);
    bf16* OM = wsp<bf16>(F, WS_OM);
    const int nunits = BATCH * 4 * 32;
    const int per = (nunits + F.G - 1) / F.G;
    int cur_bh = -1;
#pragma unroll 1
    for (int ui = 0; ui < per; ++ui) {
        const int u = F.bid * per + ui; if (u >= nunits) break;
        const int bh = u >> 5, qblk = u & 31, b = bh >> 2, hd = bh & 3;
        if (bh != cur_bh) {
            cur_bh = bh;
            __syncthreads();
            const int ch = tid & 15; float gs[8]; const float* mkg = inp(I_MEM_K_G); const float* mqg = inp(I_MEM_Q_G);
#pragma unroll
            for (int j = 0; j < 8; ++j) gs[j] = mkg[ch * 8 + j] * mqg[ch * 8 + j] * (0.08838834764831845f * LOG2E);
#pragma unroll
            for (int i = 0; i < 8; ++i) {
                const int key = (tid >> 4) + 32 * i; const size_t row = (size_t)b * MEMT + key;
                const u32x4 raw = *(const u32x4*)(KVM + row * 1024 + hd * 128 + ch * 8);
                const float* sp = SSK + (size_t)(hd * 4) * (BATCH * MEMT) + row;
                const float rk = 1.0f / sqrtf(((sp[0] + sp[BATCH * MEMT]) + (sp[2 * BATCH * MEMT] + sp[3 * BATCH * MEMT])) * (1.0f / 128.0f) + EPS);
                u32x4 w;
                w.x = pk2(bflo(raw.x) * rk * gs[0], bfhi(raw.x) * rk * gs[1]); w.y = pk2(bflo(raw.y) * rk * gs[2], bfhi(raw.y) * rk * gs[3]);
                w.z = pk2(bflo(raw.z) * rk * gs[4], bfhi(raw.z) * rk * gs[5]); w.w = pk2(bflo(raw.w) * rk * gs[6], bfhi(raw.w) * rk * gs[7]);
                *(LAS u32x4*)(Ks + key * XA_KS + ch * 16) = w;
            }
#pragma unroll
            for (int i = 0; i < 8; ++i) {
                const int idx = tid + 512 * i, key = idx & 255, vc = idx >> 8;
                const u32x4 raw = *(const u32x4*)(KVM + ((size_t)b * MEMT + key) * 1024 + 512 + hd * 128 + vc * 8);
                LAS unsigned short* vt = (LAS unsigned short*)(VT + (vc * 8) * XA_VS + key * 2);
                const unsigned rw[4] = {raw.x, raw.y, raw.z, raw.w};
#pragma unroll
                for (int j = 0; j < 8; ++j) vt[j * (XA_VS / 2)] = (unsigned short)((j & 1) ? (rw[j >> 1] >> 16) : (rw[j >> 1] & 0xffffu));
            }
            __syncthreads();
        }
        const size_t tok = (size_t)b * SEQ + qblk * 256 + wave * 32 + r;
        bf16x8 qf[8];
#pragma unroll
        for (int ks = 0; ks < 8; ++ks) qf[ks] = *(const bf16x8*)(QM + tok * 512 + hd * 128 + 16 * ks + 8 * h);
        const float* sp = SSQ + (size_t)(hd * 4) * T + tok;
        const float rq = 1.0f / sqrtf(((sp[0] + sp[T]) + (sp[2 * (size_t)T] + sp[3 * (size_t)T])) * (1.0f / 128.0f) + EPS);
        const LAS unsigned char* kp0 = Ks + r * XA_KS + h * 16;
        float m = -INFINITY, l = 0.f;
        f32x16 o[4];
#pragma unroll
        for (int i = 0; i < 16; ++i) { o[0][i] = 0.f; o[1][i] = 0.f; o[2][i] = 0.f; o[3][i] = 0.f; }
#pragma unroll 1
        for (int kt = 0; kt < 8; ++kt) {
            bf16x8 vf[2][4];
#pragma unroll
            for (int s2 = 0; s2 < 2; ++s2)
#pragma unroll
                for (int dt = 0; dt < 4; ++dt) vf[s2][dt] = vt_frag(VT + (dt * 32 + r) * XA_VS + (kt * 32 + 16 * s2 + 4 * h) * 2);
            f32x16 s = st_tile<128>(kp0 + kt * 32 * XA_KS, qf);
            float tmax = -INFINITY;
#pragma unroll
            for (int reg = 0; reg < 16; ++reg) { s[reg] *= rq; tmax = fmaxf(tmax, s[reg]); }
            tmax = fmaxf(tmax, __shfl_xor(tmax, 32));
            if (__any(tmax > m + 8.0f)) {
                const float mn = fmaxf(m, tmax), f = __builtin_amdgcn_exp2f(m - mn);
                o[0] = o[0] * f; o[1] = o[1] * f; o[2] = o[2] * f; o[3] = o[3] * f; l *= f; m = mn;
            }
#pragma unroll
            for (int reg = 0; reg < 16; ++reg) { const float p = __builtin_amdgcn_exp2f(s[reg] - m); l += p; s[reg] = p; }
#pragma unroll
            for (int s2 = 0; s2 < 2; ++s2) {
                const bf16x8 pb = pack8(s, s2);
#pragma unroll
                for (int dt = 0; dt < 4; ++dt) o[dt] = mfma32(vf[s2][dt], pb, o[dt]);
            }
        }
        l += __shfl_xor(l, 32);
        const float inv = __builtin_amdgcn_rcpf(l);
        bf16* obase = OM + ((size_t)b * SEQ + qblk * 256 + wave * 32) * 512 + hd * 128;
        LAS unsigned char* stg = F.lds + XA_V_OFF + 128 * XA_VS + wave * OST_BYTES;
#pragma unroll
        for (int dt = 0; dt < 4; ++dt) { u32x2 w[4];
#pragma unroll
            for (int rg = 0; rg < 4; ++rg) { w[rg].x = pk2(o[dt][4 * rg] * inv, o[dt][4 * rg + 1] * inv); w[rg].y = pk2(o[dt][4 * rg + 2] * inv, o[dt][4 * rg + 3] * inv); }
            stage_store_32x32(stg, w, obase + dt * 32, 512, lane); }
    }
}
__device__ __forceinline__ float logsig2(float f) { return (fminf(f, 0.f) - log1pf(expf(-fabsf(f)))) * LOG2E; }
__device__ __forceinline__ float wave_incl_scan(float v, int lane) {
#pragma unroll
    for (int o = 1; o < 64; o <<= 1) { const float t = __shfl_up(v, o); if (lane >= o) v += t; }
    return v;
}
__device__ __forceinline__ float silu_f(float x) { return x * __builtin_amdgcn_rcpf(1.0f + __builtin_amdgcn_exp2f(-x * LOG2E)); }
__device__ __forceinline__ float sigmoid_f(float x) { return __builtin_amdgcn_rcpf(1.0f + __builtin_amdgcn_exp2f(-x * LOG2E)); }

__device__ __forceinline__ void phase_conv(Frame& F) {
    const bf16* MQ = wsp<bf16>(F, WS_MQ); const bf16* MK = wsp<bf16>(F, WS_MK); bf16* QC = wsp<bf16>(F, WS_QC); bf16* KC = wsp<bf16>(F, WS_KC);
    const float* conv_w = inp(I_CONV_W); const float* conv_b = inp(I_CONV_B);
    const int gt = F.bid * 512 + F.tid, NGT = F.G * 512;
#pragma unroll 1
    for (int it = gt; it < (T / 4) * 128; it += NGT) {
        const int cc = it & 127, rg = it >> 7, tok0 = rg * 4, pos0 = tok0 & (SEQ - 1), which = cc >> 6, col = (cc & 63) * 8, ch = which * 512 + col;
        const bf16* src = (which ? MK : MQ) + col;
        u32x4 rw[6];
#pragma unroll
        for (int d = 0; d < 6; ++d) { const int pp = pos0 + d - 1; const bool ok = pp >= 0 && pp < SEQ; rw[d] = *(const u32x4*)(src + (size_t)(ok ? tok0 + d - 1 : tok0) * 512); if (!ok) rw[d] = (u32x4){0u, 0u, 0u, 0u}; }
        const f32x4 w0a = *(const f32x4*)(conv_w + ch), w0b = *(const f32x4*)(conv_w + ch + 4), w1a = *(const f32x4*)(conv_w + 1024 + ch), w1b = *(const f32x4*)(conv_w + 1024 + ch + 4);
        const f32x4 w2a = *(const f32x4*)(conv_w + 2048 + ch), w2b = *(const f32x4*)(conv_w + 2048 + ch + 4), bba = *(const f32x4*)(conv_b + ch), bbb = *(const f32x4*)(conv_b + ch + 4);
        const float sc = which ? 0.08838834764831845f : 1.0f;
        float y[4][8];
#pragma unroll
        for (int j = 0; j < 8; ++j) {
            const float w0 = j < 4 ? w0a[j & 3] : w0b[j & 3], w1 = j < 4 ? w1a[j & 3] : w1b[j & 3], w2 = j < 4 ? w2a[j & 3] : w2b[j & 3], bb = j < 4 ? bba[j & 3] : bbb[j & 3];
            float xv[6];
#pragma unroll
            for (int d = 0; d < 6; ++d) { const unsigned wd = (j >> 1) == 0 ? rw[d].x : (j >> 1) == 1 ? rw[d].y : (j >> 1) == 2 ? rw[d].z : rw[d].w; xv[d] = (j & 1) ? bfhi(wd) : bflo(wd); }
#pragma unroll
            for (int rr = 0; rr < 4; ++rr) y[rr][j] = silu_f(bb + w0 * xv[rr] + w1 * xv[rr + 1] + w2 * xv[rr + 2]) * sc;
        }
        bf16* dst = (which ? KC : QC) + col;
#pragma unroll
        for (int rr = 0; rr < 4; ++rr) { u32x4 w; w.x = pk2(y[rr][0], y[rr][1]); w.y = pk2(y[rr][2], y[rr][3]); w.z = pk2(y[rr][4], y[rr][5]); w.w = pk2(y[rr][6], y[rr][7]);
            *(u32x4*)(dst + (size_t)(tok0 + rr) * 512) = w; }
    }
}
__device__ __forceinline__ void phase_gatescan(Frame& F) {
    const int gw = F.bid * 8 + F.wave, NGW = F.G * 8, lane = F.lane;
    const float* GA = wsp<float>(F, WS_GATES); float* WST = wsp<float>(F, WS_WST); float* FTA = wsp<float>(F, WS_FTA); float* ESA = wsp<float>(F, WS_ESA); float* DEC = wsp<float>(F, WS_DEC);
#pragma unroll 1
    for (int task = gw; task < BATCH * 64 * 4 * 2; task += NGW) {
        const int dir = task & 1, hd = (task >> 1) & 3, bc = task >> 3; const size_t tok0 = (size_t)bc * 128;
        const float* g = GA + (tok0 + 2 * lane) * 16 + dir * 8 + hd;
        const float i0 = g[0] * LOG2E, i1 = g[16] * LOG2E, l0 = logsig2(g[4]), l1 = logsig2(g[20]);
        const float incl = wave_incl_scan(l0 + l1, lane), tot = __shfl(incl, 63);
        float F0, F1;
        if (!dir) { F1 = incl; F0 = incl - l1; } else { F0 = tot - incl + l0 + l1; F1 = tot - incl + l1; }
        const size_t o = (size_t)(dir * 4 + hd) * T + tok0 + 2 * lane;
        *(f32x2*)(FTA + o) = (f32x2){F0, F1}; *(f32x2*)(ESA + o) = (f32x2){i0 - F0, i1 - F1};
        *(f32x2*)(WST + o) = (f32x2){__builtin_amdgcn_exp2f(tot - F0 + i0), __builtin_amdgcn_exp2f(tot - F1 + i1)};
        if (lane == 0) DEC[task] = __builtin_amdgcn_exp2f(tot);
    }
}

constexpr int MS_KW_STRIDE = 96, MS_VT_STRIDE = 288;
constexpr int MS_KW_BYTES = 128 * MS_KW_STRIDE, MS_VT_BYTES = 128 * MS_VT_STRIDE, MS_BUF = MS_KW_BYTES + MS_VT_BYTES;
__device__ __forceinline__ void mlstm_state_unit(Frame& F, int u) {
    const int tid = F.tid, lane = F.lane, wave = F.wave;
    const int ksl = u & 3, dir = (u >> 2) & 1, hd = (u >> 3) & 3, b = u >> 5;
    const bf16* KC = wsp<bf16>(F, WS_KC); const bf16* MV = wsp<bf16>(F, WS_MV); const float* WST = wsp<float>(F, WS_WST); const float* DEC = wsp<float>(F, WS_DEC);
    bf16* C0 = wsp<bf16>(F, WS_C0); float* N0 = wsp<float>(F, WS_N0);
    const int krow = tid >> 2, kch = tid & 3, kcol = hd * 128 + ksl * 32 + kch * 8;
    f32x4 acc[2], nacc[2];
#pragma unroll
    for (int i = 0; i < 2; ++i) { acc[i] = (f32x4){0.f, 0.f, 0.f, 0.f}; nacc[i] = (f32x4){0.f, 0.f, 0.f, 0.f}; }
    const bf16x8 ones = {0x3F80, 0x3F80, 0x3F80, 0x3F80, 0x3F80, 0x3F80, 0x3F80, 0x3F80};
    const int tg = lane >> 4, ti = lane & 15, tq = ti >> 2, tp = ti & 3;
    const int aoff = (8 * tg + tq) * MS_KW_STRIDE + (4 * tp) * 2, boff = (8 * tg + tq) * MS_VT_STRIDE + (16 * wave + 4 * tp) * 2;
    u32x4 krA, vrA[4], krB, vrB[4]; float wA, wB, dA, dB;
#define MS_LOAD(kr, vr, wv, dv, c) do { const size_t tok0_ = (size_t)b * SEQ + (c) * 128; \
        kr = *(const u32x4*)(KC + (tok0_ + krow) * 512 + kcol); wv = WST[(size_t)(dir * 4 + hd) * T + tok0_ + krow]; dv = DEC[((((size_t)b * 64 + (c)) * 4 + hd) * 2) + dir]; \
        _Pragma("unroll") for (int i_ = 0; i_ < 4; ++i_) { const int idx_ = tid + 512 * i_; vr[i_] = *(const u32x4*)(MV + (tok0_ + (idx_ >> 4)) * 512 + hd * 128 + (idx_ & 15) * 8); } } while (0)
#define MS_STEP(kr, vr, wv, dv, ci) do { \
        const int c = dir ? 63 - (ci) : (ci), buf = (ci) & 1; \
        LAS unsigned char* KW = F.lds + buf * MS_BUF; LAS unsigned char* VT = KW + MS_KW_BYTES; \
        const float dec = dv; \
        { u32x4 w_; w_.x = pk2(bflo(kr.x) * wv, bfhi(kr.x) * wv); w_.y = pk2(bflo(kr.y) * wv, bfhi(kr.y) * wv); w_.z = pk2(bflo(kr.z) * wv, bfhi(kr.z) * wv); w_.w = pk2(bflo(kr.w) * wv, bfhi(kr.w) * wv); \
          *(LAS u32x4*)(KW + krow * MS_KW_STRIDE + kch * 16) = w_; \
          _Pragma("unroll") for (int i = 0; i < 4; ++i) { const int idx = tid + 512 * i; *(LAS u32x4*)(VT + (idx >> 4) * MS_VT_STRIDE + (idx & 15) * 16) = vr[i]; } } \
        if ((ci) + 2 < 64) MS_LOAD(kr, vr, wv, dv, dir ? 61 - (ci) : (ci) + 2);     \
        __syncthreads(); \
        {   \
            const size_t unit4 = (((size_t)b * 64 + c) * 4 + hd) * 2 + dir; \
            bf16* cdst = C0 + unit4 * 16384 + ksl * 4096 + (16 * wave + (lane & 15)) * 32 + 4 * (lane >> 4); \
            _Pragma("unroll") for (int kt = 0; kt < 2; ++kt) { u32x2 w; w.x = pk2(acc[kt][0], acc[kt][1]); w.y = pk2(acc[kt][2], acc[kt][3]); *(u32x2*)(cdst + 16 * kt) = w; } \
            if (wave == 0 && (lane & 15) == 0) { \
                _Pragma("unroll") for (int kt = 0; kt < 2; ++kt) *(f32x4*)(N0 + unit4 * 128 + ksl * 32 + 16 * kt + 4 * (lane >> 4)) = nacc[kt]; } \
        } \
        _Pragma("unroll") for (int kt = 0; kt < 2; ++kt) { acc[kt] = acc[kt] * dec; nacc[kt] = nacc[kt] * dec; } \
        _Pragma("unroll") for (int ks = 0; ks < 4; ++ks) { \
            const bf16x8 bv = tr_pair(VT + boff + 32 * ks * MS_VT_STRIDE, 4 * MS_VT_STRIDE); \
            _Pragma("unroll") for (int kt = 0; kt < 2; ++kt) { \
                const bf16x8 av = tr_pair(KW + aoff + 32 * ks * MS_KW_STRIDE + 32 * kt, 4 * MS_KW_STRIDE); \
                acc[kt] = mfma16(av, bv, acc[kt]); nacc[kt] = mfma16(av, ones, nacc[kt]); } } \
    } while (0)
    MS_LOAD(krA, vrA, wA, dA, dir ? 63 : 0);
    MS_LOAD(krB, vrB, wB, dB, dir ? 62 : 1);
    __syncthreads();
#pragma unroll 1
    for (int ci = 0; ci < 64; ci += 2) {
        MS_STEP(krA, vrA, wA, dA, ci);
        MS_STEP(krB, vrB, wB, dB, ci + 1);
    }
#undef MS_STEP
#undef MS_LOAD
}

constexpr int MO_KS = 0, MO_VS = 34816, MO_C0 = 71680, MO_FT = 141312, MO_ES = 142336, MO_N0 = 143360, MO_XS = 144384, MO_OG = 145408;
__device__ __forceinline__ void mlstm_out_unit(Frame& F, int u) {
    const int tid = F.tid, lane = F.lane, wave = F.wave, r = lane & 31, hh = lane >> 5;
    const int hd = u & 3, c = (u >> 2) & 63, b = u >> 8;
    const size_t tok0 = (size_t)b * SEQ + c * 128;
    const bf16* MV = wsp<bf16>(F, WS_MV); const bf16* MOg = wsp<bf16>(F, WS_MO);
    const bf16* C0 = wsp<bf16>(F, WS_C0); const float* N0 = wsp<float>(F, WS_N0); bf16* MIX = wsp<bf16>(F, WS_MIX);
    LAS unsigned char* L = F.lds;
    LAS float* FT = (LAS float*)(L + MO_FT); LAS float* ES = (LAS float*)(L + MO_ES); LAS float* N0s = (LAS float*)(L + MO_N0); LAS float* XS = (LAS float*)(L + MO_XS); LAS float* OG = (LAS float*)(L + MO_OG);
    const size_t unit4 = (((size_t)b * 64 + c) * 4 + hd) * 2;
    const int tt = wave & 3, vh = wave >> 2, t = 32 * tt + r;
    bf16x8 qf[8];
    {
    __syncthreads();
    u32x4 kst[4], vst[4], cst[8];
    {
        const bf16* KC = wsp<bf16>(F, WS_KC);
#pragma unroll
        for (int i = 0; i < 4; ++i) { const int idx = tid + 512 * i, row = idx >> 4, ch = idx & 15;
            kst[i] = *(const u32x4*)(KC + (tok0 + row) * 512 + hd * 128 + ch * 8); vst[i] = *(const u32x4*)(MV + (tok0 + row) * 512 + hd * 128 + ch * 8); }
#pragma unroll
        for (int i = 0; i < 8; ++i) cst[i] = *(const u32x4*)(C0 + unit4 * 16384 + (size_t)(tid + 512 * i) * 8);
    }
    float ftv = 0.f, esv = 0.f, n0v = 0.f;
    if (tid < 256) { const int dir = tid >> 7, pos = tid & 127; const size_t o = (size_t)(dir * 4 + hd) * T + tok0 + pos;
        ftv = wsp<float>(F, WS_FTA)[o]; esv = wsp<float>(F, WS_ESA)[o]; n0v = N0[(unit4 + dir) * 128 + pos]; }
#pragma unroll
    for (int ks = 0; ks < 8; ++ks) qf[ks] = *(const bf16x8*)(wsp<bf16>(F, WS_QC) + (tok0 + t) * 512 + hd * 128 + 16 * ks + 8 * hh);
#pragma unroll
    for (int i = 0; i < 4; ++i) { const int idx = tid + 512 * i, row = idx >> 4, ch = idx & 15;
        *(LAS u32x4*)(L + MO_KS + row * 272 + ch * 16) = kst[i]; *(LAS u32x4*)(L + MO_VS + row * 288 + ch * 16) = vst[i]; }
#pragma unroll
    for (int i = 0; i < 8; ++i) { const int cidx = tid + 512 * i, dir = cidx >> 11, ksl = (cidx >> 9) & 3, v = (cidx >> 2) & 127, kq = cidx & 3;
        *(LAS u32x4*)(L + MO_C0 + dir * 34816 + v * 272 + (ksl * 32 + kq * 8) * 2) = cst[i]; }
    if (tid >= 384) OG[tid - 384] = inp(I_ML_OUT_G)[hd * 128 + tid - 384];
    if (tid < 256) { FT[tid] = ftv; ES[tid] = esv; ((LAS unsigned short*)N0s)[tid] = (unsigned short)pk2(n0v, 0.f); }
    __syncthreads();
    }
    const int vb = vfrag_base(lane, 288);
    f32x16 hs[2];
    {
#pragma unroll
    for (int i = 0; i < 16; ++i) { hs[0][i] = 0.f; hs[1][i] = 0.f; }
#pragma unroll 1
    for (int di = 0; di < 2; ++di) {
        const int dir = di ^ vh;
        const float Ft = FT[dir * 128 + t], at = __builtin_amdgcn_exp2f(Ft);
        float qn;
        { f32x16 qa;
#pragma unroll
          for (int i = 0; i < 16; ++i) qa[i] = 0.f;
#pragma unroll
          for (int ks = 0; ks < 8; ++ks) qa = mfma32(*(const LAS bf16x8*)((const LAS unsigned char*)N0s + dir * 256 + (16 * ks + 8 * hh) * 2), qf[ks], qa);
          qn = qa[0]; }
        f32x16 num[2];
        const LAS unsigned char* c0 = L + MO_C0 + dir * 34816 + (64 * vh + r) * 272 + 16 * hh;
#pragma unroll
        for (int vt = 0; vt < 2; ++vt) {
#pragma unroll
            for (int i = 0; i < 16; ++i) num[vt][i] = 0.f;
#pragma unroll
            for (int ks = 0; ks < 8; ++ks) num[vt] = mfma32(*(const LAS bf16x8*)(c0 + vt * 32 * 272 + 32 * ks), qf[ks], num[vt]);
            num[vt] = num[vt] * at;
        }
        float rowsum = 0.f;
        const int st_lo = dir ? tt : 0, st_hi = dir ? 3 : tt;
#pragma unroll 1
        for (int st = st_lo; st <= st_hi; ++st) {
            f32x16 pm = st_tile<128>(L + MO_KS + (32 * st + r) * 272 + hh * 16, qf);
            if (st == tt) {
#pragma unroll
                for (int rg = 0; rg < 4; ++rg) {
                    const int s0 = 32 * st + 8 * rg + 4 * hh;
                    const f32x4 es = *(const LAS f32x4*)(ES + dir * 128 + s0);
#pragma unroll
                    for (int e = 0; e < 4; ++e) {
                        const int s = s0 + e; const bool ok = dir ? (s >= t) : (s <= t);
                        const float pv = ok ? pm[4 * rg + e] * __builtin_amdgcn_exp2f(Ft + es[e]) : 0.f;
                        pm[4 * rg + e] = pv; rowsum += pv;
                    }
                }
            } else {
#pragma unroll
                for (int rg = 0; rg < 4; ++rg) {
                    const f32x4 es = *(const LAS f32x4*)(ES + dir * 128 + 32 * st + 8 * rg + 4 * hh);
#pragma unroll
                    for (int e = 0; e < 4; ++e) { const float pv = pm[4 * rg + e] * __builtin_amdgcn_exp2f(Ft + es[e]); pm[4 * rg + e] = pv; rowsum += pv; }
                }
            }
#pragma unroll
            for (int s2 = 0; s2 < 2; ++s2) {
                const bf16x8 pb = pack8(pm, s2);
#pragma unroll
                for (int vt = 0; vt < 2; ++vt) num[vt] = mfma32(tr_pair(L + MO_VS + vb + (32 * st + 16 * s2) * 288 + (64 * vh + 32 * vt) * 2, 8 * 288), pb, num[vt]);
            }
        }
        rowsum += __shfl_xor(rowsum, 32);
        const float den = at * qn + rowsum, dinv = 1.0f / fmaxf(fabsf(den), 1.0f);
        hs[0] = hs[0] + num[0] * dinv; hs[1] = hs[1] + num[1] * dinv;
    }
    }
    {
    const size_t tok = tok0 + t;
    u32x2 mw[8];
#pragma unroll
    for (int i = 0; i < 8; ++i) mw[i] = *(const u32x2*)(MOg + tok * 512 + hd * 128 + 64 * vh + 32 * (i >> 2) + 8 * (i & 3) + 4 * hh);
    float ss = 0.f;
#pragma unroll
    for (int i = 0; i < 16; ++i) ss += hs[0][i] * hs[0][i] + hs[1][i] * hs[1][i];
    ss += __shfl_xor(ss, 32);
    if (hh == 0) XS[wave * 32 + r] = ss;
    __syncthreads();
    const float rinv = 1.0f / sqrtf((ss + XS[(wave ^ 4) * 32 + r]) * (1.0f / 128.0f) + EPS);
    LAS unsigned char* stg = L + MO_KS + wave * OST_BYTES;
    bf16* obase = MIX + (tok0 + 32 * tt) * 1024 + 512 + hd * 128 + 64 * vh;
#pragma unroll
    for (int vt = 0; vt < 2; ++vt) { u32x2 ow[4];
#pragma unroll
        for (int rg = 0; rg < 4; ++rg) {
            const int v = 64 * vh + 32 * vt + 8 * rg + 4 * hh;
            const f32x4 og = *(const LAS f32x4*)(OG + v);
            const u32x2 m_ = mw[vt * 4 + rg];
            const float m0 = bflo(m_.x), m1 = bfhi(m_.x), m2 = bflo(m_.y), m3 = bfhi(m_.y);
            const float o0 = hs[vt][4 * rg] * rinv * og[0] * sigmoid_f(m0), o1 = hs[vt][4 * rg + 1] * rinv * og[1] * sigmoid_f(m1);
            const float o2 = hs[vt][4 * rg + 2] * rinv * og[2] * sigmoid_f(m2), o3 = hs[vt][4 * rg + 3] * rinv * og[3] * sigmoid_f(m3);
            ow[rg].x = pk2(o0, o1); ow[rg].y = pk2(o2, o3);
        }
        stage_store_32x32(stg, ow, obase + 32 * vt, 1024, lane); }
    }
}
constexpr int SEL_VALS = 0, SEL_HIST = 32768, SEL_MISC = 32768 + 1024, SEL_WSUM = SEL_MISC + 64;
__device__ __forceinline__ void select_unit(Frame& F, int u) {
    const int tid = F.tid, lane = F.lane, wave = F.wave;
    LAS unsigned* vals = (LAS unsigned*)(F.lds + SEL_VALS); LAS unsigned* hist = (LAS unsigned*)(F.lds + SEL_HIST); LAS unsigned* misc = (LAS unsigned*)(F.lds + SEL_MISC); LAS unsigned* wsum = (LAS unsigned*)(F.lds + SEL_WSUM);
    const float* AFF = wsp<float>(F, WS_AFF) + (size_t)u * SEQ;
    int* IDX = wsp<int>(F, WS_IDX) + (size_t)u * CAP; float* GV = wsp<float>(F, WS_GVAL) + (size_t)u * CAP; int* SLOT = wsp<int>(F, WS_SLOT);
    float* RE = wsp<float>(F, WS_RINVE) + (size_t)u * CAP; const float* RINV2 = wsp<float>(F, WS_RINV2) + (size_t)(u >> 4) * SEQ;
    const int b = u >> 4, e = u & 15;
    __syncthreads();
    unsigned mine[16];
#pragma unroll
    for (int i = 0; i < 4; ++i) { const u32x4 v = *(const u32x4*)(AFF + 16 * tid + 4 * i); mine[4 * i] = v.x; mine[4 * i + 1] = v.y; mine[4 * i + 2] = v.z; mine[4 * i + 3] = v.w; }
    unsigned prefix = 0u, mask = 0u, kk = CAP;
#pragma unroll 1
    for (int pass = 0; pass < 4; ++pass) {
        const int shift = 24 - 8 * pass;
        if (tid < 256) hist[tid] = 0u;
        __syncthreads();
#pragma unroll
        for (int i = 0; i < 16; ++i) if ((mine[i] & mask) == prefix) __hip_atomic_fetch_add(&hist[(mine[i] >> shift) & 255u], 1u, __ATOMIC_RELAXED, __HIP_MEMORY_SCOPE_WORKGROUP);
        __syncthreads();
        if (wave == 0) {
            const unsigned h0 = hist[4 * lane], h1 = hist[4 * lane + 1], h2 = hist[4 * lane + 2], h3 = hist[4 * lane + 3];
            const unsigned ls = h0 + h1 + h2 + h3;
            unsigned incl = ls;
#pragma unroll
            for (int o = 1; o < 64; o <<= 1) { const unsigned t = __shfl_down(incl, o); if (lane + o < 64) incl += t; }
            const unsigned above = incl - ls;
            const unsigned a3 = above, a2 = above + h3, a1 = a2 + h2, a0 = a1 + h1;
            int d = -1; unsigned ab = 0u;
            if (a3 < kk && kk <= a3 + h3) { d = 4 * lane + 3; ab = a3; }
            else if (a2 < kk && kk <= a2 + h2) { d = 4 * lane + 2; ab = a2; }
            else if (a1 < kk && kk <= a1 + h1) { d = 4 * lane + 1; ab = a1; }
            else if (a0 < kk && kk <= a0 + h0) { d = 4 * lane; ab = a0; }
            if (d >= 0) { misc[0] = (unsigned)d; misc[1] = ab; }
        }
        __syncthreads();
        prefix |= misc[0] << shift; mask |= 255u << shift; kk -= misc[1];
    }
    unsigned cg = 0u, ce = 0u;
#pragma unroll
    for (int i = 0; i < 16; ++i) { cg += mine[i] > prefix ? 1u : 0u; ce += mine[i] == prefix ? 1u : 0u; }
    unsigned pk = cg | (ce << 16), incl = pk;
#pragma unroll
    for (int o = 1; o < 64; o <<= 1) { const unsigned t = __shfl_up(incl, o); if (lane >= o) incl += t; }
    if (lane == 63) wsum[wave] = incl;
    __syncthreads();
    unsigned base = 0u;
#pragma unroll
    for (int w = 0; w < 8; ++w) if (w < wave) base += wsum[w];
    unsigned excl = base + incl - pk;
    unsigned ng = excl & 0xffffu, ne = excl >> 16;
    const unsigned ngt_total = CAP - kk;
#pragma unroll
    for (int i = 0; i < 16; ++i) {
        const int s = 16 * tid + i; int slot = -1;
        if (mine[i] > prefix) { slot = (int)ng; ++ng; }
        else if (mine[i] == prefix) { if (ne < kk) slot = (int)(ngt_total + ne); ++ne; }
        if (slot >= 0) { IDX[slot] = s; GV[slot] = __builtin_bit_cast(float, mine[i]); RE[slot] = RINV2[s]; }
        SLOT[(size_t)u * SEQ + s] = slot;
    }
}
__device__ __forceinline__ void phase_gather(Frame& F) {
    const int gw = F.bid * 8 + F.wave, NGW = F.G * 8, lane = F.lane;
    const int* IDX = wsp<int>(F, WS_IDX); const bf16* X2B = wsp<bf16>(F, WS_X2B); bf16* XE = wsp<bf16>(F, WS_XE); const float* RINV2 = wsp<float>(F, WS_RINV2); float* RE = wsp<float>(F, WS_RINVE);
    for (int row = gw; row < XROWS; row += NGW) {
        const int b = row >> 14; const size_t tok = (size_t)b * SEQ + IDX[row];
        const u32x4* src = (const u32x4*)(X2B + tok * 1024) + lane; u32x4* dst = (u32x4*)(XE + (size_t)row * 1024) + lane;
        const u32x4 v0 = src[0], v1 = src[64];
        dst[0] = v0; dst[64] = v1;
        if (lane == 0) RE[row] = RINV2[tok];
    }
}
__device__ __forceinline__ void phase_combine(Frame& F) {
    const int gw = F.bid * 8 + F.wave, NGW = F.G * 8, lane = F.lane;
    const int* SLOT = wsp<int>(F, WS_SLOT); const unsigned char* Y8 = wsp<unsigned char>(F, WS_Y); const bf16* X2B = wsp<bf16>(F, WS_X2B);
    constexpr float YS = 1.0f / (float)(1 << F8_YSHIFT);
#define CB_ADD(acc0, acc1, acc2, acc3, yv, wt) do { f32x2 p_; \
        p_ = __builtin_amdgcn_cvt_pk_f32_fp8((int)(yv).x, false); acc0[0] += p_[0] * (wt); acc0[1] += p_[1] * (wt); p_ = __builtin_amdgcn_cvt_pk_f32_fp8((int)(yv).x, true); acc0[2] += p_[0] * (wt); acc0[3] += p_[1] * (wt); \
        p_ = __builtin_amdgcn_cvt_pk_f32_fp8((int)(yv).y, false); acc1[0] += p_[0] * (wt); acc1[1] += p_[1] * (wt); p_ = __builtin_amdgcn_cvt_pk_f32_fp8((int)(yv).y, true); acc1[2] += p_[0] * (wt); acc1[3] += p_[1] * (wt); \
        p_ = __builtin_amdgcn_cvt_pk_f32_fp8((int)(yv).z, false); acc2[0] += p_[0] * (wt); acc2[1] += p_[1] * (wt); p_ = __builtin_amdgcn_cvt_pk_f32_fp8((int)(yv).z, true); acc2[2] += p_[0] * (wt); acc2[3] += p_[1] * (wt); \
        p_ = __builtin_amdgcn_cvt_pk_f32_fp8((int)(yv).w, false); acc3[0] += p_[0] * (wt); acc3[1] += p_[1] * (wt); p_ = __builtin_amdgcn_cvt_pk_f32_fp8((int)(yv).w, true); acc3[2] += p_[0] * (wt); acc3[3] += p_[1] * (wt); } while (0)
#define CB_LOAD(jj, X0, X1, YV, WT, REST) do { \
        unsigned mm_ = (unsigned)((((jj) & 1) ? by : bx) >> (16 * ((jj) >> 1))) & 0xffffu; \
        _Pragma("unroll") for (int k_ = 0; k_ < 4; ++k_) { const bool has_ = mm_ != 0u; const int e_ = has_ ? __builtin_ctz(mm_) : 0; mm_ = has_ ? (mm_ & (mm_ - 1u)) : 0u; \
            const int slot_ = has_ ? __builtin_amdgcn_readlane(((jj) & 1) ? (int)sl.y : (int)sl.x, 16 * ((jj) >> 1) + e_) : 0; \
            WT[k_] = has_ ? YS : 0.f; YV[k_] = *((const u32x4*)(Y8 + ((size_t)(b * 16 + e_) * CAP + slot_) * 1024) + lane); } \
        REST = mm_; { const u32x4* xr_ = (const u32x4*)(X2B + (size_t)(tok0 + (jj)) * 1024) + 2 * lane; X0 = xr_[0]; X1 = xr_[1]; } } while (0)
#define CB_FINISH(jj, X0, X1, YV, WT, REST) do { \
        f32x4 a0 = {bflo(X0.x), bfhi(X0.x), bflo(X0.y), bfhi(X0.y)}, a1 = {bflo(X0.z), bfhi(X0.z), bflo(X0.w), bfhi(X0.w)}; \
        f32x4 a2 = {bflo(X1.x), bfhi(X1.x), bflo(X1.y), bfhi(X1.y)}, a3 = {bflo(X1.z), bfhi(X1.z), bflo(X1.w), bfhi(X1.w)}; \
        _Pragma("unroll") for (int k_ = 0; k_ < 4; ++k_) CB_ADD(a0, a1, a2, a3, YV[k_], WT[k_]); \
        { unsigned mm_ = REST; \
          while (mm_ != 0u) { const int e_ = __builtin_ctz(mm_); mm_ &= mm_ - 1u; const int slot_ = __builtin_amdgcn_readlane(((jj) & 1) ? (int)sl.y : (int)sl.x, 16 * ((jj) >> 1) + e_); \
              const u32x4 yv_ = *((const u32x4*)(Y8 + ((size_t)(b * 16 + e_) * CAP + slot_) * 1024) + lane); CB_ADD(a0, a1, a2, a3, yv_, YS); } } \
        f32x4* o_ = (f32x4*)(F.out + (size_t)(tok0 + (jj)) * 1024) + 4 * lane; o_[0] = a0; o_[1] = a1; o_[2] = a2; o_[3] = a3; } while (0)
#pragma unroll 1
    for (int grp = gw; grp < T / 8; grp += NGW) {
        const int tok0 = grp * 8, b = tok0 >> 13, s0 = tok0 & (SEQ - 1);
        const u32x2 sl = *(const u32x2*)(SLOT + ((size_t)(b * 16 + (lane & 15)) * SEQ + s0 + 2 * (lane >> 4)));
        const unsigned long long bx = __ballot((int)sl.x >= 0), by = __ballot((int)sl.y >= 0);
        u32x4 xa0, xa1, ya[4], xb0, xb1, yb[4]; float wa[4], wb[4]; unsigned ra, rb;
        CB_LOAD(0, xa0, xa1, ya, wa, ra);
#pragma unroll
        for (int jj = 0; jj < 8; jj += 2) {
            CB_LOAD(jj + 1, xb0, xb1, yb, wb, rb);
            CB_FINISH(jj, xa0, xa1, ya, wa, ra);
            if (jj + 2 < 8) CB_LOAD(jj + 2, xa0, xa1, ya, wa, ra);
            CB_FINISH(jj + 1, xb0, xb1, yb, wb, rb);
        }
    }
#undef CB_ADD
#undef CB_LOAD
#undef CB_FINISH
}
struct Args { const float* in[25]; float* out; unsigned char* ws; };
constexpr int MISC_OFF = LDS_BYTES - 64;
constexpr int CW_BAR = 4096;
__global__ void __launch_bounds__(512, 2) hymba_fwd(Args args) {
    extern __shared__ __attribute__((aligned(16))) unsigned char lds_raw[];
    cg::grid_group grid = cg::this_grid();
    Frame F;
    F.lds = (LAS unsigned char*)lds_raw;
    F.tid = threadIdx.x; F.lane = F.tid & 63; F.wave = __builtin_amdgcn_readfirstlane(F.tid >> 6); F.bid = blockIdx.x; F.G = gridDim.x;
    F.out = args.out; F.ws = args.ws;
    const int G = F.G, bid = F.bid;
    if (F.tid < 16) ((LAS unsigned*)(F.lds + MISC_OFF))[F.tid] = 0u;
    __syncthreads();
    if (bid == 0) for (int i = F.tid; i < XCD_BAR_WORDS; i += 512) ((unsigned*)(F.ws + WS_CTL) + CW_BAR)[i] = 0u;
#define GSYNC() xcd_barrier(xbar, F.wave == 0 && pg8::fresh_lane() == 0)
#define LAUNDER() do { F.tid = F.wave * 64 + pg8::fresh_lane(); asm volatile("" : "+v"(F.tid)); F.lane = F.tid & 63; } while (0)

    LAUNDER(); prep_weights(F);
    LAUNDER(); prep_small(F);
    LAUNDER(); prep_rows(F);
    grid.sync();
    const XcdBarrier xbar = xcd_barrier_post((unsigned*)(F.ws + WS_CTL) + CW_BAR, (volatile LAS unsigned*)(F.lds + MISC_OFF), F.wave == 0 && pg8::fresh_lane() == 0);
    LAUNDER(); phase_gates(F, G > 64 ? 32 : 0);
    LAUNDER(); {
        pg8::Gemm g{wsp<bf16>(F, WS_MEMN), wsp<bf16>(F, WS_WKV), BATCH * MEMT, 1024, 1024, F.wave}; pg8::StaticOrder S; S.init(BATCH * MEMT, 1024, G, bid);
        pg8::EpiHead128<false> E{wsp<bf16>(F, WS_KVM), 1024, nullptr, wsp<float>(F, WS_SSQMK), 2, BATCH * MEMT};
        pg8::gemm_phase<pg8::EpiHead128<false>, pg8::StaticOrder, true, true>(F.lds, g, S, E);
    }
    LAUNDER(); {
        pg8::Gemm g{wsp<bf16>(F, WS_XB), wsp<bf16>(F, WS_WIN), T, INW_G, 1024, F.wave}; pg8::StaticOrder S; S.init(T, INW_G, G, bid);
        pg8::EpiInProj E{F.ws};
        pg8::gemm_phase<pg8::EpiInProj, pg8::StaticOrder, true, true>(F.lds, g, S, E);
    }
    GSYNC();
    LAUNDER(); phase_conv(F);
    LAUNDER(); phase_gatescan(F);
    LAUNDER(); for (int u = bid; u < BATCH * 64 * 2; u += G) { const int kvh = u & 1, qb = (u >> 1) & 63, b = u >> 7; wattn_unit(F, b, qb, kvh); }
    GSYNC();
    LAUNDER(); for (int v = bid; v < BATCH * 4 * 2 * 4; v += G) { const int u = (((v >> 5) << 3 | (v & 7)) << 2) | ((v >> 3) & 3); mlstm_state_unit(F, u); }
    GSYNC();
    LAUNDER(); for (int u = bid; u < BATCH * 64 * 4; u += G) mlstm_out_unit(F, u);
    GSYNC();
    LAUNDER(); {
        pg8::Gemm g{wsp<bf16>(F, WS_MIX), wsp<bf16>(F, WS_WOUT), T, 1024, 1024, F.wave}; pg8::StaticOrder S; S.init(T, 1024, G, bid);
        pg8::EpiResid<true> E{wsp<bf16>(F, WS_XB), wsp<bf16>(F, WS_X1B), wsp<float>(F, WS_SSQ1)};
        pg8::gemm_phase<pg8::EpiResid<true>, pg8::StaticOrder, true, true>(F.lds, g, S, E);
    }
    GSYNC();
    LAUNDER(); {
        pg8::Gemm g{wsp<bf16>(F, WS_X1B), wsp<bf16>(F, WS_WMQ), T, 512, 1024, F.wave}; pg8::StaticOrder S; S.init(T, 512, G, bid);
        { float* R1 = wsp<float>(F, WS_RINVX); const float* SS = wsp<float>(F, WS_SSQ1); pg8::Unit pu;
          for (int i = 0; S.next(i, pu); ++i) if (F.tid < 256) { const int row = pu.pm * 256 + F.tid; float pp[16];
#pragma unroll
              for (int q = 0; q < 16; ++q) pp[q] = SS[(size_t)q * T + row];
              const float t = (((pp[0] + pp[1]) + (pp[2] + pp[3])) + ((pp[4] + pp[5]) + (pp[6] + pp[7]))) + (((pp[8] + pp[9]) + (pp[10] + pp[11])) + ((pp[12] + pp[13]) + (pp[14] + pp[15])));
              R1[row] = 1.0f / sqrtf(t * (1.0f / 1024.0f) + 1e-6f); }
          asm volatile("s_waitcnt vmcnt(0)" ::: "memory"); __syncthreads(); }
        pg8::EpiHead128<true> E{wsp<bf16>(F, WS_QM), 512, wsp<float>(F, WS_RINVX), wsp<float>(F, WS_SSQQ), 2, T};
        pg8::gemm_phase<pg8::EpiHead128<true>, pg8::StaticOrder, false, true>(F.lds, g, S, E);
    }
    GSYNC();
    LAUNDER(); xattn_phase(F);
    GSYNC();
    {
        pg8::Gemm g{wsp<bf16>(F, WS_OM), wsp<bf16>(F, WS_WMO), T, 1024, 512, F.wave}; pg8::StaticOrder S; S.init(T, 1024, G, bid);
        pg8::EpiResid<true, true> E{wsp<bf16>(F, WS_X1B), wsp<bf16>(F, WS_X2B), nullptr, wsp<unsigned char>(F, WS_X2F8)};
        pg8::gemm_phase<pg8::EpiResid<true, true>, pg8::StaticOrder, true, true>(F.lds, g, S, E);
    }
    GSYNC();
    LAUNDER(); phase_router(F);
    GSYNC();
    LAUNDER(); for (int u = bid; u < BATCH * NEXP; u += G) select_unit(F, u);
    GSYNC();
    LAUNDER(); {
        pg8::Gemm g{wsp<bf16>(F, WS_X2F8), wsp<bf16>(F, WS_WGU), XROWS, NEXP * 2048, 512, F.wave}; pg8::ExpertOrder<8> S{G, bid};
        pg8::EpiGateUpT<true, 2> E{wsp<bf16>(F, WS_HID), wsp<float>(F, WS_RINVE), 1.0f / (float)(1 << F8_WSHIFT)};
        pg8::gemm_phase<pg8::EpiGateUpT<true, 2>, pg8::ExpertOrder<8>, true, true, true, 1>(F.lds, g, S, E, wsp<int>(F, WS_IDX));
    }
    GSYNC();
    LAUNDER(); {
        pg8::Gemm g{wsp<bf16>(F, WS_HID), wsp<bf16>(F, WS_WD), XROWS, NEXP * 1024, 512, F.wave}; pg8::ExpertOrder<4> S{G, bid};
        pg8::EpiDownT<2, true> E{wsp<bf16>(F, WS_Y), wsp<float>(F, WS_GVAL), (float)(1 << F8_YSHIFT) / (float)(1 << F8_WSHIFT)};
        pg8::gemm_phase<pg8::EpiDownT<2, true>, pg8::ExpertOrder<4>, false, true, false, 1>(F.lds, g, S, E);
    }
    GSYNC();
    LAUNDER(); phase_combine(F);
}

extern "C" void kernel_launch(void* const* d_in, const int* in_sizes, int n_in, void* d_out, int out_size, void* d_ws, size_t ws_size, hipStream_t stream) {
    static int grid = 0;
    if (grid == 0) {
        if (n_in != 25 || in_sizes[0] != T * DM || out_size != T * DM || ws_size < WS_END) { fprintf(stderr, "kernel_launch: unexpected shapes (n_in %d, in0 %d, out %d, ws %zu); nothing launched\n", n_in, n_in > 0 ? in_sizes[0] : -1, out_size, ws_size); grid = -1; return; }
        int dev = 0, cus = 0, per_cu = 0;
        if (hipGetDevice(&dev) != hipSuccess || hipDeviceGetAttribute(&cus, hipDeviceAttributeMultiprocessorCount, dev) != hipSuccess) { grid = -1; return; }
        if (hipFuncSetAttribute((const void*)hymba_fwd, hipFuncAttributeMaxDynamicSharedMemorySize, LDS_BYTES) != hipSuccess) { fprintf(stderr, "kernel_launch: hipFuncSetAttribute failed\n"); grid = -1; return; }
        if (hipOccupancyMaxActiveBlocksPerMultiprocessor(&per_cu, (const void*)hymba_fwd, 512, LDS_BYTES) != hipSuccess || per_cu < 1) { fprintf(stderr, "kernel_launch: occupancy query says %d blocks per CU\n", per_cu); (void)hipGetLastError(); per_cu = 1; }
        grid = cus;
        fprintf(stderr, "kernel_launch: %d CUs, %d blocks/CU by the occupancy query, grid %d, ws %zu\n", cus, per_cu, grid, ws_size);
    }
    if (grid < 0) return;
    Args a{};
    for (int i = 0; i < 25; ++i) a.in[i] = (const float*)d_in[i];
    a.out = (float*)d_out; a.ws = (unsigned char*)d_ws;
    void* kargs[] = {&a};
    const hipError_t e = hipLaunchCooperativeKernel((const void*)hymba_fwd, dim3(grid), dim3(512), kargs, LDS_BYTES, stream);
    if (e != hipSuccess) fprintf(stderr, "kernel_launch: cooperative launch failed: %s (grid %d)\n", hipGetErrorString(e), grid);
}
```
